# Optimizing an MI355X kernel written in HIP

```python
import jax, jax.numpy as jnp
from jax import lax
import numpy as np

D_MODEL = 2048
BATCH = 2
SEQ = 8192
DEPTH = 1

GRID_W = 64
CTX_LEN = 256
HEAD_DIM = 128
N_Q_HEADS = 16
N_KV_HEADS = 4
Q_PER_KV = N_Q_HEADS // N_KV_HEADS
WINDOW = 128
BLOCK = 128
ROPE_THETA = 10000.0
GLA_HEADS = 4
GLA_DK = D_MODEL // 2 // GLA_HEADS
GLA_DV = D_MODEL // GLA_HEADS
GLA_LOWRANK = 16
GLA_GATE_NORM = 16.0
GLA_CHUNK = 64
D_FF = 5632
CONV_W = 3
EPS = 1e-6
ATTN_WIDTH = N_Q_HEADS * HEAD_DIM
KV_WIDTH = N_KV_HEADS * HEAD_DIM
GLA_K_WIDTH = GLA_HEADS * GLA_DK
GLA_V_WIDTH = GLA_HEADS * GLA_DV
IN_SPLITS = (ATTN_WIDTH, KV_WIDTH, KV_WIDTH, GLA_K_WIDTH, GLA_K_WIDTH, GLA_V_WIDTH, GLA_V_WIDTH,
             GLA_LOWRANK, GLA_LOWRANK, D_MODEL, D_MODEL)
IN_WIDTH = sum(IN_SPLITS)

kernel_name = "hybrid_swa_gla_convffn_prefix_dit"


def rms_norm(x, g):
    xf = x.astype(jnp.float32)
    y = xf * lax.rsqrt(jnp.mean(xf * xf, axis=-1, keepdims=True) + EPS)
    return (y * g.astype(jnp.float32)).astype(x.dtype)


def modulate(x, g, shift, scale):
    return rms_norm(x, g) * (1 + scale) + shift


def split_heads(a, n_heads):
    return a.reshape(*a.shape[:-1], n_heads, -1)


def axial_rope_angles(n):
    rows = n // GRID_W
    row = jnp.repeat(jnp.arange(rows), GRID_W)
    col = jnp.tile(jnp.arange(GRID_W), rows)
    n_freq = HEAD_DIM // 4
    inv = ROPE_THETA ** (-jnp.arange(n_freq, dtype=jnp.float32) / n_freq)
    ang = jnp.concatenate([row[:, None] * inv, col[:, None] * inv], axis=-1)
    return jnp.cos(ang), jnp.sin(ang)


def apply_rope(x, cos, sin):
    half = HEAD_DIM // 2
    x1, x2 = x[..., :half].astype(jnp.float32), x[..., half:].astype(jnp.float32)
    c, s = cos[None, :, None, :], sin[None, :, None, :]
    return jnp.concatenate([x1 * c - x2 * s, x2 * c + x1 * s], axis=-1).astype(x.dtype)


def gqa_scores(q5, k):
    return jnp.einsum("bqhgd,bkhd->bhgqk", q5, k).astype(jnp.float32) * (HEAD_DIM ** -0.5)


def attend_with_sink(parts, sink_g):
    sink_b = sink_g[None, :, :, None]
    m = sink_b
    for s, _ in parts:
        m = jnp.maximum(m, s.max(axis=-1))
    denom = jnp.exp(sink_b - m)
    out = None
    for s, val in parts:
        p = jnp.exp(s - m[..., None])
        denom = denom + p.sum(axis=-1)
        o = jnp.einsum("bhgqk,bkhd->bqhgd", p, val.astype(jnp.float32))
        out = o if out is None else out + o
    return out / jnp.transpose(denom, (0, 3, 1, 2))[..., None]


def windowed_attention(q, k, v, k_ctx, v_ctx, sink):
    B, n = q.shape[:2]
    nb = n // BLOCK
    span = BLOCK + 2 * WINDOW
    pad = ((0, 0), (WINDOW, WINDOW), (0, 0), (0, 0))
    kp, vp = jnp.pad(k, pad), jnp.pad(v, pad)
    qb = jnp.swapaxes(q.reshape(B, nb, BLOCK, N_KV_HEADS, Q_PER_KV, HEAD_DIM), 0, 1)
    sink_g = sink.reshape(N_KV_HEADS, Q_PER_KV).astype(jnp.float32)
    s_ctx_all = None

    def block(args):
        qi, i = args
        start = i * BLOCK
        kw = lax.dynamic_slice_in_dim(kp, start, span, axis=1)
        vw = lax.dynamic_slice_in_dim(vp, start, span, axis=1)
        qpos = start + jnp.arange(BLOCK)
        kpos = start - WINDOW + jnp.arange(span)
        valid = ((jnp.abs(qpos[:, None] - kpos[None, :]) <= WINDOW)
                 & (kpos >= 0)[None, :] & (kpos < n)[None, :])
        s_lat = jnp.where(valid, gqa_scores(qi, kw), -jnp.inf)
        s_ctx = gqa_scores(qi, k_ctx)
        return attend_with_sink([(s_lat, vw), (s_ctx, v_ctx)], sink_g)

    o = lax.map(block, (qb, jnp.arange(nb)))
    return jnp.swapaxes(o, 0, 1).reshape(B, n, ATTN_WIDTH).astype(q.dtype)


def context_attention(q, k, v, sink):
    B, L = q.shape[:2]
    q5 = q.reshape(B, L, N_KV_HEADS, Q_PER_KV, HEAD_DIM)
    sink_g = sink.reshape(N_KV_HEADS, Q_PER_KV).astype(jnp.float32)
    o = attend_with_sink([(gqa_scores(q5, k), v)], sink_g)
    return o.reshape(B, L, ATTN_WIDTH).astype(q.dtype)


def gla_chunked(q, k, v, g, s0):
    B, T, H, _ = q.shape
    dv = v.shape[-1]
    nc = T // GLA_CHUNK

    def to_chunks(a):
        return jnp.transpose(a.reshape(B, nc, GLA_CHUNK, H, a.shape[-1]), (1, 0, 3, 2, 4)).astype(jnp.float32)

    causal = jnp.tril(jnp.ones((GLA_CHUNK, GLA_CHUNK), dtype=bool))[..., None]

    def step(S, inp):
        qc, kc, vc, gc = inp
        b = jnp.cumsum(gc, axis=2)
        b_last = b[:, :, -1:]
        o_inter = jnp.einsum("bhcd,bhde->bhce", qc * jnp.exp(b), S)
        rel = jnp.where(causal, b[:, :, :, None, :] - b[:, :, None, :, :], -jnp.inf)
        A = jnp.einsum("bhtd,bhsd,bhtsd->bhts", qc, kc, jnp.exp(rel))
        o = o_inter + jnp.einsum("bhts,bhse->bhte", A, vc)
        S = (jnp.exp(b_last[:, :, 0])[..., None] * S
             + jnp.einsum("bhsd,bhse->bhde", kc * jnp.exp(b_last - b), vc))
        return S, o

    S, o = lax.scan(step, s0, (to_chunks(q), to_chunks(k), to_chunks(v), to_chunks(g)))
    o = jnp.transpose(o, (1, 0, 3, 2, 4)).reshape(B, T, H, dv)
    return o.astype(v.dtype), S


def gla_final_state(k, v, g):
    b = jnp.cumsum(g.astype(jnp.float32), axis=1)
    w = jnp.exp(b[:, -1:] - b)
    return jnp.einsum("bthd,bthe->bhde", k.astype(jnp.float32) * w, v.astype(jnp.float32))


def flip(a):
    return a[:, ::-1]


def context_gla(q, k, v, gf, gb, need_out):
    if need_out:
        s0 = jnp.zeros((q.shape[0], GLA_HEADS, GLA_DK, GLA_DV), jnp.float32)
        of, sf = gla_chunked(q, k, v, gf, s0)
        ob, sb = gla_chunked(flip(q), flip(k), flip(v), flip(gb), s0)
        return sf, sb, of + flip(ob)
    return gla_final_state(k, v, gf), gla_final_state(flip(k), flip(v), flip(gb)), None


def latent_gla(q, k, v, gf, gb, sf, sb):
    of, _ = gla_chunked(q, k, v, gf, sf)
    ob, _ = gla_chunked(flip(q), flip(k), flip(v), flip(gb), sb)
    return of + flip(ob)


def project_heads(h, w_in, q_norm, k_norm, w_gate_f, b_gate_f, w_gate_b, b_gate_b):
    offs = np.cumsum(IN_SPLITS)[:-1].tolist()
    qa, ka, va, qb, kb, vb, rb, lrf, lrb, gate_a, gate_b = jnp.split(h @ w_in, offs, axis=-1)
    qa = rms_norm(split_heads(qa, N_Q_HEADS), q_norm)
    ka = rms_norm(split_heads(ka, N_KV_HEADS), k_norm)
    va = split_heads(va, N_KV_HEADS)
    qb = split_heads(qb, GLA_HEADS) * (GLA_DK ** -0.5)
    kb = split_heads(kb, GLA_HEADS)
    vb = split_heads(vb, GLA_HEADS)
    gf = split_heads(jax.nn.log_sigmoid((lrf @ w_gate_f + b_gate_f).astype(jnp.float32)) / GLA_GATE_NORM, GLA_HEADS)
    gb = split_heads(jax.nn.log_sigmoid((lrb @ w_gate_b + b_gate_b).astype(jnp.float32)) / GLA_GATE_NORM, GLA_HEADS)
    return qa, ka, va, qb, kb, vb, rb, gf, gb, gate_a, gate_b


def merge_branches(o_attn, o_gla, rb, gate_a, gate_b, gla_norm, w_attn_o, w_gla_o, w_out):
    B, T = o_attn.shape[:2]
    y_att = o_attn @ w_attn_o
    y_gla = (rms_norm(o_gla, gla_norm).reshape(B, T, GLA_V_WIDTH) * jax.nn.silu(rb)) @ w_gla_o
    return (jax.nn.sigmoid(gate_a) * y_att + jax.nn.sigmoid(gate_b) * y_gla) @ w_out


def conv_ffn(h, w_up, conv_w, conv_b, w_down):
    T = h.shape[1]
    u = h @ w_up
    up = jnp.pad(u, ((0, 0), (CONV_W // 2, CONV_W // 2), (0, 0)))
    u = sum(up[:, j:j + T] * conv_w[j] for j in range(CONV_W)) + conv_b
    a, g = jnp.split(u, 2, axis=-1)
    return (jax.nn.silu(a) * g) @ w_down


def setup_inputs(seed: int = 0) -> dict:
    key = jax.random.key(seed)
    ks = jax.random.split(key, 24)
    D, L = D_MODEL, DEPTH

    def nrm(k, shape, s):
        return jax.random.normal(k, shape, jnp.float32) * s

    return {
        "x": nrm(ks[0], (BATCH, SEQ, D), 1.0),
        "c": nrm(ks[1], (BATCH, D), 1.0),
        "ctx": nrm(ks[2], (BATCH, CTX_LEN, D), 1.0),
        "c_ctx": nrm(ks[3], (D,), 1.0),
        "w_mod": nrm(ks[4], (L, D, 6 * D), 0.5 * D ** -0.5),
        "b_mod": nrm(ks[5], (L, 6 * D), 0.02),
        "g_mix": 1.0 + nrm(ks[6], (L, D), 0.05),
        "w_in": nrm(ks[7], (L, D, IN_WIDTH), D ** -0.5),
        "q_norm": 1.0 + nrm(ks[8], (L, HEAD_DIM), 0.05),
        "k_norm": 1.0 + nrm(ks[9], (L, HEAD_DIM), 0.05),
        "attn_sink": nrm(ks[10], (L, N_Q_HEADS), 0.5),
        "w_gate_f": nrm(ks[11], (L, GLA_LOWRANK, GLA_K_WIDTH), GLA_LOWRANK ** -0.5),
        "b_gate_f": nrm(ks[12], (L, GLA_K_WIDTH), 0.1),
        "w_gate_b": nrm(ks[13], (L, GLA_LOWRANK, GLA_K_WIDTH), GLA_LOWRANK ** -0.5),
        "b_gate_b": nrm(ks[14], (L, GLA_K_WIDTH), 0.1),
        "gla_norm": 1.0 + nrm(ks[15], (L, GLA_DV), 0.05),
        "w_attn_o": nrm(ks[16], (L, ATTN_WIDTH, D), ATTN_WIDTH ** -0.5),
        "w_gla_o": nrm(ks[17], (L, GLA_V_WIDTH, D), GLA_V_WIDTH ** -0.5),
        "w_out": nrm(ks[18], (L, D, D), D ** -0.5),
        "g_ffn": 1.0 + nrm(ks[19], (L, D), 0.05),
        "w_up": nrm(ks[20], (L, D, 2 * D_FF), D ** -0.5),
        "conv_w": nrm(ks[21], (L, CONV_W, 2 * D_FF), CONV_W ** -0.5),
        "conv_b": nrm(ks[22], (L, 2 * D_FF), 0.02),
        "w_down": nrm(ks[23], (L, D_FF, D), D_FF ** -0.5),
    }


def reference(x, c, ctx, c_ctx, w_mod, b_mod, g_mix, w_in, q_norm, k_norm, attn_sink,
              w_gate_f, b_gate_f, w_gate_b, b_gate_b, gla_norm, w_attn_o, w_gla_o, w_out,
              g_ffn, w_up, conv_w, conv_b, w_down):
    n = x.shape[1]
    cos, sin = axial_rope_angles(n)
    for l in range(DEPTH):
        last = l == DEPTH - 1
        mod_x = jnp.split((jax.nn.silu(c) @ w_mod[l] + b_mod[l])[:, None, :], 6, axis=-1)
        mod_c = jnp.split((jax.nn.silu(c_ctx) @ w_mod[l] + b_mod[l])[None, None, :], 6, axis=-1)
        proj = lambda h: project_heads(h, w_in[l], q_norm[l], k_norm[l],
                                       w_gate_f[l], b_gate_f[l], w_gate_b[l], b_gate_b[l])

        qa, ka, va, qb, kb, vb, rb, gf, gb, gate_a, gate_b = proj(modulate(x, g_mix[l], mod_x[0], mod_x[1]))
        qa, ka = apply_rope(qa, cos, sin), apply_rope(ka, cos, sin)
        cqa, cka, cva, cqb, ckb, cvb, crb, cgf, cgb, cgate_a, cgate_b = proj(
            modulate(ctx, g_mix[l], mod_c[0], mod_c[1]))

        o_attn = windowed_attention(qa, ka, va, cka, cva, attn_sink[l])
        sf, sb, o_gla_c = context_gla(cqb, ckb, cvb, cgf, cgb, need_out=not last)
        o_gla = latent_gla(qb, kb, vb, gf, gb, sf, sb)
        x = x + mod_x[2] * merge_branches(o_attn, o_gla, rb, gate_a, gate_b, gla_norm[l],
                                          w_attn_o[l], w_gla_o[l], w_out[l])
        x = x + mod_x[5] * conv_ffn(modulate(x, g_ffn[l], mod_x[3], mod_x[4]),
                                    w_up[l], conv_w[l], conv_b[l], w_down[l])

        if not last:
            o_attn_c = context_attention(cqa, cka, cva, attn_sink[l])
            ctx = ctx + mod_c[2] * merge_branches(o_attn_c, o_gla_c, crb, cgate_a, cgate_b, gla_norm[l],
                                                  w_attn_o[l], w_gla_o[l], w_out[l])
            ctx = ctx + mod_c[5] * conv_ffn(modulate(ctx, g_ffn[l], mod_c[3], mod_c[4]),
                                            w_up[l], conv_w[l], conv_b[l], w_down[l])
    return x
```

```cpp
#include <hip/hip_runtime.h>
#include <hip/hip_cooperative_groups.h>
#include <cstdio>
namespace cg = cooperative_groups;

#define LAS __attribute__((address_space(3)))
typedef unsigned short bf16_t;
typedef short bf16x8 __attribute__((ext_vector_type(8)));
typedef float f32x4 __attribute__((ext_vector_type(4)));
typedef float f32x2 __attribute__((ext_vector_type(2)));
typedef unsigned u32x4 __attribute__((ext_vector_type(4)));
typedef unsigned u32x2 __attribute__((ext_vector_type(2)));

constexpr int T_ = 8192, NTOK = 16384, NROW = 16896, DM = 2048;
constexpr int LDS_BYTES = 153600;
constexpr float EPS_ = 1e-6f;

constexpr size_t O_MODP = 0;
constexpr size_t O_MOD = O_MODP + 4718592;
constexpr size_t O_ROPE = O_MOD + 147456;
constexpr size_t O_DD = O_ROPE + 32768;
constexpr size_t O_BASE = O_DD + 1081344;
constexpr size_t O_W2IN = O_BASE;
constexpr size_t O_WMRG = O_W2IN + 25165824;
constexpr size_t O_WOUT = O_WMRG + 16777216;
constexpr size_t O_H = O_WOUT + 8388608;
constexpr size_t O_XR = O_H + 69206016;
constexpr size_t O_QA = O_XR + 33554432;
constexpr size_t O_KA = O_QA + 67108864;
constexpr size_t O_VAT = O_KA + 17301504;
constexpr size_t O_KB = O_VAT + 17301504;
constexpr size_t O_QB = O_KB + 34603008;
constexpr size_t O_VBT = O_QB + 33554432;
constexpr size_t O_LR = O_VBT + 69206016;
constexpr size_t O_QF = O_LR + 2162688;
constexpr size_t O_KT = O_QF + 33554432;
constexpr size_t O_MIXEND = O_KT + 69206016;
constexpr size_t O_OF = O_QA;
constexpr size_t O_GA = O_QB;
constexpr size_t O_M = O_QA;
constexpr size_t O_WUP = O_BASE;
constexpr size_t O_WDN = O_WUP + 46137344;
constexpr size_t O_H2 = O_WDN + 23068672;
constexpr size_t O_U = O_H2 + 67108864;

struct P {
    const float *x, *c, *ctx, *c_ctx, *w_mod, *b_mod, *g_mix, *w_in, *q_norm, *k_norm, *sink, *wgf, *bgf, *wgb, *bgb, *gla_norm,
        *w_attn_o, *w_gla_o, *w_out, *g_ffn, *w_up, *conv_w, *conv_b, *w_down;
    float* out;
    unsigned char* ws;
    long long o_act;
    int ns[4];
    int nsmax, pad;
};

typedef __bf16 bf16x2_t __attribute__((ext_vector_type(2)));
__device__ __forceinline__ unsigned cvt_pk_bf16(float lo, float hi) { const f32x2 v = {lo, hi}; const bf16x2_t b = __builtin_convertvector(v, bf16x2_t); return __builtin_bit_cast(unsigned, b); }
__device__ __forceinline__ float bf2f(unsigned short b) { return __uint_as_float(((unsigned)b) << 16); }
__device__ __forceinline__ float bflo(unsigned u) { return __uint_as_float(u << 16); }
__device__ __forceinline__ float bfhi(unsigned u) { return __uint_as_float(u & 0xffff0000u); }
__device__ __forceinline__ bf16_t f2bf(float f) { return (bf16_t)(cvt_pk_bf16(f, 0.f) & 0xffffu); }
__device__ __forceinline__ float wave_sum(float v) {
#pragma unroll
    for (int o = 32; o >= 1; o >>= 1) v += __shfl_xor(v, o);
    return v;
}
__device__ __forceinline__ float sigmoidf_(float x) { return 1.0f / (1.0f + __expf(-x)); }
__device__ __forceinline__ float siluf_(float x) { return x / (1.0f + __expf(-x)); }
__device__ __forceinline__ void unpack8(const u32x4 v, float* f) {
    f[0] = bflo(v.x); f[1] = bfhi(v.x); f[2] = bflo(v.y); f[3] = bfhi(v.y); f[4] = bflo(v.z); f[5] = bfhi(v.z); f[6] = bflo(v.w); f[7] = bfhi(v.w);
}
__device__ __forceinline__ u32x4 pack8(const float* f) {
    u32x4 w; w.x = cvt_pk_bf16(f[0], f[1]); w.y = cvt_pk_bf16(f[2], f[3]); w.z = cvt_pk_bf16(f[4], f[5]); w.w = cvt_pk_bf16(f[6], f[7]); return w;
}
__device__ __forceinline__ int opaque0() { int z; asm volatile("v_mov_b32 %0, 0" : "=v"(z)); return z; }
#define MFMA16(a, b, c) __builtin_amdgcn_mfma_f32_16x16x32_bf16((a), (b), (c), 0, 0, 0)

namespace pg8 {
constexpr int BM = 256, BK = 64, HALF = 128, HTB = HALF * BK * 2, STAGE_BYTES = 8 * HTB, NXCD = 8, WGM = 8;
__device__ __forceinline__ int lds_byte(int r, int c) { const int st = (r >> 4) * 2 + (c >> 5), rr = r & 15, cc = c & 31, ob = rr * 64 + cc * 2; return st * 1024 + (ob ^ (((ob >> 9) & 1) << 5)); }
__device__ __forceinline__ void stage_rc(int b, int& R, int& C) { const int st = b / 1024, sb = b % 1024, swz = sb ^ (((sb >> 9) & 1) << 5); R = (st >> 1) * 16 + swz / 64; C = (st & 1) * 32 + (swz % 64) / 2; }
__device__ __forceinline__ int perm32(int rho) { const int n = rho >> 4, i = rho & 15; return 8 * (i >> 2) + 4 * n + (i & 3); }

struct Unit { const char* A; const char* B; char* out; int ldc; int kind; int row0; int col0; };

__device__ __forceinline__ void rect_map(int L, int nM, int nN, int& pm, int& pn) {
    const int nwg = nM * nN; int wgid = L;
    { const int q = nwg / NXCD, r = nwg % NXCD, xcd = wgid % NXCD, off = wgid / NXCD; wgid = (xcd < r ? xcd * (q + 1) : r * (q + 1) + (xcd - r) * q) + off; }
    const int nig = WGM * nN, gid = wgid / nig, fm = gid * WGM, gsz = (nM - fm) < WGM ? (nM - fm) : WGM;
    pm = fm + ((wgid % nig) % gsz); pn = (wgid % nig) / gsz;
}

template <class Epi, class Sched>
__device__ __forceinline__ void gemm_phase(LAS unsigned char* lds, const int K, const Sched& S, const Epi& E) {
    const int tid = threadIdx.x + opaque0(), wid = __builtin_amdgcn_readfirstlane(tid >> 6), lane = tid & 63, wr = wid >> 2, wc = wid & 3, fr = lane & 15, fq = lane >> 4;
    const int nt = K / BK;
    unsigned voffA[2], voffB[2];
#pragma unroll
    for (int i = 0; i < 2; ++i) { int R, C; stage_rc(tid * 16 + i * 8192, R, C); const int Rb = (R & ~31) + perm32(R & 31);
        voffA[i] = (unsigned)(R * K + C) * 2u; voffB[i] = (unsigned)(Rb * K + C) * 2u; }
    const size_t kstep = (size_t)(BK * 2);
    const size_t hstep = (size_t)HALF * K * 2;
    const unsigned ldsw = (unsigned)wid * 1024u;
    const int aoff = lds_byte(wr * 64 + fr, fq * 8), boff = lds_byte(wc * 32 + fr, fq * 8);
#define PG8_SA(b, h) (((b) * 2 + (h)) * HTB)
#define PG8_SB(b, h) ((4 + (b) * 2 + (h)) * HTB)
#define PG8_STAGE(bufoff, gbase, voff) do { _Pragma("unroll") for (int _i = 0; _i < 2; ++_i) \
        __builtin_amdgcn_global_load_lds((const unsigned*)((const char*)(gbase) + (voff)[_i]), (LAS unsigned*)(lds + (bufoff) + ldsw + _i * 8192), 16, 0, 0); } while (0)
#define PG8_LDA(dst, b, h) do { _Pragma("unroll") for (int m = 0; m < 4; ++m) _Pragma("unroll") for (int k = 0; k < 2; ++k) dst[m][k] = *(const LAS bf16x8*)(lds + PG8_SA(b, h) + aoff + m * 2048 + k * 1024); } while (0)
#define PG8_LDB(dst, b, h) do { _Pragma("unroll") for (int n = 0; n < 2; ++n) _Pragma("unroll") for (int k = 0; k < 2; ++k) dst[n][k] = *(const LAS bf16x8*)(lds + PG8_SB(b, h) + boff + n * 2048 + k * 1024); } while (0)
#define PG8_MMA(ai, bj, At, Bt) do { __builtin_amdgcn_s_setprio(1); _Pragma("unroll") for (int m = 0; m < 4; ++m) _Pragma("unroll") for (int n = 0; n < 2; ++n) _Pragma("unroll") for (int k = 0; k < 2; ++k) \
        acc[ai][bj][m][n] = __builtin_amdgcn_mfma_f32_16x16x32_bf16(Bt[n][k], At[m][k], acc[ai][bj][m][n], 0, 0, 0); __builtin_amdgcn_s_setprio(0); } while (0)
#define PG8_WAIT_V(n) asm volatile("s_waitcnt vmcnt(" #n ")" ::: "memory")
#define PG8_WAIT_L(n) asm volatile("s_waitcnt lgkmcnt(" #n ")" ::: "memory")
#define PG8_BAR __builtin_amdgcn_s_barrier()
#define PG8_SCHED __builtin_amdgcn_sched_barrier(0)
    Unit cur, nxt; int ui = 0;
    if (!S.next(0, cur)) return;
    f32x4 acc[2][2][4][2];
#pragma unroll
    for (int a = 0; a < 2; ++a)
#pragma unroll
        for (int b = 0; b < 2; ++b)
#pragma unroll
            for (int m = 0; m < 4; ++m)
#pragma unroll
                for (int n = 0; n < 2; ++n) acc[a][b][m][n] = (f32x4){0.f, 0.f, 0.f, 0.f};
    bf16x8 At[4][2], B0[2][2], B1[2][2];
    const char* cA = cur.A; const char* cB = cur.B;
    PG8_STAGE(PG8_SB(0, 0), cB, voffB); PG8_STAGE(PG8_SA(0, 0), cA, voffA); PG8_STAGE(PG8_SB(0, 1), cB + hstep, voffB); PG8_STAGE(PG8_SA(0, 1), cA + hstep, voffA);
    if (wr == 1) PG8_BAR;
    PG8_WAIT_V(4); PG8_BAR;
    PG8_STAGE(PG8_SB(1, 0), cB + kstep, voffB); PG8_STAGE(PG8_SA(1, 0), cA + kstep, voffA); PG8_STAGE(PG8_SB(1, 1), cB + hstep + kstep, voffB);
    PG8_WAIT_V(6); PG8_BAR;
    for (;;) {
        const bool has_next = S.next(ui + 1, nxt);
        const char* nA = has_next ? nxt.A : cA; const char* nB = has_next ? nxt.B : cB;
        for (int t = 0; t < nt; t += 2) {
            const bool last = (t == nt - 2);
            if constexpr (Epi::MID) { if (t == (nt >> 1)) E.mid(acc, cur, wr, wc, fr, fq); }
            const char* a1 = cA + (size_t)(t + 1) * kstep;
            const char* a2 = last ? nA : cA + (size_t)(t + 2) * kstep; const char* b2 = last ? nB : cB + (size_t)(t + 2) * kstep;
            const char* a3 = a2 + kstep; const char* b3 = b2 + kstep;
            PG8_LDB(B0, 0, 0); PG8_SCHED; PG8_LDA(At, 0, 0); PG8_STAGE(PG8_SA(1, 1), a1 + hstep, voffA);
            PG8_WAIT_L(8); PG8_BAR; PG8_WAIT_L(0); PG8_MMA(0, 0, At, B0); PG8_BAR; PG8_SCHED;
            PG8_LDB(B1, 0, 1); PG8_STAGE(PG8_SB(0, 0), b2, voffB);
            PG8_BAR; PG8_WAIT_L(0); PG8_MMA(0, 1, At, B1); PG8_BAR;
            PG8_LDA(At, 0, 1); PG8_STAGE(PG8_SA(0, 0), a2, voffA);
            PG8_BAR; PG8_WAIT_L(0); PG8_MMA(1, 0, At, B0); PG8_BAR; PG8_SCHED;
            PG8_STAGE(PG8_SB(0, 1), b2 + hstep, voffB);
            PG8_WAIT_V(6); PG8_BAR; PG8_MMA(1, 1, At, B1); PG8_BAR;
            PG8_LDB(B0, 1, 0); PG8_SCHED; PG8_LDA(At, 1, 0); PG8_STAGE(PG8_SA(0, 1), a2 + hstep, voffA);
            PG8_WAIT_L(8); PG8_BAR; PG8_WAIT_L(0); PG8_MMA(0, 0, At, B0); PG8_BAR; PG8_SCHED;
            PG8_LDB(B1, 1, 1); PG8_STAGE(PG8_SB(1, 0), b3, voffB);
            PG8_BAR; PG8_WAIT_L(0); PG8_MMA(0, 1, At, B1); PG8_BAR;
            PG8_LDA(At, 1, 1); PG8_STAGE(PG8_SA(1, 0), a3, voffA);
            PG8_BAR; PG8_WAIT_L(0); PG8_MMA(1, 0, At, B0); PG8_BAR; PG8_SCHED;
            PG8_STAGE(PG8_SB(1, 1), b3 + hstep, voffB);
            PG8_WAIT_V(6); PG8_BAR; PG8_MMA(1, 1, At, B1); PG8_BAR;
        }
        E(acc, cur, wr, wc, fr, fq);
        if (!has_next) break;
#pragma unroll
        for (int a = 0; a < 2; ++a)
#pragma unroll
            for (int b = 0; b < 2; ++b)
#pragma unroll
                for (int m = 0; m < 4; ++m)
#pragma unroll
                    for (int n = 0; n < 2; ++n) acc[a][b][m][n] = (f32x4){0.f, 0.f, 0.f, 0.f};
        cur = nxt; cA = nA; cB = nB; ++ui;
    }
    PG8_WAIT_V(0);
    if (wr == 0) PG8_BAR;
    PG8_BAR;
#undef PG8_SA
#undef PG8_SB
#undef PG8_STAGE
#undef PG8_LDA
#undef PG8_LDB
#undef PG8_MMA
#undef PG8_WAIT_V
#undef PG8_WAIT_L
#undef PG8_BAR
#undef PG8_SCHED
}
}
using pg8::Unit;
typedef f32x4 Acc[2][2][4][2];

__device__ __forceinline__ void store_tile_bf16(const Acc& acc, const Unit& u, int wr, int wc, int fr, int fq) {
    bf16_t* base = (bf16_t*)u.out + (size_t)(wr * 64 + fr) * u.ldc + wc * 32 + 8 * fq;
#pragma unroll
    for (int ai = 0; ai < 2; ++ai)
#pragma unroll
        for (int m = 0; m < 4; ++m) {
            bf16_t* rowp = base + (size_t)(ai * 128 + m * 16) * u.ldc;
#pragma unroll
            for (int bj = 0; bj < 2; ++bj) {
                const f32x4 v0 = acc[ai][bj][m][0], v1 = acc[ai][bj][m][1];
                u32x4 w; w.x = cvt_pk_bf16(v0[0], v0[1]); w.y = cvt_pk_bf16(v0[2], v0[3]); w.z = cvt_pk_bf16(v1[0], v1[1]); w.w = cvt_pk_bf16(v1[2], v1[3]);
                *(u32x4*)(rowp + bj * 128) = w;
            }
        }
}

struct SchedProj1 {
    const char* h; const char* w; unsigned char* ws; int G, c;
    __device__ bool next(int i, Unit& u) const {
        const int L = i * G + c; int pm, pn;
        if (L < 64 * 29) pg8::rect_map(L, 64, 29, pm, pn);
        else { const int e = L - 64 * 29; if (e >= 34) return false; pm = 64 + e / 17; const int q = e % 17; pn = q < 4 ? 8 + q : (q < 16 ? 12 + q : 28); }
        const char* ha = h + (size_t)pm * 256 * DM * 2; const char* wa = w + (size_t)pn * 256 * DM * 2;
        u.A = ha; u.B = wa; u.kind = 0; u.row0 = pm * 256; u.col0 = pn * 256;
        if (pn < 8) { u.out = (char*)(ws + O_QA) + ((size_t)pm * 256 * 2048 + pn * 256) * 2; u.ldc = 2048; }
        else if (pn < 10) { u.out = (char*)(ws + O_KA) + ((size_t)pm * 256 * 512 + (pn - 8) * 256) * 2; u.ldc = 512; }
        else if (pn < 12) { u.A = wa; u.B = ha; u.out = (char*)(ws + O_VAT) + ((size_t)(pn - 10) * 256 * NROW + pm * 256) * 2; u.ldc = NROW; }
        else if (pn < 16) { u.out = (char*)(ws + O_QB) + ((size_t)pm * 256 * 1024 + (pn - 12) * 256) * 2; u.ldc = 1024; }
        else if (pn < 20) { u.out = (char*)(ws + O_KB) + ((size_t)pm * 256 * 1024 + (pn - 16) * 256) * 2; u.ldc = 1024; }
        else if (pn < 28) { u.A = wa; u.B = ha; u.out = (char*)(ws + O_VBT) + ((size_t)(pn - 20) * 256 * NROW + pm * 256) * 2; u.ldc = NROW; }
        else { u.kind = 1; u.out = (char*)(ws + O_LR) + (size_t)pm * 256 * 32 * 4; u.ldc = 32; }
        return true;
    }
};
struct EpiProj1 {
    static constexpr bool MID = false;
    __device__ __forceinline__ void mid(Acc&, const Unit&, int, int, int, int) const {}
    __device__ __forceinline__ void operator()(const Acc& acc, const Unit& u, int wr, int wc, int fr, int fq) const {
        if (u.kind == 0) { store_tile_bf16(acc, u, wr, wc, fr, fq); return; }
        if (wc == 0) {
            float* base = (float*)u.out + (size_t)(wr * 64 + fr) * 32 + 8 * fq;
#pragma unroll
            for (int ai = 0; ai < 2; ++ai)
#pragma unroll
                for (int m = 0; m < 4; ++m) { float* rowp = base + (size_t)(ai * 128 + m * 16) * 32; *(f32x4*)rowp = acc[ai][0][m][0]; *(f32x4*)(rowp + 4) = acc[ai][0][m][1]; }
        }
    }
};
struct SchedProj2 {
    const char* h; const char* w; unsigned char* ws; bf16_t* cc; int G, c;
    __device__ bool next(int i, Unit& u) const {
        const int L = i * G + c; if (L >= 64 * 24) return false; int pm, pn; pg8::rect_map(L, 64, 24, pm, pn);
        u.A = h + (size_t)pm * 256 * DM * 2; u.B = w + (size_t)pn * 256 * DM * 2; u.row0 = pm * 256; u.col0 = pn * 256;
        if (pn < 8) { u.kind = 2; u.out = (char*)(cc + (size_t)pm * 256 * 4096 + 2048 + pn * 256); u.ldc = 4096; }
        else if (pn < 16) { u.kind = 0; u.out = (char*)(ws + O_GA) + ((size_t)pm * 256 * 2048 + (pn - 8) * 256) * 2; u.ldc = 2048; }
        else { u.kind = 0; u.out = (char*)(ws + O_GA + 67108864) + ((size_t)pm * 256 * 2048 + (pn - 16) * 256) * 2; u.ldc = 2048; }
        return true;
    }
};
struct EpiProj2 {
    static constexpr bool MID = false;
    __device__ __forceinline__ void mid(Acc&, const Unit&, int, int, int, int) const {}
    __device__ __forceinline__ void operator()(const Acc& acc, const Unit& u, int wr, int wc, int fr, int fq) const {
        if (u.kind == 0) { store_tile_bf16(acc, u, wr, wc, fr, fq); return; }
        bf16_t* base = (bf16_t*)u.out + (size_t)(wr * 64 + fr) * u.ldc + wc * 32 + 8 * fq;
#pragma unroll
        for (int ai = 0; ai < 2; ++ai)
#pragma unroll
            for (int m = 0; m < 4; ++m) {
                bf16_t* rowp = base + (size_t)(ai * 128 + m * 16) * u.ldc;
#pragma unroll
                for (int bj = 0; bj < 2; ++bj) {
                    const f32x4 v0 = acc[ai][bj][m][0], v1 = acc[ai][bj][m][1];
                    float y[8]; unpack8(*(const u32x4*)(rowp + bj * 128), y);
                    y[0] *= siluf_(v0[0]); y[1] *= siluf_(v0[1]); y[2] *= siluf_(v0[2]); y[3] *= siluf_(v0[3]);
                    y[4] *= siluf_(v1[0]); y[5] *= siluf_(v1[1]); y[6] *= siluf_(v1[2]); y[7] *= siluf_(v1[3]);
                    *(u32x4*)(rowp + bj * 128) = pack8(y);
                }
            }
    }
};
struct SchedMerge {
    const char* a; const char* w; unsigned char* ws; int G, c;
    __device__ bool next(int i, Unit& u) const {
        const int L = i * G + c; if (L >= 64 * 8) return false; int pm, pn; pg8::rect_map(L, 64, 8, pm, pn);
        u.A = a + (size_t)pm * 256 * 4096 * 2; u.B = w + (size_t)pn * 256 * 4096 * 2; u.row0 = pm * 256; u.col0 = pn * 256; u.kind = 0;
        u.out = (char*)(ws + O_M) + ((size_t)pm * 256 * 2048 + pn * 256) * 2; u.ldc = 2048; return true;
    }
};
struct EpiMerge {
    static constexpr bool MID = true;
    const bf16_t* ga; const bf16_t* gb;
    __device__ __forceinline__ void mid(Acc& acc, const Unit& u, int wr, int wc, int fr, int fq) const {
        const unsigned lo = (unsigned)(((wr * 64 + fr) * 2048 + wc * 32 + 8 * fq) * 2 + opaque0());
#pragma unroll
        for (int ai = 0; ai < 2; ++ai)
#pragma unroll
            for (int m = 0; m < 4; ++m)
#pragma unroll
                for (int bj = 0; bj < 2; ++bj) {
                    const size_t ub = ((size_t)(u.row0 + ai * 128 + m * 16) * 2048 + u.col0 + bj * 128) * 2;
                    float a[8], b[8]; unpack8(*(const u32x4*)((const char*)ga + ub + lo), a); unpack8(*(const u32x4*)((const char*)gb + ub + lo), b);
#pragma unroll
                    for (int e = 0; e < 8; ++e) { const float r = (1.0f + __expf(-b[e])) / (1.0f + __expf(-a[e])); acc[ai][bj][m][e >> 2][e & 3] *= r; }
                    __builtin_amdgcn_sched_barrier(0);
                }
    }
    __device__ __forceinline__ void operator()(const Acc& acc, const Unit& u, int wr, int wc, int fr, int fq) const {
        const unsigned lo = (unsigned)(((wr * 64 + fr) * 2048 + wc * 32 + 8 * fq) * 2 + opaque0());
        char* outp = (char*)u.out - ((size_t)u.row0 * 2048 + u.col0) * 2;
#pragma unroll
        for (int ai = 0; ai < 2; ++ai)
#pragma unroll
            for (int m = 0; m < 4; ++m)
#pragma unroll
                for (int bj = 0; bj < 2; ++bj) {
                    const size_t ub = ((size_t)(u.row0 + ai * 128 + m * 16) * 2048 + u.col0 + bj * 128) * 2;
                    float b[8], y[8]; unpack8(*(const u32x4*)((const char*)gb + ub + lo), b);
#pragma unroll
                    for (int e = 0; e < 8; ++e) y[e] = acc[ai][bj][m][e >> 2][e & 3] * sigmoidf_(b[e]);
                    *(u32x4*)(outp + ub + lo) = pack8(y);
                    __builtin_amdgcn_sched_barrier(0);
                }
    }
};
struct SchedRes {
    const char* a; const char* w; int K, G, c;
    __device__ bool next(int i, Unit& u) const {
        const int L = i * G + c; if (L >= 64 * 8) return false; int pm, pn; pg8::rect_map(L, 64, 8, pm, pn);
        u.A = a + (size_t)pm * 256 * K * 2; u.B = w + (size_t)pn * 256 * K * 2; u.row0 = pm * 256; u.col0 = pn * 256; u.kind = 0; u.out = nullptr; u.ldc = 2048; return true;
    }
};
struct EpiRes {
    static constexpr bool MID = false;
    const float* base; float* out; const float* gate;
    __device__ __forceinline__ void mid(Acc&, const Unit&, int, int, int, int) const {}
    __device__ __forceinline__ void operator()(const Acc& acc, const Unit& u, int wr, int wc, int fr, int fq) const {
        const int col = u.col0 + wc * 32 + 8 * fq;
        const float* gp = gate + (size_t)(u.row0 >> 13) * 12288 + col;
        f32x4 g[2][2];
#pragma unroll
        for (int bj = 0; bj < 2; ++bj) { g[bj][0] = *(const f32x4*)(gp + bj * 128); g[bj][1] = *(const f32x4*)(gp + bj * 128 + 4); }
        const size_t o0 = (size_t)(u.row0 + wr * 64 + fr) * 2048 + col;
#pragma unroll
        for (int ai = 0; ai < 2; ++ai)
#pragma unroll
            for (int m = 0; m < 4; ++m)
#pragma unroll
                for (int bj = 0; bj < 2; ++bj) {
                    const size_t o = o0 + (size_t)(ai * 128 + m * 16) * 2048 + bj * 128;
                    const f32x4 x0 = *(const f32x4*)(base + o), x1 = *(const f32x4*)(base + o + 4);
                    *(f32x4*)(out + o) = x0 + g[bj][0] * acc[ai][bj][m][0];
                    *(f32x4*)(out + o + 4) = x1 + g[bj][1] * acc[ai][bj][m][1];
                }
    }
};
struct SchedUp {
    const char* a; const char* w; char* uo; int j0, ns, ldu, G, c;
    __device__ bool next(int i, Unit& u) const {
        const int L = i * G + c; if (L >= 64 * ns) return false; int pm, pn; pg8::rect_map(L, 64, ns, pm, pn);
        u.A = a + (size_t)pm * 256 * DM * 2; u.B = w + (size_t)(j0 + pn) * 256 * DM * 2; u.row0 = pm * 256; u.col0 = pn * 256; u.kind = 0;
        u.out = uo + ((size_t)pm * 256 * ldu + pn * 256) * 2; u.ldc = ldu; return true;
    }
};
struct EpiStore {
    static constexpr bool MID = false;
    __device__ __forceinline__ void mid(Acc&, const Unit&, int, int, int, int) const {}
    __device__ __forceinline__ void operator()(const Acc& acc, const Unit& u, int wr, int wc, int fr, int fq) const { store_tile_bf16(acc, u, wr, wc, fr, fq); }
};

__device__ __forceinline__ int srccol(int kind, int n) {
    if (kind == 0) return n;
    if (kind == 1) return n < 7168 ? n : (n < 7200 ? n + 2048 : -1);
    if (kind == 2) return n < 2048 ? 7168 + n : 9248 + (n - 2048);
    const int j = n >> 8, i = n & 255; return i < 128 ? 128 * j + i : 5632 + 128 * j + (i - 128);
}
__device__ void transpose_tile(LAS float* tl, const float* __restrict__ src, int ld_src, bf16_t* dst, int ld_dst, int k0, int n0, int kind, int koff) {
    const int tid = threadIdx.x + opaque0();
    { const int kr = tid >> 4, nq = (tid & 15) * 4; const int sc = srccol(kind, n0 + nq);
#pragma unroll
      for (int pass = 0; pass < 2; ++pass) { const int k = kr + 32 * pass;
          f32x4 v = (f32x4){0.f, 0.f, 0.f, 0.f}; if (sc >= 0) v = *(const f32x4*)(src + (size_t)(k0 + k) * ld_src + sc);
          tl[(nq + 0) * 65 + k] = v[0]; tl[(nq + 1) * 65 + k] = v[1]; tl[(nq + 2) * 65 + k] = v[2]; tl[(nq + 3) * 65 + k] = v[3]; } }
    __syncthreads();
    { const int n = tid >> 3, kc = (tid & 7) * 8; float f[8];
#pragma unroll
      for (int e = 0; e < 8; ++e) f[e] = tl[n * 65 + kc + e];
      *(u32x4*)(dst + (size_t)(n0 + n) * ld_dst + koff + k0 + kc) = pack8(f); }
    __syncthreads();
}
__device__ void transpose_job(LAS float* tl, const float* src, int ld_src, bf16_t* dst, int ld_dst, int K, int N, int kind, int koff, int it) {
    const int nnt = N / 64; const int kt = it / nnt, ntl = it % nnt; (void)K;
    transpose_tile(tl, src, ld_src, dst, ld_dst, kt * 64, ntl * 64, kind, koff);
}

__device__ void phase0(LAS unsigned char* lds, const P& p) {
    LAS float* tl = (LAS float*)lds;
    unsigned char* ws = p.ws;
    const int nb = gridDim.x, bid = blockIdx.x, tid = threadIdx.x + opaque0();
    for (int it = bid; it < 256; it += nb) {
        const int kc = it >> 3, nch = it & 7; float a[3][3];
#pragma unroll
        for (int v = 0; v < 3; ++v)
#pragma unroll
            for (int j = 0; j < 3; ++j) a[v][j] = 0.f;
        for (int k = kc * 64; k < kc * 64 + 64; ++k) {
            const float s0 = siluf_(p.c[k]), s1 = siluf_(p.c[2048 + k]), s2 = siluf_(p.c_ctx[k]);
            const float* wr = p.w_mod + (size_t)k * 12288 + nch * 1536 + tid;
#pragma unroll
            for (int j = 0; j < 3; ++j) { const float w = wr[j * 512]; a[0][j] += s0 * w; a[1][j] += s1 * w; a[2][j] += s2 * w; }
        }
        float* mp = (float*)(ws + O_MODP) + (size_t)kc * 3 * 12288 + nch * 1536 + tid;
#pragma unroll
        for (int v = 0; v < 3; ++v)
#pragma unroll
            for (int j = 0; j < 3; ++j) mp[(size_t)v * 12288 + j * 512] = a[v][j];
    }
    for (int i = bid * 512 + tid; i < 128 * 32; i += nb * 512) {
        const int pos = i >> 5, f = i & 31;
        const float inv = exp2f(-(float)f * (13.287712379549449f / 32.0f));
        const float ang = (float)pos * inv;
        const double ad = (double)ang; const double n = rint(ad * 0.15915494309189535); double r = ad - n * 6.283185307179586476925;
        r *= 0.125; const double r2 = r * r;
        double s = r * (1.0 + r2 * (-1.0 / 6 + r2 * (1.0 / 120 + r2 * (-1.0 / 5040 + r2 * (1.0 / 362880 + r2 * (-1.0 / 39916800))))));
        double c = 1.0 + r2 * (-0.5 + r2 * (1.0 / 24 + r2 * (-1.0 / 720 + r2 * (1.0 / 40320 + r2 * (-1.0 / 3628800 + r2 * (1.0 / 479001600))))));
#pragma unroll
        for (int q = 0; q < 3; ++q) { const double s2 = 2.0 * s * c, c2 = c * c - s * s; s = s2; c = c2; }
        ((f32x2*)(ws + O_ROPE))[i] = (f32x2){(float)c, (float)s};
    }
    const int J0 = 32 * 116, J1 = 32 * 96, J2 = 1024, J3 = 1024, J4 = 1024;
    for (int it = bid; it < J0 + J1 + J2 + J3 + J4; it += nb) {
        int q = it;
        if (q < J0) { transpose_job(tl, p.w_in, 13344, (bf16_t*)(ws + O_XR), 2048, 2048, 7424, 1, 0, q); continue; } q -= J0;
        if (q < J1) { transpose_job(tl, p.w_in, 13344, (bf16_t*)(ws + O_W2IN), 2048, 2048, 6144, 2, 0, q); continue; } q -= J1;
        if (q < J2) { transpose_job(tl, p.w_attn_o, 2048, (bf16_t*)(ws + O_WMRG), 4096, 2048, 2048, 0, 0, q); continue; } q -= J2;
        if (q < J3) { transpose_job(tl, p.w_gla_o, 2048, (bf16_t*)(ws + O_WMRG), 4096, 2048, 2048, 0, 2048, q); continue; } q -= J3;
        transpose_job(tl, p.w_out, 2048, (bf16_t*)(ws + O_WOUT), 2048, 2048, 2048, 0, 0, q);
    }
}
__device__ void phase_modreduce(const P& p) {
    const float* mp = (const float*)(p.ws + O_MODP); float* mod = (float*)(p.ws + O_MOD);
    for (int i = blockIdx.x * 512 + threadIdx.x; i < 3 * 12288; i += gridDim.x * 512) {
        float s = p.b_mod[i % 12288];
        for (int kc = 0; kc < 32; ++kc) s += mp[(size_t)kc * 3 * 12288 + i];
        mod[i] = s;
    }
}
__device__ void phase_modulate(const float* xlat, const float* xctx, const float* g, const float* mod, int sh, int sc, bf16_t* h, int nrows) {
    const int tix = threadIdx.x + opaque0(); const int lane = tix & 63, gw = blockIdx.x * 8 + (tix >> 6), nw = gridDim.x * 8;
    for (int r = gw; r < nrows; r += nw) {
        const float* xr = r < NTOK ? xlat + (size_t)r * DM : xctx + (size_t)(r - NTOK) * DM;
        const float* mv = mod + (size_t)(r < NTOK ? (r >> 13) : 2) * 12288;
        f32x4 v[8]; float ss = 0.f;
#pragma unroll
        for (int i = 0; i < 8; ++i) { v[i] = *(const f32x4*)(xr + (i * 64 + lane) * 4); ss += v[i][0] * v[i][0] + v[i][1] * v[i][1] + v[i][2] * v[i][2] + v[i][3] * v[i][3]; }
        ss = wave_sum(ss); const float rs = rsqrtf(ss * (1.0f / DM) + EPS_);
#pragma unroll
        for (int i = 0; i < 8; ++i) { const int cidx = (i * 64 + lane) * 4;
            const f32x4 gg = *(const f32x4*)(g + cidx), s1 = *(const f32x4*)(mv + sc * 2048 + cidx), s0 = *(const f32x4*)(mv + sh * 2048 + cidx);
            const f32x4 y = v[i] * rs * gg * (s1 + 1.0f) + s0;
            u32x2 w; w.x = cvt_pk_bf16(y[0], y[1]); w.y = cvt_pk_bf16(y[2], y[3]); *(u32x2*)(h + (size_t)r * DM + cidx) = w; }
    }
}

__device__ __forceinline__ void normrope8x4(float (&y)[4][8], const float* nw, int dofs, float rs, bool rope, int t, const f32x2* tab) {
#pragma unroll
    for (int s = 0; s < 4; ++s) { const f32x4 w0 = *(const f32x4*)(nw + s * 32 + dofs), w1 = *(const f32x4*)(nw + s * 32 + dofs + 4);
#pragma unroll
        for (int e = 0; e < 4; ++e) { y[s][e] *= rs * w0[e]; y[s][4 + e] *= rs * w1[e]; } }
    if (rope) {
#pragma unroll
        for (int s = 0; s < 2; ++s) { const int pos = s == 0 ? (t >> 6) : (t & 63); const f32x2* tp = tab + pos * 32 + dofs;
#pragma unroll
            for (int e = 0; e < 8; ++e) { const f32x2 cs = tp[e]; const float x1 = y[s][e], x2 = y[s + 2][e]; y[s][e] = x1 * cs.x - x2 * cs.y; y[s + 2][e] = x2 * cs.x + x1 * cs.y; } }
    }
}
__device__ void attn_item(LAS unsigned char* lds, const P& p, bf16_t* cc, int item) {
    const int tid = threadIdx.x + opaque0(), w = __builtin_amdgcn_readfirstlane(tid >> 6), lane = tid & 63, fr = lane & 15, fq = lane >> 4;
    const int pair = item & 1, kvh = (item >> 1) & 3, qb = (item >> 3) & 63, b = item >> 9;
    LAS bf16_t* Ks = (LAS bf16_t*)lds; LAS bf16_t* Vs = Ks + 128 * 136; LAS bf16_t* Ps = Vs + 128 * 136 + w * (32 * 136);
    const bf16_t* QA = (const bf16_t*)(p.ws + O_QA); const bf16_t* KA = (const bf16_t*)(p.ws + O_KA); const bf16_t* VAT = (const bf16_t*)(p.ws + O_VAT);
    const f32x2* tab = (const f32x2*)(p.ws + O_ROPE);
    const int hq = kvh * 4 + pair * 2 + (w >> 2), rc = w & 3, qrow0 = qb * 128 + rc * 32;
    const float SC = 0.08838834764831845f * 1.4426950408889634f;
    bf16x8 qf[2][4];
#pragma unroll
    for (int mt = 0; mt < 2; ++mt) {
        const int t = qrow0 + mt * 16 + fr; const bf16_t* src = QA + (size_t)(b * T_ + t) * 2048 + hq * 128 + fq * 8;
        float y[4][8]; float ss = 0.f;
#pragma unroll
        for (int s = 0; s < 4; ++s) { unpack8(*(const u32x4*)(src + s * 32), y[s]);
#pragma unroll
            for (int e = 0; e < 8; ++e) ss += y[s][e] * y[s][e]; }
        ss += __shfl_xor(ss, 16); ss += __shfl_xor(ss, 32);
        const float rs = rsqrtf(ss * (1.0f / 128) + EPS_);
        normrope8x4(y, p.q_norm, fq * 8, rs, true, t, tab);
#pragma unroll
        for (int s = 0; s < 4; ++s) {
#pragma unroll
            for (int e = 0; e < 8; ++e) y[s][e] *= SC;
            const u32x4 pk = pack8(y[s]); qf[mt][s] = *(const bf16x8*)&pk; }
    }
    f32x4 o[2][8];
#pragma unroll
    for (int mt = 0; mt < 2; ++mt)
#pragma unroll
        for (int n = 0; n < 8; ++n) o[mt][n] = (f32x4){0.f, 0.f, 0.f, 0.f};
    float mrun[2][4], lrun[2][4];
    { const float sk = p.sink[hq] * 1.4426950408889634f;
#pragma unroll
      for (int mt = 0; mt < 2; ++mt)
#pragma unroll
          for (int j = 0; j < 4; ++j) { mrun[mt][j] = sk; lrun[mt][j] = fr == 0 ? 1.0f : 0.0f; } }
    for (int jj = 0; jj < 5; ++jj) {
        int tokbase, mtype = 0, tpos0 = 0; bool lat = jj < 3;
        if (lat) { const int j = qb - 1 + jj; if (j < 0 || j > 63) continue; tokbase = b * T_ + j * 128; tpos0 = j * 128; mtype = jj == 0 ? 1 : (jj == 2 ? 2 : 0); }
        else tokbase = NTOK + b * 256 + (jj - 3) * 128;
        const int mlo = mtype == 1 ? 0 : -100000, mhi = mtype == 2 ? 0 : 100000;
        const int dl = fr - rc * 32 - fq * 4 + opaque0();
        __syncthreads();
        {
            const int key = tid >> 2, part = tid & 3; const bf16_t* src = KA + (size_t)(tokbase + key) * 512 + kvh * 128 + part * 8;
            float y[4][8]; float ss = 0.f;
#pragma unroll
            for (int s = 0; s < 4; ++s) { unpack8(*(const u32x4*)(src + s * 32), y[s]);
#pragma unroll
                for (int e = 0; e < 8; ++e) ss += y[s][e] * y[s][e]; }
            ss += __shfl_xor(ss, 1); ss += __shfl_xor(ss, 2);
            const float rs = rsqrtf(ss * (1.0f / 128) + EPS_);
            normrope8x4(y, p.k_norm, part * 8, rs, lat, tpos0 + key, tab);
#pragma unroll
            for (int s = 0; s < 4; ++s) *(LAS u32x4*)(Ks + key * 136 + s * 32 + part * 8) = pack8(y[s]);
            const bf16_t* vsrc = VAT + (size_t)(kvh * 128 + key) * NROW + tokbase + part * 8;
#pragma unroll
            for (int s = 0; s < 4; ++s) *(LAS u32x4*)(Vs + key * 136 + s * 32 + part * 8) = *(const u32x4*)(vsrc + s * 32);
        }
        __syncthreads();
#pragma unroll
        for (int mt = 0; mt < 2; ++mt) {
            f32x4 sacc[8];
#pragma unroll
            for (int n = 0; n < 8; ++n) sacc[n] = (f32x4){0.f, 0.f, 0.f, 0.f};
#pragma unroll
            for (int s = 0; s < 4; ++s) {
#pragma unroll
                for (int n = 0; n < 8; ++n) { const bf16x8 kf = *(const LAS bf16x8*)(Ks + (n * 16 + fr) * 136 + s * 32 + fq * 8); sacc[n] = MFMA16(qf[mt][s], kf, sacc[n]); }
                __builtin_amdgcn_sched_barrier(0); }
#pragma unroll
            for (int j = 0; j < 4; ++j) {
                float mx = -INFINITY;
#pragma unroll
                for (int n = 0; n < 8; ++n) { const int dkq = dl + (n * 16 - mt * 16 - j); float v = sacc[n][j];
                    if (dkq < mlo || dkq > mhi) v = -INFINITY; sacc[n][j] = v; mx = fmaxf(mx, v); }
                mx = fmaxf(mx, __shfl_xor(mx, 1)); mx = fmaxf(mx, __shfl_xor(mx, 2)); mx = fmaxf(mx, __shfl_xor(mx, 4)); mx = fmaxf(mx, __shfl_xor(mx, 8));
                const float mn = fmaxf(mrun[mt][j], mx), al = exp2f(mrun[mt][j] - mn); mrun[mt][j] = mn;
                float ps = 0.f;
#pragma unroll
                for (int n = 0; n < 8; ++n) { const float pv = exp2f(sacc[n][j] - mn); ps += pv; o[mt][n][j] *= al;
                    Ps[(mt * 16 + fq * 4 + j) * 136 + n * 16 + fr] = f2bf(pv); }
                lrun[mt][j] = lrun[mt][j] * al + ps;
            }
            __builtin_amdgcn_sched_barrier(0);
        }
        __syncthreads();
#pragma unroll
        for (int s = 0; s < 4; ++s) {
            const bf16x8 p0 = *(const LAS bf16x8*)(Ps + fr * 136 + s * 32 + fq * 8), p1 = *(const LAS bf16x8*)(Ps + (16 + fr) * 136 + s * 32 + fq * 8);
#pragma unroll
            for (int n = 0; n < 8; ++n) { const bf16x8 vf = *(const LAS bf16x8*)(Vs + (n * 16 + fr) * 136 + s * 32 + fq * 8);
                o[0][n] = MFMA16(p0, vf, o[0][n]); o[1][n] = MFMA16(p1, vf, o[1][n]); }
            __builtin_amdgcn_sched_barrier(0);
        }
    }
#pragma unroll
    for (int mt = 0; mt < 2; ++mt)
#pragma unroll
        for (int j = 0; j < 4; ++j) {
            float l = lrun[mt][j]; l += __shfl_xor(l, 1); l += __shfl_xor(l, 2); l += __shfl_xor(l, 4); l += __shfl_xor(l, 8);
            const float inv = 1.0f / l; bf16_t* dst = cc + (size_t)(b * T_ + qrow0 + mt * 16 + fq * 4 + j) * 4096 + hq * 128 + fr;
#pragma unroll
            for (int n = 0; n < 8; ++n) dst[n * 16] = f2bf(o[mt][n][j] * inv);
        }
}

__device__ void glaprep_item(LAS unsigned char* lds, const P& p, int item) {
    const int tid = threadIdx.x + opaque0(), w = __builtin_amdgcn_readfirstlane(tid >> 6), lane = tid & 63, fr = lane & 15, fq = lane >> 4;
    const int ck = item % 66, h = (item / 66) & 3, b = item / 264;
    const bool lat = ck < 64; const int r0 = lat ? b * T_ + ck * 128 : NTOK + b * 256 + (ck - 64) * 128;
    LAS bf16_t* Qs = (LAS bf16_t*)lds; LAS bf16_t* Ks = Qs + 128 * 264; LAS float* lrs = (LAS float*)(lds + 2 * 128 * 264 * 2); LAS float* seg = lrs + 128 * 32;
    unsigned char* ws = p.ws;
    bf16_t* QB = (bf16_t*)(ws + O_QB); bf16_t* QF = (bf16_t*)(ws + O_QF); const bf16_t* KB = (const bf16_t*)(ws + O_KB);
    __syncthreads();
    { const f32x4* src = (const f32x4*)((const float*)(ws + O_LR) + (size_t)r0 * 32); ((LAS f32x4*)lrs)[tid] = src[tid]; ((LAS f32x4*)lrs)[tid + 512] = src[tid + 512]; }
    const int half = tid >> 8, d = tid & 255, gc = h * 256 + d;
    for (int dir = 0; dir < 2; ++dir) {
        const int chain = dir * 8 + b * 4 + h;
        const float* wg = dir == 0 ? p.wgf : p.wgb; const float bias = (dir == 0 ? p.bgf : p.bgb)[gc];
        float wv[16];
#pragma unroll
        for (int j = 0; j < 16; ++j) wv[j] = wg[j * 1024 + gc];
        __syncthreads();
        float carry = 0.f;
        bf16_t* qdst = dir == 0 ? QF : QB;
#pragma unroll 1
        for (int rnd = 0; rnd < 2; ++rnd) {
            float bl[32]; float run = 0.f;
            const int ibase = rnd * 64 + half * 32;
#pragma unroll
            for (int ii = 0; ii < 32; ++ii) {
                const int i = ibase + ii, tok = dir == 0 ? i : 127 - i;
                const LAS f32x4* lp = (const LAS f32x4*)(lrs + tok * 32 + dir * 16);
                float xg = bias;
#pragma unroll
                for (int q = 0; q < 4; ++q) { const f32x4 l4 = lp[q]; xg += l4[0] * wv[q * 4] + l4[1] * wv[q * 4 + 1] + l4[2] * wv[q * 4 + 2] + l4[3] * wv[q * 4 + 3]; }
                const float ls = fminf(xg, 0.f) - __logf(1.0f + __expf(-fabsf(xg)));
                run += ls * 0.0625f; bl[ii] = run;
            }
            __syncthreads();
            seg[half * 256 + d] = run;
            __syncthreads();
            const float s0 = seg[d], s1 = seg[256 + d];
            const float off = carry + (half == 1 ? s0 : 0.f);
            carry += s0 + s1;
#pragma unroll
            for (int ii = 0; ii < 32; ++ii) {
                const int i = ibase + ii, tok = dir == 0 ? i : 127 - i;
                const float bb = bl[ii] + off; const float eb = __expf(bb), ieb = __expf(-bb);
                const size_t gi = (size_t)(r0 + tok) * 1024 + gc;
                Ks[tok * 264 + d] = f2bf(bf2f(KB[gi]) * ieb);
                if (lat) { const bf16_t qv = f2bf(bf2f(QB[gi]) * 0.0625f * eb); Qs[tok * 264 + d] = qv; qdst[gi] = qv; }
                if ((ii & 7) == 7) __builtin_amdgcn_sched_barrier(0);
            }
        }
        if (half == 1) ((float*)(ws + O_DD))[((size_t)chain * 66 + ck) * 256 + d] = __expf(carry);
        __syncthreads();
        if (lat) {
            f32x4 a[8];
#pragma unroll
            for (int n = 0; n < 8; ++n) a[n] = (f32x4){0.f, 0.f, 0.f, 0.f};
#pragma unroll
            for (int s = 0; s < 8; ++s) { const bf16x8 qfr = *(const LAS bf16x8*)(Qs + (16 * w + fr) * 264 + s * 32 + fq * 8);
#pragma unroll
                for (int n = 0; n < 8; ++n) { const bf16x8 kfr = *(const LAS bf16x8*)(Ks + (n * 16 + fr) * 264 + s * 32 + fq * 8); a[n] = MFMA16(kfr, qfr, a[n]); }
                __builtin_amdgcn_sched_barrier(0); }
            bf16_t* ab = (bf16_t*)(ws + O_XR) + ((size_t)(chain * 64 + ck) * 128 + 16 * w + fr) * 128;
            const int cmr = (fq * 4 - 16 * w - fr + opaque0()) * (dir == 0 ? 1 : -1);
#pragma unroll
            for (int n = 0; n < 8; ++n) { float v[4];
#pragma unroll
                for (int j = 0; j < 4; ++j) { const int dcr = cmr + (dir == 0 ? (n * 16 + j) : -(n * 16 + j)); v[j] = dcr <= 0 ? a[n][j] : 0.f; }
                u32x2 pk; pk.x = cvt_pk_bf16(v[0], v[1]); pk.y = cvt_pk_bf16(v[2], v[3]); *(u32x2*)(ab + n * 16 + fq * 4) = pk; }
        }
        {
            bf16_t* kt = (bf16_t*)(ws + O_KT) + ((size_t)dir * 1024 + (size_t)gc) * NROW + r0;
#pragma unroll
            for (int it = 0; it < 8; ++it) { const int tc = it * 2 + half; unsigned short e[8];
#pragma unroll
                for (int q = 0; q < 8; ++q) e[q] = Ks[(tc * 8 + q) * 264 + d];
                u32x4 pk; pk.x = e[0] | ((unsigned)e[1] << 16); pk.y = e[2] | ((unsigned)e[3] << 16); pk.z = e[4] | ((unsigned)e[5] << 16); pk.w = e[6] | ((unsigned)e[7] << 16);
                *(u32x4*)(kt + tc * 8) = pk; }
        }
    }
}

__device__ void glaseq_item(LAS unsigned char* lds, const P& p, int item) {
    const int tid = threadIdx.x + opaque0(), w = __builtin_amdgcn_readfirstlane(tid >> 6), lane = tid & 63, fr = lane & 15, fq = lane >> 4;
    const int chain = item & 15, sl = item >> 4, dir = chain >> 3, b = (chain >> 2) & 1, h = chain & 3;
    unsigned char* ws = p.ws;
    LAS bf16_t* Ss = (LAS bf16_t*)lds;
    const bf16_t* VBT = (const bf16_t*)(ws + O_VBT) + (size_t)(h * 512 + sl * 32 + fr) * NROW + fq * 8;
    const bf16_t* KT = (const bf16_t*)(ws + O_KT) + ((size_t)dir * 1024 + h * 256 + 32 * w + fr) * NROW + fq * 8;
    const bf16_t* QT = (const bf16_t*)(ws + (dir == 0 ? O_QF : O_QB));
    const bf16_t* AB = (const bf16_t*)(ws + O_XR) + (size_t)chain * 64 * 128 * 128;
    const float* DD = (const float*)(ws + O_DD) + (size_t)chain * 66 * 256 + 32 * w + fq * 4;
    bf16_t* OB = (bf16_t*)(ws + O_OF) + (size_t)dir * NTOK * 2048;
    f32x4 st[2][2];
#pragma unroll
    for (int t = 0; t < 2; ++t)
#pragma unroll
        for (int n = 0; n < 2; ++n) st[t][n] = (f32x4){0.f, 0.f, 0.f, 0.f};
    for (int s = 0; s < 66; ++s) {
        const int ck = dir == 0 ? (s < 2 ? 64 + s : s - 2) : (s < 2 ? 65 - s : 65 - s);
        const bool lat = s >= 2;
        const int r0 = lat ? b * T_ + ck * 128 : NTOK + b * 256 + (ck - 64) * 128;
        bf16x8 vf[2][4], kf[2][4]; f32x4 dd[2];
#pragma unroll
        for (int n = 0; n < 2; ++n)
#pragma unroll
            for (int q = 0; q < 4; ++q) { vf[n][q] = *(const bf16x8*)(VBT + (size_t)n * 16 * NROW + r0 + q * 32); kf[n][q] = *(const bf16x8*)(KT + (size_t)n * 16 * NROW + r0 + q * 32); }
        dd[0] = *(const f32x4*)(DD + (size_t)ck * 256); dd[1] = *(const f32x4*)(DD + (size_t)ck * 256 + 16);
        if (lat) {
            __syncthreads();
#pragma unroll
            for (int t = 0; t < 2; ++t)
#pragma unroll
                for (int n = 0; n < 2; ++n) { u32x2 pk; pk.x = cvt_pk_bf16(st[t][n][0], st[t][n][1]); pk.y = cvt_pk_bf16(st[t][n][2], st[t][n][3]);
                    *(LAS u32x2*)(Ss + (n * 16 + fr) * 264 + 32 * w + t * 16 + fq * 4) = pk; }
            __syncthreads();
            f32x4 oo[2] = {(f32x4){0.f, 0.f, 0.f, 0.f}, (f32x4){0.f, 0.f, 0.f, 0.f}};
            const bf16_t* qp = QT + (size_t)(r0 + 16 * w + fr) * 1024 + h * 256 + fq * 8;
#pragma unroll
            for (int q = 0; q < 8; ++q) { const bf16x8 qfr = *(const bf16x8*)(qp + q * 32);
#pragma unroll
                for (int n = 0; n < 2; ++n) { const bf16x8 sf = *(const LAS bf16x8*)(Ss + (n * 16 + fr) * 264 + q * 32 + fq * 8); oo[n] = MFMA16(sf, qfr, oo[n]); } }
            const bf16_t* ap = AB + ((size_t)ck * 128 + 16 * w + fr) * 128 + fq * 8;
#pragma unroll
            for (int q = 0; q < 4; ++q) { const bf16x8 af = *(const bf16x8*)(ap + q * 32);
#pragma unroll
                for (int n = 0; n < 2; ++n) oo[n] = MFMA16(vf[n][q], af, oo[n]); }
            bf16_t* op = OB + (size_t)(r0 + 16 * w + fr) * 2048 + h * 512 + sl * 32 + fq * 4;
#pragma unroll
            for (int n = 0; n < 2; ++n) { u32x2 pk; pk.x = cvt_pk_bf16(oo[n][0], oo[n][1]); pk.y = cvt_pk_bf16(oo[n][2], oo[n][3]); *(u32x2*)(op + n * 16) = pk; }
        }
#pragma unroll
        for (int t = 0; t < 2; ++t)
#pragma unroll
            for (int n = 0; n < 2; ++n) { f32x4 tmp = st[t][n];
#pragma unroll
                for (int q = 0; q < 4; ++q) tmp = MFMA16(kf[t][q], vf[n][q], tmp);
                st[t][n] = tmp * dd[t]; }
    }
}

__device__ void phase_glafinal(const P& p, bf16_t* cc) {
    const int tix = threadIdx.x + opaque0(); const int lane = tix & 63, gw = blockIdx.x * 8 + (tix >> 6), nw = gridDim.x * 8;
    const bf16_t* OF = (const bf16_t*)(p.ws + O_OF); const bf16_t* OBk = OF + (size_t)NTOK * 2048;
    f32x4 g0 = *(const f32x4*)(p.gla_norm + lane * 8), g1 = *(const f32x4*)(p.gla_norm + lane * 8 + 4);
    for (int i = gw; i < NTOK * 4; i += nw) {
        const size_t o = (size_t)i * 512 + lane * 8;
        float a[8], c[8]; unpack8(*(const u32x4*)(OF + o), a); unpack8(*(const u32x4*)(OBk + o), c);
        float ss = 0.f;
#pragma unroll
        for (int e = 0; e < 8; ++e) { a[e] += c[e]; ss += a[e] * a[e]; }
        ss = wave_sum(ss); const float rs = rsqrtf(ss * (1.0f / 512) + EPS_);
#pragma unroll
        for (int e = 0; e < 4; ++e) { a[e] *= rs * g0[e]; a[4 + e] *= rs * g1[e]; }
        const int r = i >> 2, hh = i & 3;
        *(u32x4*)(cc + (size_t)r * 4096 + 2048 + hh * 512 + lane * 8) = pack8(a);
    }
}

__device__ void phase_conv(const P& p, const bf16_t* U, int ldu, int j0, int ns, bf16_t* act) {
    const int ncg = ns * 16, ntask = 256 * ncg;
    for (int task = blockIdx.x * 512 + threadIdx.x + opaque0(); task < ntask; task += gridDim.x * 512) {
        const int run = task / ncg, cgi = task % ncg, jl = cgi >> 4, i8 = (cgi & 15) * 8;
        const int ch = 128 * (j0 + jl) + i8; const int ucol = jl * 256 + i8;
        float wa[3][8], wg[3][8], ba[8], bg[8];
#pragma unroll
        for (int j = 0; j < 3; ++j)
#pragma unroll
            for (int e = 0; e < 8; ++e) { wa[j][e] = p.conv_w[j * 11264 + ch + e]; wg[j][e] = p.conv_w[j * 11264 + 5632 + ch + e]; }
#pragma unroll
        for (int e = 0; e < 8; ++e) { ba[e] = p.conv_b[ch + e]; bg[e] = p.conv_b[5632 + ch + e]; }
        const int rw0 = run * 64; const int tl0 = rw0 & (T_ - 1);
        float pa[8], pg[8], ca[8], cg_[8], na[8], ng[8];
        const bf16_t* up = U + (size_t)rw0 * ldu + ucol;
        if (tl0 > 0) { unpack8(*(const u32x4*)(up - ldu), pa); unpack8(*(const u32x4*)(up - ldu + 128), pg); }
        else {
#pragma unroll
            for (int e = 0; e < 8; ++e) { pa[e] = 0.f; pg[e] = 0.f; } }
        unpack8(*(const u32x4*)(up), ca); unpack8(*(const u32x4*)(up + 128), cg_);
        for (int i = 0; i < 64; ++i) {
            const bool has_next = (tl0 + i + 1) < T_;
            if (has_next) { unpack8(*(const u32x4*)(up + (size_t)(i + 1) * ldu), na); unpack8(*(const u32x4*)(up + (size_t)(i + 1) * ldu + 128), ng); }
            else {
#pragma unroll
                for (int e = 0; e < 8; ++e) { na[e] = 0.f; ng[e] = 0.f; } }
            float y[8];
#pragma unroll
            for (int e = 0; e < 8; ++e) { const float av = wa[0][e] * pa[e] + wa[1][e] * ca[e] + wa[2][e] * na[e] + ba[e]; const float gv = wg[0][e] * pg[e] + wg[1][e] * cg_[e] + wg[2][e] * ng[e] + bg[e];
                y[e] = siluf_(av) * gv; pa[e] = ca[e]; pg[e] = cg_[e]; ca[e] = na[e]; cg_[e] = ng[e]; }
            *(u32x4*)(act + (size_t)(rw0 + i) * 5632 + ch) = pack8(y);
        }
    }
}


#ifdef DBG_STOP
__device__ void dbg_dump(cg::grid_group& grid, const P& p, const bf16_t* src, size_t ld, int rows, int cols) {
    bf16_t* tmp = (bf16_t*)(p.ws + O_MIXEND);
    grid.sync();
    const size_t n = (size_t)rows * cols;
    for (size_t i = (size_t)blockIdx.x * 512 + threadIdx.x; i < n; i += (size_t)gridDim.x * 512) tmp[i] = src[(i / cols) * ld + (i % cols)];
    grid.sync();
    for (size_t i = (size_t)blockIdx.x * 512 + threadIdx.x; i < (size_t)NTOK * DM; i += (size_t)gridDim.x * 512) {
        const size_t r = i / DM, c = i % DM; p.out[i] = (r < (size_t)rows && c < (size_t)cols) ? bf2f(tmp[r * cols + c]) : 0.f; }
}
#define DBG_AT(k, src, ld, rows, cols) if (DBG_STOP == k) { dbg_dump(grid, p, (const bf16_t*)(src), ld, rows, cols); return; }
#else
#define DBG_AT(k, src, ld, rows, cols)
#endif

#ifdef DBG_STOP
__device__ void dbg_nancount(cg::grid_group& grid, const P& p, const bf16_t* src, size_t n, int mode) {
    unsigned* cnt = (unsigned*)(p.ws + O_MIXEND);
    grid.sync();
    if (blockIdx.x == 0 && threadIdx.x == 0) { cnt[0] = 0; cnt[1] = 0; }
    grid.sync();
    unsigned c = 0; float mx = 0.f;
    for (size_t i = (size_t)blockIdx.x * 512 + threadIdx.x; i < n; i += (size_t)gridDim.x * 512) { const unsigned short v = src[i]; if ((v & 0x7f80) == 0x7f80) ++c; else mx = fmaxf(mx, fabsf(bf2f(v))); }
    if (c) atomicAdd(cnt, c);
    atomicMax(cnt + 1, __float_as_uint(mx));
    grid.sync();
    for (size_t i = (size_t)blockIdx.x * 512 + threadIdx.x; i < (size_t)NTOK * DM; i += (size_t)gridDim.x * 512) p.out[i] = 0.f;
    grid.sync();
    if (blockIdx.x == 0 && threadIdx.x == 0) p.out[0] = mode == 0 ? (float)cnt[0] : __uint_as_float(cnt[1]);
}
#define DBG_NAN(k, src, n) if (DBG_STOP == k) { dbg_nancount(grid, p, (const bf16_t*)(src), n, 0); return; } if (DBG_STOP == k + 100) { dbg_nancount(grid, p, (const bf16_t*)(src), n, 1); return; }
#else
#define DBG_NAN(k, src, n)
#endif
__global__ void __launch_bounds__(512) fwd_megakernel(P p) {
    extern __shared__ __attribute__((aligned(16))) unsigned char shm[];
    LAS unsigned char* lds = (LAS unsigned char*)shm;
    cg::grid_group grid = cg::this_grid();
    unsigned char* ws = p.ws; const int nb = gridDim.x, bid = blockIdx.x;
    float* mod = (float*)(ws + O_MOD);
    bf16_t* cc = (bf16_t*)p.out;

#ifndef PHMASK
#define PHMASK 0xffff
#endif
    if (PHMASK & 1) phase0(lds, p);
    grid.sync();
    if (PHMASK & 1) phase_modreduce(p);
    grid.sync();
    if (PHMASK & 1) phase_modulate(p.x, p.ctx, p.g_mix, mod, 0, 1, (bf16_t*)(ws + O_H), NROW);
    grid.sync();
    if (PHMASK & 2) { SchedProj1 S{(const char*)(ws + O_H), (const char*)(ws + O_XR), ws, nb, bid}; EpiProj1 E; pg8::gemm_phase(lds, 2048, S, E); }
    grid.sync();
    DBG_AT(1, ws + O_QA, 2048, 8192, 2048)
    DBG_AT(2, ws + O_VBT, NROW, 2048, 2048)
    DBG_AT(11, ws + O_H, 2048, 8192, 2048)
    DBG_AT(12, ws + O_KB, 1024, 8192, 1024)
    if (PHMASK & 4) for (int it = bid; it < 1024; it += nb) attn_item(lds, p, cc, it);
    if (PHMASK & 8) for (int it = nb - 1 - bid; it < 528; it += nb) glaprep_item(lds, p, it);
    grid.sync();
    DBG_AT(3, cc, 4096, 8192, 2048)
    DBG_AT(4, ws + O_QF, 1024, 8192, 1024)
    DBG_AT(5, ws + O_XR, 2048, 8192, 2048)
    DBG_AT(6, ws + O_KT, NROW, 2048, 2048)
    DBG_AT(13, ws + O_QB, 1024, 8192, 1024)
#if defined(DBG_STOP) && DBG_STOP == 16
    { grid.sync(); for (size_t i = (size_t)bid * 512 + threadIdx.x; i < (size_t)NTOK * DM; i += (size_t)nb * 512) p.out[i] = i < 270336 ? ((const float*)(ws + O_DD))[i] : 0.f; return; }
#endif
    if (PHMASK & 16) for (int it = bid; it < 256; it += nb) glaseq_item(lds, p, it);
    grid.sync();
    DBG_AT(7, ws + O_OF, 2048, 8192, 2048)
    DBG_NAN(20, ws + O_OF, (size_t)2 * NTOK * 2048)
    DBG_NAN(21, ws + O_KT, (size_t)2 * 1024 * NROW)
    DBG_AT(14, ws + O_OF + 67108864, 2048, 8192, 2048)
    if (PHMASK & 32) phase_glafinal(p, cc);
    grid.sync();
    DBG_AT(8, cc + 2048, 4096, 8192, 2048)
    if (PHMASK & 64) { SchedProj2 S{(const char*)(ws + O_H), (const char*)(ws + O_W2IN), ws, cc, nb, bid}; EpiProj2 E; pg8::gemm_phase(lds, 2048, S, E); }
    grid.sync();
    DBG_AT(9, ws + O_GA, 2048, 8192, 2048)
    DBG_AT(15, cc + 2048, 4096, 8192, 2048)
    if (PHMASK & 128) { SchedMerge S{(const char*)cc, (const char*)(ws + O_WMRG), ws, nb, bid}; EpiMerge E{(const bf16_t*)(ws + O_GA), (const bf16_t*)(ws + O_GA + 67108864)}; pg8::gemm_phase(lds, 4096, S, E); }
    grid.sync();
    DBG_AT(10, ws + O_M, 2048, 8192, 2048)
    if (PHMASK & 256) { SchedRes S{(const char*)(ws + O_M), (const char*)(ws + O_WOUT), 2048, nb, bid}; EpiRes E{p.x, p.out, mod + 2 * 2048}; pg8::gemm_phase(lds, 2048, S, E); }
    grid.sync();
#ifdef DBG_STOP_WOUT
    return;
#endif
    if (PHMASK & 512) phase_modulate(p.out, p.out, p.g_ffn, mod, 3, 4, (bf16_t*)(ws + O_H2), NTOK);
    if (PHMASK & 512) { LAS float* tl = (LAS float*)lds; const int J5 = 32 * 176, J6 = 88 * 32;
      for (int it = bid; it < J5 + J6; it += nb) {
          if (it < J5) transpose_job(tl, p.w_up, 11264, (bf16_t*)(ws + O_WUP), 2048, 2048, 11264, 3, 0, it);
          else transpose_job(tl, p.w_down, 2048, (bf16_t*)(ws + O_WDN), 5632, 5632, 2048, 0, 0, it - J5); } }
    grid.sync();
    { int j0 = 0; const int ldu = p.nsmax * 256;
      for (int si = 0; si < 4 && p.ns[si] > 0; ++si) {
          const int ns = p.ns[si];
          if (PHMASK & 1024) { SchedUp S{(const char*)(ws + O_H2), (const char*)(ws + O_WUP), (char*)(ws + O_U), j0, ns, ldu, nb, bid}; EpiStore E; pg8::gemm_phase(lds, 2048, S, E); }
          grid.sync();
          if (PHMASK & 2048) phase_conv(p, (const bf16_t*)(ws + O_U), ldu, j0, ns, (bf16_t*)(ws + p.o_act));
          grid.sync();
          j0 += ns; } }
    if (PHMASK & 4096) { SchedRes S{(const char*)(ws + p.o_act), (const char*)(ws + O_WDN), 5632, nb, bid}; EpiRes E{p.out, p.out, mod + 5 * 2048}; pg8::gemm_phase(lds, 5632, S, E); }
#ifdef DBG_COPYX
    grid.sync();
    for (size_t i = (size_t)bid * 512 + threadIdx.x; i < (size_t)NTOK * DM / 4; i += (size_t)nb * 512) ((f32x4*)p.out)[i] = ((const f32x4*)p.x)[i];
#endif
}

extern "C" void kernel_launch(void* const* d_in, const int* in_sizes, int n_in, void* d_out, int out_size, void* d_ws, size_t ws_size, hipStream_t stream) {
    static int grid_blocks = 0;
    if (grid_blocks == 0) {
        int dev = 0, cus = 0, per_cu = 0;
        hipGetDevice(&dev); hipDeviceGetAttribute(&cus, hipDeviceAttributeMultiprocessorCount, dev);
        if (hipFuncSetAttribute((const void*)fwd_megakernel, hipFuncAttributeMaxDynamicSharedMemorySize, LDS_BYTES) != hipSuccess) { fprintf(stderr, "kernel_launch: hipFuncSetAttribute failed\n"); grid_blocks = -1; return; }
        if (hipOccupancyMaxActiveBlocksPerMultiprocessor(&per_cu, (const void*)fwd_megakernel, 512, LDS_BYTES) != hipSuccess || per_cu < 1) { fprintf(stderr, "kernel_launch: occupancy query gave %d\n", per_cu); per_cu = 1; }
        (void)hipGetLastError();
        grid_blocks = cus * 1;
    }
    if (grid_blocks < 0) return;
    P p{};
    const float** f = (const float**)&p;
    for (int i = 0; i < 24; ++i) f[i] = (const float*)d_in[i];
    p.out = (float*)d_out; p.ws = (unsigned char*)d_ws;
    const size_t act_bytes = 184549376;
    if (ws_size >= O_U + (size_t)24 * 256 * NTOK * 2 + act_bytes) { p.ns[0] = 20; p.ns[1] = 24; p.ns[2] = 0; p.nsmax = 24; }
    else { p.ns[0] = 16; p.ns[1] = 16; p.ns[2] = 12; p.ns[3] = 0; p.nsmax = 16; }
    p.o_act = (long long)(O_U + (size_t)p.nsmax * 256 * NTOK * 2);
    if (ws_size < (size_t)p.o_act + act_bytes || ws_size < O_MIXEND) { fprintf(stderr, "kernel_launch: workspace too small (%zu)\n", ws_size); return; }
    void* args[] = {&p};
    hipError_t e = hipLaunchCooperativeKernel((void*)fwd_megakernel, dim3(grid_blocks), dim3(512), args, LDS_BYTES, stream);
    if (e != hipSuccess) fprintf(stderr, "cooperative launch failed: %s (grid %d)\n", hipGetErrorString(e), grid_blocks);
}
```

```cpp
#include <hip/hip_runtime.h>
#include <hip/hip_cooperative_groups.h>
#include <cstdio>
namespace cg = cooperative_groups;

#define LAS __attribute__((address_space(3)))
typedef unsigned short bf16_t;
typedef short bf16x8 __attribute__((ext_vector_type(8)));
typedef float f32x4 __attribute__((ext_vector_type(4)));
typedef float f32x2 __attribute__((ext_vector_type(2)));
typedef unsigned u32x4 __attribute__((ext_vector_type(4)));
typedef unsigned u32x2 __attribute__((ext_vector_type(2)));

constexpr int T_ = 8192, NTOK = 16384, NROW = 16896, DM = 2048;
constexpr int LDS_BYTES = 153600;
constexpr float EPS_ = 1e-6f;

constexpr size_t O_MODP = 0;
constexpr size_t O_MOD = O_MODP + 4718592;
constexpr size_t O_ROPE = O_MOD + 147456;
constexpr size_t O_DD = O_ROPE + 32768;
constexpr size_t O_BASE = O_DD + 1081344;
constexpr size_t O_W2IN = O_BASE;
constexpr size_t O_WMRG = O_W2IN + 25165824;
constexpr size_t O_WOUT = O_WMRG + 16777216;
constexpr size_t O_H = O_WOUT + 8388608;
constexpr size_t O_XR = O_H + 69206016;
constexpr size_t O_QA = O_XR + 33554432;
constexpr size_t O_KA = O_QA + 67108864;
constexpr size_t O_VAT = O_KA + 17301504;
constexpr size_t O_KB = O_VAT + 17301504;
constexpr size_t O_QB = O_KB + 34603008;
constexpr size_t O_VBT = O_QB + 33554432;
constexpr size_t O_LR = O_VBT + 69206016;
constexpr size_t O_QF = O_LR + 2162688;
constexpr size_t O_KT = O_QF + 33554432;
constexpr size_t O_MIXEND = O_KT + 69206016;
constexpr size_t O_OF = O_QA;
constexpr size_t O_GA = O_QB;
constexpr size_t O_M = O_QA;
constexpr size_t O_WUP = O_BASE;
constexpr size_t O_WDN = O_WUP + 46137344;
constexpr size_t O_H2 = O_WDN + 23068672;
constexpr size_t O_U = O_H2 + 67108864;

struct P {
    const float *x, *c, *ctx, *c_ctx, *w_mod, *b_mod, *g_mix, *w_in, *q_norm, *k_norm, *sink, *wgf, *bgf, *wgb, *bgb, *gla_norm,
        *w_attn_o, *w_gla_o, *w_out, *g_ffn, *w_up, *conv_w, *conv_b, *w_down;
    float* out;
    unsigned char* ws;
    long long o_act;
    int ns[4];
    int nsmax, pad;
};

typedef __bf16 bf16x2_t __attribute__((ext_vector_type(2)));
__device__ __forceinline__ unsigned cvt_pk_bf16(float lo, float hi) { const f32x2 v = {lo, hi}; const bf16x2_t b = __builtin_convertvector(v, bf16x2_t); return __builtin_bit_cast(unsigned, b); }
__device__ __forceinline__ float bf2f(unsigned short b) { return __uint_as_float(((unsigned)b) << 16); }
__device__ __forceinline__ float bflo(unsigned u) { return __uint_as_float(u << 16); }
__device__ __forceinline__ float bfhi(unsigned u) { return __uint_as_float(u & 0xffff0000u); }
__device__ __forceinline__ bf16_t f2bf(float f) { return (bf16_t)(cvt_pk_bf16(f, 0.f) & 0xffffu); }
__device__ __forceinline__ float wave_sum(float v) {
#pragma unroll
    for (int o = 32; o >= 1; o >>= 1) v += __shfl_xor(v, o);
    return v;
}
__device__ __forceinline__ float sigmoidf_(float x) { return 1.0f / (1.0f + __expf(-x)); }
__device__ __forceinline__ float siluf_(float x) { return x / (1.0f + __expf(-x)); }
__device__ __forceinline__ void unpack8(const u32x4 v, float* f) {
    f[0] = bflo(v.x); f[1] = bfhi(v.x); f[2] = bflo(v.y); f[3] = bfhi(v.y); f[4] = bflo(v.z); f[5] = bfhi(v.z); f[6] = bflo(v.w); f[7] = bfhi(v.w);
}
__device__ __forceinline__ u32x4 pack8(const float* f) {
    u32x4 w; w.x = cvt_pk_bf16(f[0], f[1]); w.y = cvt_pk_bf16(f[2], f[3]); w.z = cvt_pk_bf16(f[4], f[5]); w.w = cvt_pk_bf16(f[6], f[7]); return w;
}
__device__ __forceinline__ int opaque0() { int z; asm volatile("v_mov_b32 %0, 0" : "=v"(z)); return z; }
#define MFMA16(a, b, c) __builtin_amdgcn_mfma_f32_16x16x32_bf16((a), (b), (c), 0, 0, 0)

namespace pg8 {
constexpr int BM = 256, BK = 64, HALF = 128, HTB = HALF * BK * 2, STAGE_BYTES = 8 * HTB, NXCD = 8, WGM = 8;
__device__ __forceinline__ int lds_byte(int r, int c) { const int st = (r >> 4) * 2 + (c >> 5), rr = r & 15, cc = c & 31, ob = rr * 64 + cc * 2; return st * 1024 + (ob ^ (((ob >> 9) & 1) << 5)); }
__device__ __forceinline__ void stage_rc(int b, int& R, int& C) { const int st = b / 1024, sb = b % 1024, swz = sb ^ (((sb >> 9) & 1) << 5); R = (st >> 1) * 16 + swz / 64; C = (st & 1) * 32 + (swz % 64) / 2; }
__device__ __forceinline__ int perm32(int rho) { const int n = rho >> 4, i = rho & 15; return 8 * (i >> 2) + 4 * n + (i & 3); }

struct Unit { const char* A; const char* B; char* out; int ldc; int kind; int row0; int col0; };

__device__ __forceinline__ void rect_map(int L, int nM, int nN, int& pm, int& pn) {
    const int nwg = nM * nN; int wgid = L;
    { const int q = nwg / NXCD, r = nwg % NXCD, xcd = wgid % NXCD, off = wgid / NXCD; wgid = (xcd < r ? xcd * (q + 1) : r * (q + 1) + (xcd - r) * q) + off; }
    const int nig = WGM * nN, gid = wgid / nig, fm = gid * WGM, gsz = (nM - fm) < WGM ? (nM - fm) : WGM;
    pm = fm + ((wgid % nig) % gsz); pn = (wgid % nig) / gsz;
}

template <class Epi, class Sched>
__device__ __forceinline__ void gemm_phase(LAS unsigned char* lds, const int K, const Sched& S, const Epi& E) {
    const int tid = threadIdx.x + opaque0(), wid = __builtin_amdgcn_readfirstlane(tid >> 6), lane = tid & 63, wr = wid >> 2, wc = wid & 3, fr = lane & 15, fq = lane >> 4;
    const int nt = K / BK;
    unsigned voffA[2], voffB[2];
#pragma unroll
    for (int i = 0; i < 2; ++i) { int R, C; stage_rc(tid * 16 + i * 8192, R, C); const int Rb = (R & ~31) + perm32(R & 31);
        voffA[i] = (unsigned)(R * K + C) * 2u; voffB[i] = (unsigned)(Rb * K + C) * 2u; }
    const size_t kstep = (size_t)(BK * 2);
    const size_t hstep = (size_t)HALF * K * 2;
    const unsigned ldsw = (unsigned)wid * 1024u;
    const int aoff = lds_byte(wr * 64 + fr, fq * 8), boff = lds_byte(wc * 32 + fr, fq * 8);
#define PG8_SA(b, h) (((b) * 2 + (h)) * HTB)
#define PG8_SB(b, h) ((4 + (b) * 2 + (h)) * HTB)
#define PG8_STAGE(bufoff, gbase, voff) do { _Pragma("unroll") for (int _i = 0; _i < 2; ++_i) \
        __builtin_amdgcn_global_load_lds((const unsigned*)((const char*)(gbase) + (voff)[_i]), (LAS unsigned*)(lds + (bufoff) + ldsw + _i * 8192), 16, 0, 0); } while (0)
#define PG8_LDA(dst, b, h) do { _Pragma("unroll") for (int m = 0; m < 4; ++m) _Pragma("unroll") for (int k = 0; k < 2; ++k) dst[m][k] = *(const LAS bf16x8*)(lds + PG8_SA(b, h) + aoff + m * 2048 + k * 1024); } while (0)
#define PG8_LDB(dst, b, h) do { _Pragma("unroll") for (int n = 0; n < 2; ++n) _Pragma("unroll") for (int k = 0; k < 2; ++k) dst[n][k] = *(const LAS bf16x8*)(lds + PG8_SB(b, h) + boff + n * 2048 + k * 1024); } while (0)
#define PG8_MMA(ai, bj, At, Bt) do { __builtin_amdgcn_s_setprio(1); _Pragma("unroll") for (int m = 0; m < 4; ++m) _Pragma("unroll") for (int n = 0; n < 2; ++n) _Pragma("unroll") for (int k = 0; k < 2; ++k) \
        acc[ai][bj][m][n] = __builtin_amdgcn_mfma_f32_16x16x32_bf16(Bt[n][k], At[m][k], acc[ai][bj][m][n], 0, 0, 0); __builtin_amdgcn_s_setprio(0); } while (0)
#define PG8_WAIT_V(n) asm volatile("s_waitcnt vmcnt(" #n ")" ::: "memory")
#define PG8_WAIT_L(n) asm volatile("s_waitcnt lgkmcnt(" #n ")" ::: "memory")
#define PG8_BAR __builtin_amdgcn_s_barrier()
#define PG8_SCHED __builtin_amdgcn_sched_barrier(0)
    Unit cur, nxt; int ui = 0;
    if (!S.next(0, cur)) return;
    f32x4 acc[2][2][4][2];
#pragma unroll
    for (int a = 0; a < 2; ++a)
#pragma unroll
        for (int b = 0; b < 2; ++b)
#pragma unroll
            for (int m = 0; m < 4; ++m)
#pragma unroll
                for (int n = 0; n < 2; ++n) acc[a][b][m][n] = (f32x4){0.f, 0.f, 0.f, 0.f};
    bf16x8 At[4][2], B0[2][2], B1[2][2];
    const char* cA = cur.A; const char* cB = cur.B;
    PG8_STAGE(PG8_SB(0, 0), cB, voffB); PG8_STAGE(PG8_SA(0, 0), cA, voffA); PG8_STAGE(PG8_SB(0, 1), cB + hstep, voffB); PG8_STAGE(PG8_SA(0, 1), cA + hstep, voffA);
    if (wr == 1) PG8_BAR;
    PG8_WAIT_V(4); PG8_BAR;
    PG8_STAGE(PG8_SB(1, 0), cB + kstep, voffB); PG8_STAGE(PG8_SA(1, 0), cA + kstep, voffA); PG8_STAGE(PG8_SB(1, 1), cB + hstep + kstep, voffB);
    PG8_WAIT_V(6); PG8_BAR;
    for (;;) {
        const bool has_next = S.next(ui + 1, nxt);
        const char* nA = has_next ? nxt.A : cA; const char* nB = has_next ? nxt.B : cB;
        for (int t = 0; t < nt; t += 2) {
            const bool last = (t == nt - 2);
            if constexpr (Epi::MID) { if (t == (nt >> 1)) E.mid(acc, cur, wr, wc, fr, fq); }
            const char* a1 = cA + (size_t)(t + 1) * kstep;
            const char* a2 = last ? nA : cA + (size_t)(t + 2) * kstep; const char* b2 = last ? nB : cB + (size_t)(t + 2) * kstep;
            const char* a3 = a2 + kstep; const char* b3 = b2 + kstep;
            PG8_LDB(B0, 0, 0); PG8_SCHED; PG8_LDA(At, 0, 0); PG8_STAGE(PG8_SA(1, 1), a1 + hstep, voffA);
            PG8_WAIT_L(8); PG8_BAR; PG8_WAIT_L(0); PG8_MMA(0, 0, At, B0); PG8_BAR; PG8_SCHED;
            PG8_LDB(B1, 0, 1); PG8_STAGE(PG8_SB(0, 0), b2, voffB);
            PG8_BAR; PG8_WAIT_L(0); PG8_MMA(0, 1, At, B1); PG8_BAR;
            PG8_LDA(At, 0, 1); PG8_STAGE(PG8_SA(0, 0), a2, voffA);
            PG8_BAR; PG8_WAIT_L(0); PG8_MMA(1, 0, At, B0); PG8_BAR; PG8_SCHED;
            PG8_STAGE(PG8_SB(0, 1), b2 + hstep, voffB);
            PG8_WAIT_V(6); PG8_BAR; PG8_MMA(1, 1, At, B1); PG8_BAR;
            PG8_LDB(B0, 1, 0); PG8_SCHED; PG8_LDA(At, 1, 0); PG8_STAGE(PG8_SA(0, 1), a2 + hstep, voffA);
            PG8_WAIT_L(8); PG8_BAR; PG8_WAIT_L(0); PG8_MMA(0, 0, At, B0); PG8_BAR; PG8_SCHED;
            PG8_LDB(B1, 1, 1); PG8_STAGE(PG8_SB(1, 0), b3, voffB);
            PG8_BAR; PG8_WAIT_L(0); PG8_MMA(0, 1, At, B1); PG8_BAR;
            PG8_LDA(At, 1, 1); PG8_STAGE(PG8_SA(1, 0), a3, voffA);
            PG8_BAR; PG8_WAIT_L(0); PG8_MMA(1, 0, At, B0); PG8_BAR; PG8_SCHED;
            PG8_STAGE(PG8_SB(1, 1), b3 + hstep, voffB);
            PG8_WAIT_V(6); PG8_BAR; PG8_MMA(1, 1, At, B1); PG8_BAR;
        }
        E(acc, cur, wr, wc, fr, fq);
        if (!has_next) break;
#pragma unroll
        for (int a = 0; a < 2; ++a)
#pragma unroll
            for (int b = 0; b < 2; ++b)
#pragma unroll
                for (int m = 0; m < 4; ++m)
#pragma unroll
                    for (int n = 0; n < 2; ++n) acc[a][b][m][n] = (f32x4){0.f, 0.f, 0.f, 0.f};
        cur = nxt; cA = nA; cB = nB; ++ui;
    }
    PG8_WAIT_V(0);
    if (wr == 0) PG8_BAR;
    PG8_BAR;
#undef PG8_SA
#undef PG8_SB
#undef PG8_STAGE
#undef PG8_LDA
#undef PG8_LDB
#undef PG8_MMA
#undef PG8_WAIT_V
#undef PG8_WAIT_L
#undef PG8_BAR
#undef PG8_SCHED
}
}
using pg8::Unit;
typedef f32x4 Acc[2][2][4][2];

__device__ __forceinline__ void store_tile_bf16(const Acc& acc, const Unit& u, int wr, int wc, int fr, int fq) {
    bf16_t* base = (bf16_t*)u.out + (size_t)(wr * 64 + fr) * u.ldc + wc * 32 + 8 * fq;
#pragma unroll
    for (int ai = 0; ai < 2; ++ai)
#pragma unroll
        for (int m = 0; m < 4; ++m) {
            bf16_t* rowp = base + (size_t)(ai * 128 + m * 16) * u.ldc;
#pragma unroll
            for (int bj = 0; bj < 2; ++bj) {
                const f32x4 v0 = acc[ai][bj][m][0], v1 = acc[ai][bj][m][1];
                u32x4 w; w.x = cvt_pk_bf16(v0[0], v0[1]); w.y = cvt_pk_bf16(v0[2], v0[3]); w.z = cvt_pk_bf16(v1[0], v1[1]); w.w = cvt_pk_bf16(v1[2], v1[3]);
                *(u32x4*)(rowp + bj * 128) = w;
            }
        }
}

struct SchedProj1 {
    const char* h; const char* w; unsigned char* ws; int G, c;
    __device__ bool next(int i, Unit& u) const {
        const int L = i * G + c; int pm, pn;
        if (L < 64 * 29) pg8::rect_map(L, 64, 29, pm, pn);
        else { const int e = L - 64 * 29; if (e >= 34) return false; pm = 64 + e / 17; const int q = e % 17; pn = q < 4 ? 8 + q : (q < 16 ? 12 + q : 28); }
        const char* ha = h + (size_t)pm * 256 * DM * 2; const char* wa = w + (size_t)pn * 256 * DM * 2;
        u.A = ha; u.B = wa; u.kind = 0; u.row0 = pm * 256; u.col0 = pn * 256;
        if (pn < 8) { u.out = (char*)(ws + O_QA) + ((size_t)pm * 256 * 2048 + pn * 256) * 2; u.ldc = 2048; }
        else if (pn < 10) { u.out = (char*)(ws + O_KA) + ((size_t)pm * 256 * 512 + (pn - 8) * 256) * 2; u.ldc = 512; }
        else if (pn < 12) { u.A = wa; u.B = ha; u.out = (char*)(ws + O_VAT) + ((size_t)(pn - 10) * 256 * NROW + pm * 256) * 2; u.ldc = NROW; }
        else if (pn < 16) { u.out = (char*)(ws + O_QB) + ((size_t)pm * 256 * 1024 + (pn - 12) * 256) * 2; u.ldc = 1024; }
        else if (pn < 20) { u.out = (char*)(ws + O_KB) + ((size_t)pm * 256 * 1024 + (pn - 16) * 256) * 2; u.ldc = 1024; }
        else if (pn < 28) { u.A = wa; u.B = ha; u.out = (char*)(ws + O_VBT) + ((size_t)(pn - 20) * 256 * NROW + pm * 256) * 2; u.ldc = NROW; }
        else { u.kind = 1; u.out = (char*)(ws + O_LR) + (size_t)pm * 256 * 32 * 4; u.ldc = 32; }
        return true;
    }
};
struct EpiProj1 {
    static constexpr bool MID = false;
    __device__ __forceinline__ void mid(Acc&, const Unit&, int, int, int, int) const {}
    __device__ __forceinline__ void operator()(const Acc& acc, const Unit& u, int wr, int wc, int fr, int fq) const {
        if (u.kind == 0) { store_tile_bf16(acc, u, wr, wc, fr, fq); return; }
        if (wc == 0) {
            float* base = (float*)u.out + (size_t)(wr * 64 + fr) * 32 + 8 * fq;
#pragma unroll
            for (int ai = 0; ai < 2; ++ai)
#pragma unroll
                for (int m = 0; m < 4; ++m) { float* rowp = base + (size_t)(ai * 128 + m * 16) * 32; *(f32x4*)rowp = acc[ai][0][m][0]; *(f32x4*)(rowp + 4) = acc[ai][0][m][1]; }
        }
    }
};
struct SchedProj2 {
    const char* h; const char* w; unsigned char* ws; bf16_t* cc; int G, c;
    __device__ bool next(int i, Unit& u) const {
        const int L = i * G + c; if (L >= 64 * 24) return false; int pm, pn; pg8::rect_map(L, 64, 24, pm, pn);
        u.A = h + (size_t)pm * 256 * DM * 2; u.B = w + (size_t)pn * 256 * DM * 2; u.row0 = pm * 256; u.col0 = pn * 256;
        if (pn < 8) { u.kind = 2; u.out = (char*)(cc + (size_t)pm * 256 * 4096 + 2048 + pn * 256); u.ldc = 4096; }
        else if (pn < 16) { u.kind = 0; u.out = (char*)(ws + O_GA) + ((size_t)pm * 256 * 2048 + (pn - 8) * 256) * 2; u.ldc = 2048; }
        else { u.kind = 0; u.out = (char*)(ws + O_GA + 67108864) + ((size_t)pm * 256 * 2048 + (pn - 16) * 256) * 2; u.ldc = 2048; }
        return true;
    }
};
struct EpiProj2 {
    static constexpr bool MID = false;
    __device__ __forceinline__ void mid(Acc&, const Unit&, int, int, int, int) const {}
    __device__ __forceinline__ void operator()(const Acc& acc, const Unit& u, int wr, int wc, int fr, int fq) const {
        if (u.kind == 0) { store_tile_bf16(acc, u, wr, wc, fr, fq); return; }
        bf16_t* base = (bf16_t*)u.out + (size_t)(wr * 64 + fr) * u.ldc + wc * 32 + 8 * fq;
#pragma unroll
        for (int ai = 0; ai < 2; ++ai)
#pragma unroll
            for (int m = 0; m < 4; ++m) {
                bf16_t* rowp = base + (size_t)(ai * 128 + m * 16) * u.ldc;
#pragma unroll
                for (int bj = 0; bj < 2; ++bj) {
                    const f32x4 v0 = acc[ai][bj][m][0], v1 = acc[ai][bj][m][1];
                    float y[8]; unpack8(*(const u32x4*)(rowp + bj * 128), y);
                    y[0] *= siluf_(v0[0]); y[1] *= siluf_(v0[1]); y[2] *= siluf_(v0[2]); y[3] *= siluf_(v0[3]);
                    y[4] *= siluf_(v1[0]); y[5] *= siluf_(v1[1]); y[6] *= siluf_(v1[2]); y[7] *= siluf_(v1[3]);
                    *(u32x4*)(rowp + bj * 128) = pack8(y);
                }
            }
    }
};
struct SchedMerge {
    const char* a; const char* w; unsigned char* ws; int G, c;
    __device__ bool next(int i, Unit& u) const {
        const int L = i * G + c; if (L >= 64 * 8) return false; int pm, pn; pg8::rect_map(L, 64, 8, pm, pn);
        u.A = a + (size_t)pm * 256 * 4096 * 2; u.B = w + (size_t)pn * 256 * 4096 * 2; u.row0 = pm * 256; u.col0 = pn * 256; u.kind = 0;
        u.out = (char*)(ws + O_M) + ((size_t)pm * 256 * 2048 + pn * 256) * 2; u.ldc = 2048; return true;
    }
};
struct EpiMerge {
    static constexpr bool MID = true;
    const bf16_t* ga; const bf16_t* gb;
    __device__ __forceinline__ void mid(Acc& acc, const Unit& u, int wr, int wc, int fr, int fq) const {
        const unsigned lo = (unsigned)(((wr * 64 + fr) * 2048 + wc * 32 + 8 * fq) * 2 + opaque0());
#pragma unroll
        for (int ai = 0; ai < 2; ++ai)
#pragma unroll
            for (int m = 0; m < 4; ++m)
#pragma unroll
                for (int bj = 0; bj < 2; ++bj) {
                    const size_t ub = ((size_t)(u.row0 + ai * 128 + m * 16) * 2048 + u.col0 + bj * 128) * 2;
                    float a[8], b[8]; unpack8(*(const u32x4*)((const char*)ga + ub + lo), a); unpack8(*(const u32x4*)((const char*)gb + ub + lo), b);
#pragma unroll
                    for (int e = 0; e < 8; ++e) { const float r = (1.0f + __expf(-b[e])) / (1.0f + __expf(-a[e])); acc[ai][bj][m][e >> 2][e & 3] *= r; }
                    __builtin_amdgcn_sched_barrier(0);
                }
    }
    __device__ __forceinline__ void operator()(const Acc& acc, const Unit& u, int wr, int wc, int fr, int fq) const {
        const unsigned lo = (unsigned)(((wr * 64 + fr) * 2048 + wc * 32 + 8 * fq) * 2 + opaque0());
        char* outp = (char*)u.out - ((size_t)u.row0 * 2048 + u.col0) * 2;
#pragma unroll
        for (int ai = 0; ai < 2; ++ai)
#pragma unroll
            for (int m = 0; m < 4; ++m)
#pragma unroll
                for (int bj = 0; bj < 2; ++bj) {
                    const size_t ub = ((size_t)(u.row0 + ai * 128 + m * 16) * 2048 + u.col0 + bj * 128) * 2;
                    float b[8], y[8]; unpack8(*(const u32x4*)((const char*)gb + ub + lo), b);
#pragma unroll
                    for (int e = 0; e < 8; ++e) y[e] = acc[ai][bj][m][e >> 2][e & 3] * sigmoidf_(b[e]);
                    *(u32x4*)(outp + ub + lo) = pack8(y);
                    __builtin_amdgcn_sched_barrier(0);
                }
    }
};
struct SchedRes {
    const char* a; const char* w; int K, G, c;
    __device__ bool next(int i, Unit& u) const {
        const int L = i * G + c; if (L >= 64 * 8) return false; int pm, pn; pg8::rect_map(L, 64, 8, pm, pn);
        u.A = a + (size_t)pm * 256 * K * 2; u.B = w + (size_t)pn * 256 * K * 2; u.row0 = pm * 256; u.col0 = pn * 256; u.kind = 0; u.out = nullptr; u.ldc = 2048; return true;
    }
};
struct EpiRes {
    static constexpr bool MID = false;
    const float* base; float* out; const float* gate;
    __device__ __forceinline__ void mid(Acc&, const Unit&, int, int, int, int) const {}
    __device__ __forceinline__ void operator()(const Acc& acc, const Unit& u, int wr, int wc, int fr, int fq) const {
        const int col = u.col0 + wc * 32 + 8 * fq;
        const float* gp = gate + (size_t)(u.row0 >> 13) * 12288 + col;
        f32x4 g[2][2];
#pragma unroll
        for (int bj = 0; bj < 2; ++bj) { g[bj][0] = *(const f32x4*)(gp + bj * 128); g[bj][1] = *(const f32x4*)(gp + bj * 128 + 4); }
        const size_t o0 = (size_t)(u.row0 + wr * 64 + fr) * 2048 + col;
#pragma unroll
        for (int ai = 0; ai < 2; ++ai)
#pragma unroll
            for (int m = 0; m < 4; ++m)
#pragma unroll
                for (int bj = 0; bj < 2; ++bj) {
                    const size_t o = o0 + (size_t)(ai * 128 + m * 16) * 2048 + bj * 128;
                    const f32x4 x0 = *(const f32x4*)(base + o), x1 = *(const f32x4*)(base + o + 4);
                    *(f32x4*)(out + o) = x0 + g[bj][0] * acc[ai][bj][m][0];
                    *(f32x4*)(out + o + 4) = x1 + g[bj][1] * acc[ai][bj][m][1];
                }
    }
};
struct SchedUp {
    const char* a; const char* w; char* uo; int j0, ns, ldu, G, c;
    __device__ bool next(int i, Unit& u) const {
        const int L = i * G + c; if (L >= 64 * ns) return false; int pm, pn; pg8::rect_map(L, 64, ns, pm, pn);
        u.A = a + (size_t)pm * 256 * DM * 2; u.B = w + (size_t)(j0 + pn) * 256 * DM * 2; u.row0 = pm * 256; u.col0 = pn * 256; u.kind = 0;
        u.out = uo + ((size_t)pm * 256 * ldu + pn * 256) * 2; u.ldc = ldu; return true;
    }
};
struct EpiStore {
    static constexpr bool MID = false;
    __device__ __forceinline__ void mid(Acc&, const Unit&, int, int, int, int) const {}
    __device__ __forceinline__ void operator()(const Acc& acc, const Unit& u, int wr, int wc, int fr, int fq) const { store_tile_bf16(acc, u, wr, wc, fr, fq); }
};

__device__ __forceinline__ int srccol(int kind, int n) {
    if (kind == 0) return n;
    if (kind == 1) return n < 7168 ? n : (n < 7200 ? n + 2048 : -1);
    if (kind == 2) return n < 2048 ? 7168 + n : 9248 + (n - 2048);
    const int j = n >> 8, i = n & 255; return i < 128 ? 128 * j + i : 5632 + 128 * j + (i - 128);
}
__device__ void transpose_tile(LAS float* tl, const float* __restrict__ src, int ld_src, bf16_t* dst, int ld_dst, int k0, int n0, int kind, int koff) {
    const int tid = threadIdx.x + opaque0();
    { const int kr = tid >> 4, nq = (tid & 15) * 4; const int sc = srccol(kind, n0 + nq);
#pragma unroll
      for (int pass = 0; pass < 2; ++pass) { const int k = kr + 32 * pass;
          f32x4 v = (f32x4){0.f, 0.f, 0.f, 0.f}; if (sc >= 0) v = *(const f32x4*)(src + (size_t)(k0 + k) * ld_src + sc);
          tl[(nq + 0) * 65 + k] = v[0]; tl[(nq + 1) * 65 + k] = v[1]; tl[(nq + 2) * 65 + k] = v[2]; tl[(nq + 3) * 65 + k] = v[3]; } }
    __syncthreads();
    { const int n = tid >> 3, kc = (tid & 7) * 8; float f[8];
#pragma unroll
      for (int e = 0; e < 8; ++e) f[e] = tl[n * 65 + kc + e];
      *(u32x4*)(dst + (size_t)(n0 + n) * ld_dst + koff + k0 + kc) = pack8(f); }
    __syncthreads();
}
__device__ void transpose_job(LAS float* tl, const float* src, int ld_src, bf16_t* dst, int ld_dst, int K, int N, int kind, int koff, int it) {
    const int nnt = N / 64; const int kt = it / nnt, ntl = it % nnt; (void)K;
    transpose_tile(tl, src, ld_src, dst, ld_dst, kt * 64, ntl * 64, kind, koff);
}

__device__ void phase0(LAS unsigned char* lds, const P& p) {
    LAS float* tl = (LAS float*)lds;
    unsigned char* ws = p.ws;
    const int nb = gridDim.x, bid = blockIdx.x, tid = threadIdx.x + opaque0();
    for (int it = bid; it < 256; it += nb) {
        const int kc = it >> 3, nch = it & 7; float a[3][3];
#pragma unroll
        for (int v = 0; v < 3; ++v)
#pragma unroll
            for (int j = 0; j < 3; ++j) a[v][j] = 0.f;
        for (int k = kc * 64; k < kc * 64 + 64; ++k) {
            const float s0 = siluf_(p.c[k]), s1 = siluf_(p.c[2048 + k]), s2 = siluf_(p.c_ctx[k]);
            const float* wr = p.w_mod + (size_t)k * 12288 + nch * 1536 + tid;
#pragma unroll
            for (int j = 0; j < 3; ++j) { const float w = wr[j * 512]; a[0][j] += s0 * w; a[1][j] += s1 * w; a[2][j] += s2 * w; }
        }
        float* mp = (float*)(ws + O_MODP) + (size_t)kc * 3 * 12288 + nch * 1536 + tid;
#pragma unroll
        for (int v = 0; v < 3; ++v)
#pragma unroll
            for (int j = 0; j < 3; ++j) mp[(size_t)v * 12288 + j * 512] = a[v][j];
    }
    for (int i = bid * 512 + tid; i < 128 * 32; i += nb * 512) {
        const int pos = i >> 5, f = i & 31;
        const float inv = exp2f(-(float)f * (13.287712379549449f / 32.0f));
        const float ang = (float)pos * inv;
        const double ad = (double)ang; const double n = rint(ad * 0.15915494309189535); double r = ad - n * 6.283185307179586476925;
        r *= 0.125; const double r2 = r * r;
        double s = r * (1.0 + r2 * (-1.0 / 6 + r2 * (1.0 / 120 + r2 * (-1.0 / 5040 + r2 * (1.0 / 362880 + r2 * (-1.0 / 39916800))))));
        double c = 1.0 + r2 * (-0.5 + r2 * (1.0 / 24 + r2 * (-1.0 / 720 + r2 * (1.0 / 40320 + r2 * (-1.0 / 3628800 + r2 * (1.0 / 479001600))))));
#pragma unroll
        for (int q = 0; q < 3; ++q) { const double s2 = 2.0 * s * c, c2 = c * c - s * s; s = s2; c = c2; }
        ((f32x2*)(ws + O_ROPE))[i] = (f32x2){(float)c, (float)s};
    }
    const int J0 = 32 * 116, J1 = 32 * 96, J2 = 1024, J3 = 1024, J4 = 1024;
    for (int it = bid; it < J0 + J1 + J2 + J3 + J4; it += nb) {
        int q = it;
        if (q < J0) { transpose_job(tl, p.w_in, 13344, (bf16_t*)(ws + O_XR), 2048, 2048, 7424, 1, 0, q); continue; } q -= J0;
        if (q < J1) { transpose_job(tl, p.w_in, 13344, (bf16_t*)(ws + O_W2IN), 2048, 2048, 6144, 2, 0, q); continue; } q -= J1;
        if (q < J2) { transpose_job(tl, p.w_attn_o, 2048, (bf16_t*)(ws + O_WMRG), 4096, 2048, 2048, 0, 0, q); continue; } q -= J2;
        if (q < J3) { transpose_job(tl, p.w_gla_o, 2048, (bf16_t*)(ws + O_WMRG), 4096, 2048, 2048, 0, 2048, q); continue; } q -= J3;
        transpose_job(tl, p.w_out, 2048, (bf16_t*)(ws + O_WOUT), 2048, 2048, 2048, 0, 0, q);
    }
}
__device__ void phase_modreduce(const P& p) {
    const float* mp = (const float*)(p.ws + O_MODP); float* mod = (float*)(p.ws + O_MOD);
    for (int i = blockIdx.x * 512 + threadIdx.x; i < 3 * 12288; i += gridDim.x * 512) {
        float s = p.b_mod[i % 12288];
        for (int kc = 0; kc < 32; ++kc) s += mp[(size_t)kc * 3 * 12288 + i];
        mod[i] = s;
    }
}
__device__ void phase_modulate(const float* xlat, const float* xctx, const float* g, const float* mod, int sh, int sc, bf16_t* h, int nrows) {
    const int tix = threadIdx.x + opaque0(); const int lane = tix & 63, gw = blockIdx.x * 8 + (tix >> 6), nw = gridDim.x * 8;
    for (int r = gw; r < nrows; r += nw) {
        const float* xr = r < NTOK ? xlat + (size_t)r * DM : xctx + (size_t)(r - NTOK) * DM;
        const float* mv = mod + (size_t)(r < NTOK ? (r >> 13) : 2) * 12288;
        f32x4 v[8]; float ss = 0.f;
#pragma unroll
        for (int i = 0; i < 8; ++i) { v[i] = *(const f32x4*)(xr + (i * 64 + lane) * 4); ss += v[i][0] * v[i][0] + v[i][1] * v[i][1] + v[i][2] * v[i][2] + v[i][3] * v[i][3]; }
        ss = wave_sum(ss); const float rs = rsqrtf(ss * (1.0f / DM) + EPS_);
#pragma unroll
        for (int i = 0; i < 8; ++i) { const int cidx = (i * 64 + lane) * 4;
            const f32x4 gg = *(const f32x4*)(g + cidx), s1 = *(const f32x4*)(mv + sc * 2048 + cidx), s0 = *(const f32x4*)(mv + sh * 2048 + cidx);
            const f32x4 y = v[i] * rs * gg * (s1 + 1.0f) + s0;
            u32x2 w; w.x = cvt_pk_bf16(y[0], y[1]); w.y = cvt_pk_bf16(y[2], y[3]); *(u32x2*)(h + (size_t)r * DM + cidx) = w; }
    }
}

__device__ __forceinline__ void normrope8x4(float (&y)[4][8], const float* nw, int dofs, float rs, bool rope, int t, const f32x2* tab) {
#pragma unroll
    for (int s = 0; s < 4; ++s) { const f32x4 w0 = *(const f32x4*)(nw + s * 32 + dofs), w1 = *(const f32x4*)(nw + s * 32 + dofs + 4);
#pragma unroll
        for (int e = 0; e < 4; ++e) { y[s][e] *= rs * w0[e]; y[s][4 + e] *= rs * w1[e]; } }
    if (rope) {
#pragma unroll
        for (int s = 0; s < 2; ++s) { const int pos = s == 0 ? (t >> 6) : (t & 63); const f32x2* tp = tab + pos * 32 + dofs;
#pragma unroll
            for (int e = 0; e < 8; ++e) { const f32x2 cs = tp[e]; const float x1 = y[s][e], x2 = y[s + 2][e]; y[s][e] = x1 * cs.x - x2 * cs.y; y[s + 2][e] = x2 * cs.x + x1 * cs.y; } }
    }
}
__device__ void attn_item(LAS unsigned char* lds, const P& p, bf16_t* cc, int item) {
    const int tid = threadIdx.x + opaque0(), w = __builtin_amdgcn_readfirstlane(tid >> 6), lane = tid & 63, fr = lane & 15, fq = lane >> 4;
    const int pair = item & 1, kvh = (item >> 1) & 3, qb = (item >> 3) & 63, b = item >> 9;
    LAS bf16_t* Ks = (LAS bf16_t*)lds; LAS bf16_t* Vs = Ks + 128 * 136; LAS bf16_t* Ps = Vs + 128 * 136 + w * (32 * 136);
    const bf16_t* QA = (const bf16_t*)(p.ws + O_QA); const bf16_t* KA = (const bf16_t*)(p.ws + O_KA); const bf16_t* VAT = (const bf16_t*)(p.ws + O_VAT);
    const f32x2* tab = (const f32x2*)(p.ws + O_ROPE);
    const int hq = kvh * 4 + pair * 2 + (w >> 2), rc = w & 3, qrow0 = qb * 128 + rc * 32;
    const float SC = 0.08838834764831845f * 1.4426950408889634f;
    bf16x8 qf[2][4];
#pragma unroll
    for (int mt = 0; mt < 2; ++mt) {
        const int t = qrow0 + mt * 16 + fr; const bf16_t* src = QA + (size_t)(b * T_ + t) * 2048 + hq * 128 + fq * 8;
        float y[4][8]; float ss = 0.f;
#pragma unroll
        for (int s = 0; s < 4; ++s) { unpack8(*(const u32x4*)(src + s * 32), y[s]);
#pragma unroll
            for (int e = 0; e < 8; ++e) ss += y[s][e] * y[s][e]; }
        ss += __shfl_xor(ss, 16); ss += __shfl_xor(ss, 32);
        const float rs = rsqrtf(ss * (1.0f / 128) + EPS_);
        normrope8x4(y, p.q_norm, fq * 8, rs, true, t, tab);
#pragma unroll
        for (int s = 0; s < 4; ++s) {
#pragma unroll
            for (int e = 0; e < 8; ++e) y[s][e] *= SC;
            const u32x4 pk = pack8(y[s]); qf[mt][s] = *(const bf16x8*)&pk; }
    }
    f32x4 o[2][8];
#pragma unroll
    for (int mt = 0; mt < 2; ++mt)
#pragma unroll
        for (int n = 0; n < 8; ++n) o[mt][n] = (f32x4){0.f, 0.f, 0.f, 0.f};
    float mrun[2][4], lrun[2][4];
    { const float sk = p.sink[hq] * 1.4426950408889634f;
#pragma unroll
      for (int mt = 0; mt < 2; ++mt)
#pragma unroll
          for (int j = 0; j < 4; ++j) { mrun[mt][j] = sk; lrun[mt][j] = fr == 0 ? 1.0f : 0.0f; } }
    for (int jj = 0; jj < 5; ++jj) {
        int tokbase, mtype = 0, tpos0 = 0; bool lat = jj < 3;
        if (lat) { const int j = qb - 1 + jj; if (j < 0 || j > 63) continue; tokbase = b * T_ + j * 128; tpos0 = j * 128; mtype = jj == 0 ? 1 : (jj == 2 ? 2 : 0); }
        else tokbase = NTOK + b * 256 + (jj - 3) * 128;
        const int mlo = mtype == 1 ? 0 : -100000, mhi = mtype == 2 ? 0 : 100000;
        const int dl = fr - rc * 32 - fq * 4 + opaque0();
        __syncthreads();
        {
            const int key = tid >> 2, part = tid & 3; const bf16_t* src = KA + (size_t)(tokbase + key) * 512 + kvh * 128 + part * 8;
            float y[4][8]; float ss = 0.f;
#pragma unroll
            for (int s = 0; s < 4; ++s) { unpack8(*(const u32x4*)(src + s * 32), y[s]);
#pragma unroll
                for (int e = 0; e < 8; ++e) ss += y[s][e] * y[s][e]; }
            ss += __shfl_xor(ss, 1); ss += __shfl_xor(ss, 2);
            const float rs = rsqrtf(ss * (1.0f / 128) + EPS_);
            normrope8x4(y, p.k_norm, part * 8, rs, lat, tpos0 + key, tab);
#pragma unroll
            for (int s = 0; s < 4; ++s) *(LAS u32x4*)(Ks + key * 136 + s * 32 + part * 8) = pack8(y[s]);
            const bf16_t* vsrc = VAT + (size_t)(kvh * 128 + key) * NROW + tokbase + part * 8;
#pragma unroll
            for (int s = 0; s < 4; ++s) *(LAS u32x4*)(Vs + key * 136 + s * 32 + part * 8) = *(const u32x4*)(vsrc + s * 32);
        }
        __syncthreads();
#pragma unroll
        for (int mt = 0; mt < 2; ++mt) {
            f32x4 sacc[8];
#pragma unroll
            for (int n = 0; n < 8; ++n) sacc[n] = (f32x4){0.f, 0.f, 0.f, 0.f};
#pragma unroll
            for (int s = 0; s < 4; ++s) {
#pragma unroll
                for (int n = 0; n < 8; ++n) { const bf16x8 kf = *(const LAS bf16x8*)(Ks + (n * 16 + fr) * 136 + s * 32 + fq * 8); sacc[n] = MFMA16(qf[mt][s], kf, sacc[n]); }
                __builtin_amdgcn_sched_barrier(0); }
#pragma unroll
            for (int j = 0; j < 4; ++j) {
                float mx = -INFINITY;
#pragma unroll
                for (int n = 0; n < 8; ++n) { const int dkq = dl + (n * 16 - mt * 16 - j); float v = sacc[n][j];
                    if (dkq < mlo || dkq > mhi) v = -INFINITY; sacc[n][j] = v; mx = fmaxf(mx, v); }
                mx = fmaxf(mx, __shfl_xor(mx, 1)); mx = fmaxf(mx, __shfl_xor(mx, 2)); mx = fmaxf(mx, __shfl_xor(mx, 4)); mx = fmaxf(mx, __shfl_xor(mx, 8));
                const float mn = fmaxf(mrun[mt][j], mx), al = exp2f(mrun[mt][j] - mn); mrun[mt][j] = mn;
                float ps = 0.f;
#pragma unroll
                for (int n = 0; n < 8; ++n) { const float pv = exp2f(sacc[n][j] - mn); ps += pv; o[mt][n][j] *= al;
                    Ps[(mt * 16 + fq * 4 + j) * 136 + n * 16 + fr] = f2bf(pv); }
                lrun[mt][j] = lrun[mt][j] * al + ps;
            }
            __builtin_amdgcn_sched_barrier(0);
        }
        __syncthreads();
#pragma unroll
        for (int s = 0; s < 4; ++s) {
            const bf16x8 p0 = *(const LAS bf16x8*)(Ps + fr * 136 + s * 32 + fq * 8), p1 = *(const LAS bf16x8*)(Ps + (16 + fr) * 136 + s * 32 + fq * 8);
#pragma unroll
            for (int n = 0; n < 8; ++n) { const bf16x8 vf = *(const LAS bf16x8*)(Vs + (n * 16 + fr) * 136 + s * 32 + fq * 8);
                o[0][n] = MFMA16(p0, vf, o[0][n]); o[1][n] = MFMA16(p1, vf, o[1][n]); }
            __builtin_amdgcn_sched_barrier(0);
        }
    }
#pragma unroll
    for (int mt = 0; mt < 2; ++mt)
#pragma unroll
        for (int j = 0; j < 4; ++j) {
            float l = lrun[mt][j]; l += __shfl_xor(l, 1); l += __shfl_xor(l, 2); l += __shfl_xor(l, 4); l += __shfl_xor(l, 8);
            const float inv = 1.0f / l; bf16_t* dst = cc + (size_t)(b * T_ + qrow0 + mt * 16 + fq * 4 + j) * 4096 + hq * 128 + fr;
#pragma unroll
            for (int n = 0; n < 8; ++n) dst[n * 16] = f2bf(o[mt][n][j] * inv);
        }
}

__device__ void glaprep_item(LAS unsigned char* lds, const P& p, int item) {
    const int tid = threadIdx.x + opaque0(), w = __builtin_amdgcn_readfirstlane(tid >> 6), lane = tid & 63, fr = lane & 15, fq = lane >> 4;
    const int ck = item % 66, h = (item / 66) & 3, b = item / 264;
    const bool lat = ck < 64; const int r0 = lat ? b * T_ + ck * 128 : NTOK + b * 256 + (ck - 64) * 128;
    LAS bf16_t* Qs = (LAS bf16_t*)lds; LAS bf16_t* Ks = Qs + 128 * 264; LAS float* lrs = (LAS float*)(lds + 2 * 128 * 264 * 2); LAS float* seg = lrs + 128 * 32;
    unsigned char* ws = p.ws;
    bf16_t* QB = (bf16_t*)(ws + O_QB); bf16_t* QF = (bf16_t*)(ws + O_QF); const bf16_t* KB = (const bf16_t*)(ws + O_KB);
    __syncthreads();
    { const f32x4* src = (const f32x4*)((const float*)(ws + O_LR) + (size_t)r0 * 32); ((LAS f32x4*)lrs)[tid] = src[tid]; ((LAS f32x4*)lrs)[tid + 512] = src[tid + 512]; }
    const int half = tid >> 8, d = tid & 255, gc = h * 256 + d;
    for (int dir = 0; dir < 2; ++dir) {
        const int chain = dir * 8 + b * 4 + h;
        const float* wg = dir == 0 ? p.wgf : p.wgb; const float bias = (dir == 0 ? p.bgf : p.bgb)[gc];
        float wv[16];
#pragma unroll
        for (int j = 0; j < 16; ++j) wv[j] = wg[j * 1024 + gc];
        __syncthreads();
        float carry = 0.f;
        bf16_t* qdst = dir == 0 ? QF : QB;
#pragma unroll 1
        for (int rnd = 0; rnd < 2; ++rnd) {
            float bl[32]; float run = 0.f;
            const int ibase = rnd * 64 + half * 32;
#pragma unroll
            for (int ii = 0; ii < 32; ++ii) {
                const int i = ibase + ii, tok = dir == 0 ? i : 127 - i;
                const LAS f32x4* lp = (const LAS f32x4*)(lrs + tok * 32 + dir * 16);
                float xg = bias;
#pragma unroll
                for (int q = 0; q < 4; ++q) { const f32x4 l4 = lp[q]; xg += l4[0] * wv[q * 4] + l4[1] * wv[q * 4 + 1] + l4[2] * wv[q * 4 + 2] + l4[3] * wv[q * 4 + 3]; }
                const float ls = fminf(xg, 0.f) - __logf(1.0f + __expf(-fabsf(xg)));
                run += ls * 0.0625f; bl[ii] = run;
            }
            __syncthreads();
            seg[half * 256 + d] = run;
            __syncthreads();
            const float s0 = seg[d], s1 = seg[256 + d];
            const float off = carry + (half == 1 ? s0 : 0.f);
            carry += s0 + s1;
#pragma unroll
            for (int ii = 0; ii < 32; ++ii) {
                const int i = ibase + ii, tok = dir == 0 ? i : 127 - i;
                const float bb = bl[ii] + off; const float eb = __expf(bb), ieb = __expf(-bb);
                const size_t gi = (size_t)(r0 + tok) * 1024 + gc;
                Ks[tok * 264 + d] = f2bf(bf2f(KB[gi]) * ieb);
                if (lat) { const bf16_t qv = f2bf(bf2f(QB[gi]) * 0.0625f * eb); Qs[tok * 264 + d] = qv; qdst[gi] = qv; }
                if ((ii & 7) == 7) __builtin_amdgcn_sched_barrier(0);
            }
        }
        if (half == 1) ((float*)(ws + O_DD))[((size_t)chain * 66 + ck) * 256 + d] = __expf(carry);
        __syncthreads();
        if (lat) {
            f32x4 a[8];
#pragma unroll
            for (int n = 0; n < 8; ++n) a[n] = (f32x4){0.f, 0.f, 0.f, 0.f};
#pragma unroll
            for (int s = 0; s < 8; ++s) { const bf16x8 qfr = *(const LAS bf16x8*)(Qs + (16 * w + fr) * 264 + s * 32 + fq * 8);
#pragma unroll
                for (int n = 0; n < 8; ++n) { const bf16x8 kfr = *(const LAS bf16x8*)(Ks + (n * 16 + fr) * 264 + s * 32 + fq * 8); a[n] = MFMA16(kfr, qfr, a[n]); }
                __builtin_amdgcn_sched_barrier(0); }
            bf16_t* ab = (bf16_t*)(ws + O_XR) + ((size_t)(chain * 64 + ck) * 128 + 16 * w + fr) * 128;
            const int cmr = (fq * 4 - 16 * w - fr + opaque0()) * (dir == 0 ? 1 : -1);
#pragma unroll
            for (int n = 0; n < 8; ++n) { float v[4];
#pragma unroll
                for (int j = 0; j < 4; ++j) { const int dcr = cmr + (dir == 0 ? (n * 16 + j) : -(n * 16 + j)); v[j] = dcr <= 0 ? a[n][j] : 0.f; }
                u32x2 pk; pk.x = cvt_pk_bf16(v[0], v[1]); pk.y = cvt_pk_bf16(v[2], v[3]); *(u32x2*)(ab + n * 16 + fq * 4) = pk; }
        }
        {
            bf16_t* kt = (bf16_t*)(ws + O_KT) + ((size_t)dir * 1024 + (size_t)gc) * NROW + r0;
#pragma unroll
            for (int it = 0; it < 8; ++it) { const int tc = it * 2 + half; unsigned short e[8];
#pragma unroll
                for (int q = 0; q < 8; ++q) e[q] = Ks[(tc * 8 + q) * 264 + d];
                u32x4 pk; pk.x = e[0] | ((unsigned)e[1] << 16); pk.y = e[2] | ((unsigned)e[3] << 16); pk.z = e[4] | ((unsigned)e[5] << 16); pk.w = e[6] | ((unsigned)e[7] << 16);
                *(u32x4*)(kt + tc * 8) = pk; }
        }
    }
}

__device__ void glaseq_item(LAS unsigned char* lds, const P& p, int item) {
    const int tid = threadIdx.x + opaque0(), w = __builtin_amdgcn_readfirstlane(tid >> 6), lane = tid & 63, fr = lane & 15, fq = lane >> 4;
    const int chain = item & 15, sl = item >> 4, dir = chain >> 3, b = (chain >> 2) & 1, h = chain & 3;
    unsigned char* ws = p.ws;
    LAS bf16_t* Ss = (LAS bf16_t*)lds;
    const bf16_t* VBT = (const bf16_t*)(ws + O_VBT) + (size_t)(h * 512 + sl * 32 + fr) * NROW + fq * 8;
    const bf16_t* KT = (const bf16_t*)(ws + O_KT) + ((size_t)dir * 1024 + h * 256 + 32 * w + fr) * NROW + fq * 8;
    const bf16_t* QT = (const bf16_t*)(ws + (dir == 0 ? O_QF : O_QB));
    const bf16_t* AB = (const bf16_t*)(ws + O_XR) + (size_t)chain * 64 * 128 * 128;
    const float* DD = (const float*)(ws + O_DD) + (size_t)chain * 66 * 256 + 32 * w + fq * 4;
    bf16_t* OB = (bf16_t*)(ws + O_OF) + (size_t)dir * NTOK * 2048;
    f32x4 st[2][2];
#pragma unroll
    for (int t = 0; t < 2; ++t)
#pragma unroll
        for (int n = 0; n < 2; ++n) st[t][n] = (f32x4){0.f, 0.f, 0.f, 0.f};
#define GS_CK(s_) (dir == 0 ? ((s_) < 2 ? 64 + (s_) : (s_) - 2) : 65 - (s_))
#define GS_R0(s_, ck_) ((s_) >= 2 ? b * T_ + (ck_) * 128 : NTOK + b * 256 + ((ck_) - 64) * 128)
#define GS_LOAD(VF, KF, DDv, s_) do { const int ck_ = GS_CK(s_); const int r0_ = GS_R0(s_, ck_); \
        _Pragma("unroll") for (int n = 0; n < 2; ++n) _Pragma("unroll") for (int q = 0; q < 4; ++q) { \
            VF[n][q] = *(const bf16x8*)(VBT + (size_t)n * 16 * NROW + r0_ + q * 32); KF[n][q] = *(const bf16x8*)(KT + (size_t)n * 16 * NROW + r0_ + q * 32); } \
        DDv[0] = *(const f32x4*)(DD + (size_t)ck_ * 256); DDv[1] = *(const f32x4*)(DD + (size_t)ck_ * 256 + 16); } while (0)
#define GS_UPDATE(VF, KF, DDv) do { _Pragma("unroll") for (int t = 0; t < 2; ++t) _Pragma("unroll") for (int n = 0; n < 2; ++n) { f32x4 tmp = st[t][n]; \
        _Pragma("unroll") for (int q = 0; q < 4; ++q) tmp = MFMA16(KF[t][q], VF[n][q], tmp); st[t][n] = tmp * DDv[t]; } } while (0)
#define GS_LOADQA(s_) do { const int ck_ = GS_CK(s_); const int r0_ = GS_R0(s_, ck_); \
        const bf16_t* qp_ = QT + (size_t)(r0_ + 16 * w + fr) * 1024 + h * 256 + fq * 8; const bf16_t* ap_ = AB + ((size_t)ck_ * 128 + 16 * w + fr) * 128 + fq * 8; \
        _Pragma("unroll") for (int q = 0; q < 8; ++q) qfr[q] = *(const bf16x8*)(qp_ + q * 32); \
        _Pragma("unroll") for (int q = 0; q < 4; ++q) af[q] = *(const bf16x8*)(ap_ + q * 32); } while (0)
    bf16x8 vfA[2][4], kfA[2][4], vfB[2][4], kfB[2][4], qfr[8], af[4]; f32x4 ddA[2], ddB[2];
    GS_LOAD(vfA, kfA, ddA, 0); GS_LOAD(vfB, kfB, ddB, 1);
    GS_UPDATE(vfA, kfA, ddA);
    GS_LOAD(vfA, kfA, ddA, 2); GS_LOADQA(2);
    GS_UPDATE(vfB, kfB, ddB);
#define GS_STEP(VF, KF, DDv, VFN, KFN, DDN, s_) do { \
        const int sn_ = (s_) + 1 < 66 ? (s_) + 1 : 65; \
        GS_LOAD(VFN, KFN, DDN, sn_); \
        __syncthreads(); \
        _Pragma("unroll") for (int t = 0; t < 2; ++t) _Pragma("unroll") for (int n = 0; n < 2; ++n) { u32x2 pk; pk.x = cvt_pk_bf16(st[t][n][0], st[t][n][1]); pk.y = cvt_pk_bf16(st[t][n][2], st[t][n][3]); \
            *(LAS u32x2*)(Ss + (n * 16 + fr) * 264 + 32 * w + t * 16 + fq * 4) = pk; } \
        __syncthreads(); \
        GS_UPDATE(VF, KF, DDv); \
        f32x4 oo[2] = {(f32x4){0.f, 0.f, 0.f, 0.f}, (f32x4){0.f, 0.f, 0.f, 0.f}}; \
        _Pragma("unroll") for (int q = 0; q < 4; ++q) _Pragma("unroll") for (int n = 0; n < 2; ++n) oo[n] = MFMA16(VF[n][q], af[q], oo[n]); \
        _Pragma("unroll") for (int q = 0; q < 8; ++q) _Pragma("unroll") for (int n = 0; n < 2; ++n) { \
            const bf16x8 sf = *(const LAS bf16x8*)(Ss + (n * 16 + fr) * 264 + q * 32 + fq * 8); oo[n] = MFMA16(sf, qfr[q], oo[n]); } \
        { const int ck_ = GS_CK(s_); const int r0_ = GS_R0(s_, ck_); bf16_t* op = OB + (size_t)(r0_ + 16 * w + fr) * 2048 + h * 512 + sl * 32 + fq * 4; \
          _Pragma("unroll") for (int n = 0; n < 2; ++n) { u32x2 pk; pk.x = cvt_pk_bf16(oo[n][0], oo[n][1]); pk.y = cvt_pk_bf16(oo[n][2], oo[n][3]); *(u32x2*)(op + n * 16) = pk; } } \
        GS_LOADQA(sn_); \
    } while (0)
#pragma unroll 1
    for (int s = 2; s < 66; s += 2) {
        GS_STEP(vfA, kfA, ddA, vfB, kfB, ddB, s);
        GS_STEP(vfB, kfB, ddB, vfA, kfA, ddA, s + 1);
    }
#undef GS_CK
#undef GS_R0
#undef GS_LOAD
#undef GS_UPDATE
#undef GS_LOADQA
#undef GS_STEP
}

__device__ void phase_glafinal(const P& p, bf16_t* cc) {
    const int tix = threadIdx.x + opaque0(); const int lane = tix & 63, gw = blockIdx.x * 8 + (tix >> 6), nw = gridDim.x * 8;
    const bf16_t* OF = (const bf16_t*)(p.ws + O_OF); const bf16_t* OBk = OF + (size_t)NTOK * 2048;
    f32x4 g0 = *(const f32x4*)(p.gla_norm + lane * 8), g1 = *(const f32x4*)(p.gla_norm + lane * 8 + 4);
    for (int i = gw; i < NTOK * 4; i += nw) {
        const size_t o = (size_t)i * 512 + lane * 8;
        float a[8], c[8]; unpack8(*(const u32x4*)(OF + o), a); unpack8(*(const u32x4*)(OBk + o), c);
        float ss = 0.f;
#pragma unroll
        for (int e = 0; e < 8; ++e) { a[e] += c[e]; ss += a[e] * a[e]; }
        ss = wave_sum(ss); const float rs = rsqrtf(ss * (1.0f / 512) + EPS_);
#pragma unroll
        for (int e = 0; e < 4; ++e) { a[e] *= rs * g0[e]; a[4 + e] *= rs * g1[e]; }
        const int r = i >> 2, hh = i & 3;
        *(u32x4*)(cc + (size_t)r * 4096 + 2048 + hh * 512 + lane * 8) = pack8(a);
    }
}

__device__ void phase_conv(const P& p, const bf16_t* U, int ldu, int j0, int ns, bf16_t* act) {
    const int ncg = ns * 16, ntask = 256 * ncg;
    for (int task = blockIdx.x * 512 + threadIdx.x + opaque0(); task < ntask; task += gridDim.x * 512) {
        const int run = task / ncg, cgi = task % ncg, jl = cgi >> 4, i8 = (cgi & 15) * 8;
        const int ch = 128 * (j0 + jl) + i8; const int ucol = jl * 256 + i8;
        float wa[3][8], wg[3][8], ba[8], bg[8];
#pragma unroll
        for (int j = 0; j < 3; ++j)
#pragma unroll
            for (int e = 0; e < 8; ++e) { wa[j][e] = p.conv_w[j * 11264 + ch + e]; wg[j][e] = p.conv_w[j * 11264 + 5632 + ch + e]; }
#pragma unroll
        for (int e = 0; e < 8; ++e) { ba[e] = p.conv_b[ch + e]; bg[e] = p.conv_b[5632 + ch + e]; }
        const int rw0 = run * 64; const int tl0 = rw0 & (T_ - 1);
        float pa[8], pg[8], ca[8], cg_[8], na[8], ng[8];
        const bf16_t* up = U + (size_t)rw0 * ldu + ucol;
        if (tl0 > 0) { unpack8(*(const u32x4*)(up - ldu), pa); unpack8(*(const u32x4*)(up - ldu + 128), pg); }
        else {
#pragma unroll
            for (int e = 0; e < 8; ++e) { pa[e] = 0.f; pg[e] = 0.f; } }
        unpack8(*(const u32x4*)(up), ca); unpack8(*(const u32x4*)(up + 128), cg_);
        for (int i = 0; i < 64; ++i) {
            const bool has_next = (tl0 + i + 1) < T_;
            if (has_next) { unpack8(*(const u32x4*)(up + (size_t)(i + 1) * ldu), na); unpack8(*(const u32x4*)(up + (size_t)(i + 1) * ldu + 128), ng); }
            else {
#pragma unroll
                for (int e = 0; e < 8; ++e) { na[e] = 0.f; ng[e] = 0.f; } }
            float y[8];
#pragma unroll
            for (int e = 0; e < 8; ++e) { const float av = wa[0][e] * pa[e] + wa[1][e] * ca[e] + wa[2][e] * na[e] + ba[e]; const float gv = wg[0][e] * pg[e] + wg[1][e] * cg_[e] + wg[2][e] * ng[e] + bg[e];
                y[e] = siluf_(av) * gv; pa[e] = ca[e]; pg[e] = cg_[e]; ca[e] = na[e]; cg_[e] = ng[e]; }
            *(u32x4*)(act + (size_t)(rw0 + i) * 5632 + ch) = pack8(y);
        }
    }
}


#ifdef DBG_STOP
__device__ void dbg_dump(cg::grid_group& grid, const P& p, const bf16_t* src, size_t ld, int rows, int cols) {
    bf16_t* tmp = (bf16_t*)(p.ws + O_MIXEND);
    grid.sync();
    const size_t n = (size_t)rows * cols;
    for (size_t i = (size_t)blockIdx.x * 512 + threadIdx.x; i < n; i += (size_t)gridDim.x * 512) tmp[i] = src[(i / cols) * ld + (i % cols)];
    grid.sync();
    for (size_t i = (size_t)blockIdx.x * 512 + threadIdx.x; i < (size_t)NTOK * DM; i += (size_t)gridDim.x * 512) {
        const size_t r = i / DM, c = i % DM; p.out[i] = (r < (size_t)rows && c < (size_t)cols) ? bf2f(tmp[r * cols + c]) : 0.f; }
}
#define DBG_AT(k, src, ld, rows, cols) if (DBG_STOP == k) { dbg_dump(grid, p, (const bf16_t*)(src), ld, rows, cols); return; }
#else
#define DBG_AT(k, src, ld, rows, cols)
#endif

#ifdef DBG_STOP
__device__ void dbg_nancount(cg::grid_group& grid, const P& p, const bf16_t* src, size_t n, int mode) {
    unsigned* cnt = (unsigned*)(p.ws + O_MIXEND);
    grid.sync();
    if (blockIdx.x == 0 && threadIdx.x == 0) { cnt[0] = 0; cnt[1] = 0; }
    grid.sync();
    unsigned c = 0; float mx = 0.f;
    for (size_t i = (size_t)blockIdx.x * 512 + threadIdx.x; i < n; i += (size_t)gridDim.x * 512) { const unsigned short v = src[i]; if ((v & 0x7f80) == 0x7f80) ++c; else mx = fmaxf(mx, fabsf(bf2f(v))); }
    if (c) atomicAdd(cnt, c);
    atomicMax(cnt + 1, __float_as_uint(mx));
    grid.sync();
    for (size_t i = (size_t)blockIdx.x * 512 + threadIdx.x; i < (size_t)NTOK * DM; i += (size_t)gridDim.x * 512) p.out[i] = 0.f;
    grid.sync();
    if (blockIdx.x == 0 && threadIdx.x == 0) p.out[0] = mode == 0 ? (float)cnt[0] : __uint_as_float(cnt[1]);
}
#define DBG_NAN(k, src, n) if (DBG_STOP == k) { dbg_nancount(grid, p, (const bf16_t*)(src), n, 0); return; } if (DBG_STOP == k + 100) { dbg_nancount(grid, p, (const bf16_t*)(src), n, 1); return; }
#else
#define DBG_NAN(k, src, n)
#endif
__global__ void __launch_bounds__(512) fwd_megakernel(P p) {
    extern __shared__ __attribute__((aligned(16))) unsigned char shm[];
    LAS unsigned char* lds = (LAS unsigned char*)shm;
    cg::grid_group grid = cg::this_grid();
    unsigned char* ws = p.ws; const int nb = gridDim.x, bid = blockIdx.x;
    float* mod = (float*)(ws + O_MOD);
    bf16_t* cc = (bf16_t*)p.out;

#ifndef PHMASK
#define PHMASK 0xffff
#endif
    if (PHMASK & 1) phase0(lds, p);
    grid.sync();
#ifdef DBL_P0
    phase0(lds, p);
    grid.sync();
#endif
    if (PHMASK & 1) phase_modreduce(p);
    grid.sync();
    if (PHMASK & 1) phase_modulate(p.x, p.ctx, p.g_mix, mod, 0, 1, (bf16_t*)(ws + O_H), NROW);
    grid.sync();
    if (PHMASK & 2) { SchedProj1 S{(const char*)(ws + O_H), (const char*)(ws + O_XR), ws, nb, bid}; EpiProj1 E; pg8::gemm_phase(lds, 2048, S, E); }
    grid.sync();
    DBG_AT(1, ws + O_QA, 2048, 8192, 2048)
    DBG_AT(2, ws + O_VBT, NROW, 2048, 2048)
    DBG_AT(11, ws + O_H, 2048, 8192, 2048)
    DBG_AT(12, ws + O_KB, 1024, 8192, 1024)
    if (PHMASK & 4) for (int it = bid; it < 1024; it += nb) attn_item(lds, p, cc, it);
#ifdef DBL_ATTN
    grid.sync();
    for (int it = bid; it < 1024; it += nb) attn_item(lds, p, cc, it);
#endif
    if (PHMASK & 8) for (int it = nb - 1 - bid; it < 528; it += nb) glaprep_item(lds, p, it);
    grid.sync();
    DBG_AT(3, cc, 4096, 8192, 2048)
    DBG_AT(4, ws + O_QF, 1024, 8192, 1024)
    DBG_AT(5, ws + O_XR, 2048, 8192, 2048)
    DBG_AT(6, ws + O_KT, NROW, 2048, 2048)
    DBG_AT(13, ws + O_QB, 1024, 8192, 1024)
#if defined(DBG_STOP) && DBG_STOP == 16
    { grid.sync(); for (size_t i = (size_t)bid * 512 + threadIdx.x; i < (size_t)NTOK * DM; i += (size_t)nb * 512) p.out[i] = i < 270336 ? ((const float*)(ws + O_DD))[i] : 0.f; return; }
#endif
    if (PHMASK & 16) for (int it = bid; it < 256; it += nb) glaseq_item(lds, p, it);
    grid.sync();
#ifdef DBL_SEQ
    for (int it = bid; it < 256; it += nb) glaseq_item(lds, p, it);
    grid.sync();
#endif
    DBG_AT(7, ws + O_OF, 2048, 8192, 2048)
    DBG_NAN(20, ws + O_OF, (size_t)2 * NTOK * 2048)
    DBG_NAN(21, ws + O_KT, (size_t)2 * 1024 * NROW)
    DBG_AT(14, ws + O_OF + 67108864, 2048, 8192, 2048)
    if (PHMASK & 32) phase_glafinal(p, cc);
    grid.sync();
    DBG_AT(8, cc + 2048, 4096, 8192, 2048)
    if (PHMASK & 64) { SchedProj2 S{(const char*)(ws + O_H), (const char*)(ws + O_W2IN), ws, cc, nb, bid}; EpiProj2 E; pg8::gemm_phase(lds, 2048, S, E); }
    grid.sync();
    DBG_AT(9, ws + O_GA, 2048, 8192, 2048)
    DBG_AT(15, cc + 2048, 4096, 8192, 2048)
    if (PHMASK & 128) { SchedMerge S{(const char*)cc, (const char*)(ws + O_WMRG), ws, nb, bid}; EpiMerge E{(const bf16_t*)(ws + O_GA), (const bf16_t*)(ws + O_GA + 67108864)}; pg8::gemm_phase(lds, 4096, S, E); }
    grid.sync();
    DBG_AT(10, ws + O_M, 2048, 8192, 2048)
    if (PHMASK & 256) { SchedRes S{(const char*)(ws + O_M), (const char*)(ws + O_WOUT), 2048, nb, bid}; EpiRes E{p.x, p.out, mod + 2 * 2048}; pg8::gemm_phase(lds, 2048, S, E); }
    grid.sync();
#ifdef DBG_STOP_WOUT
    return;
#endif
    if (PHMASK & 512) phase_modulate(p.out, p.out, p.g_ffn, mod, 3, 4, (bf16_t*)(ws + O_H2), NTOK);
    if (PHMASK & 512) { LAS float* tl = (LAS float*)lds; const int J5 = 32 * 176, J6 = 88 * 32;
      for (int it = bid; it < J5 + J6; it += nb) {
          if (it < J5) transpose_job(tl, p.w_up, 11264, (bf16_t*)(ws + O_WUP), 2048, 2048, 11264, 3, 0, it);
          else transpose_job(tl, p.w_down, 2048, (bf16_t*)(ws + O_WDN), 5632, 5632, 2048, 0, 0, it - J5); } }
    grid.sync();
    { int j0 = 0; const int ldu = p.nsmax * 256;
      for (int si = 0; si < 4 && p.ns[si] > 0; ++si) {
          const int ns = p.ns[si];
          if (PHMASK & 1024) { SchedUp S{(const char*)(ws + O_H2), (const char*)(ws + O_WUP), (char*)(ws + O_U), j0, ns, ldu, nb, bid}; EpiStore E; pg8::gemm_phase(lds, 2048, S, E); }
          grid.sync();
          if (PHMASK & 2048) phase_conv(p, (const bf16_t*)(ws + O_U), ldu, j0, ns, (bf16_t*)(ws + p.o_act));
          grid.sync();
          j0 += ns; } }
    if (PHMASK & 4096) { SchedRes S{(const char*)(ws + p.o_act), (const char*)(ws + O_WDN), 5632, nb, bid}; EpiRes E{p.out, p.out, mod + 5 * 2048}; pg8::gemm_phase(lds, 5632, S, E); }
#ifdef DBG_COPYX
    grid.sync();
    for (size_t i = (size_t)bid * 512 + threadIdx.x; i < (size_t)NTOK * DM / 4; i += (size_t)nb * 512) ((f32x4*)p.out)[i] = ((const f32x4*)p.x)[i];
#endif
}

extern "C" void kernel_launch(void* const* d_in, const int* in_sizes, int n_in, void* d_out, int out_size, void* d_ws, size_t ws_size, hipStream_t stream) {
    static int grid_blocks = 0;
    if (grid_blocks == 0) {
        int dev = 0, cus = 0, per_cu = 0;
        hipGetDevice(&dev); hipDeviceGetAttribute(&cus, hipDeviceAttributeMultiprocessorCount, dev);
        if (hipFuncSetAttribute((const void*)fwd_megakernel, hipFuncAttributeMaxDynamicSharedMemorySize, LDS_BYTES) != hipSuccess) { fprintf(stderr, "kernel_launch: hipFuncSetAttribute failed\n"); grid_blocks = -1; return; }
        if (hipOccupancyMaxActiveBlocksPerMultiprocessor(&per_cu, (const void*)fwd_megakernel, 512, LDS_BYTES) != hipSuccess || per_cu < 1) { fprintf(stderr, "kernel_launch: occupancy query gave %d\n", per_cu); per_cu = 1; }
        (void)hipGetLastError();
        grid_blocks = cus * 1;
    }
    if (grid_blocks < 0) return;
    P p{};
    const float** f = (const float**)&p;
    for (int i = 0; i < 24; ++i) f[i] = (const float*)d_in[i];
    p.out = (float*)d_out; p.ws = (unsigned char*)d_ws;
    const size_t act_bytes = 184549376;
    if (ws_size >= O_U + (size_t)24 * 256 * NTOK * 2 + act_bytes) { p.ns[0] = 20; p.ns[1] = 24; p.ns[2] = 0; p.nsmax = 24; }
    else { p.ns[0] = 16; p.ns[1] = 16; p.ns[2] = 12; p.ns[3] = 0; p.nsmax = 16; }
    p.o_act = (long long)(O_U + (size_t)p.nsmax * 256 * NTOK * 2);
    if (ws_size < (size_t)p.o_act + act_bytes || ws_size < O_MIXEND) { fprintf(stderr, "kernel_launch: workspace too small (%zu)\n", ws_size); return; }
    void* args[] = {&p};
    hipError_t e = hipLaunchCooperativeKernel((void*)fwd_megakernel, dim3(grid_blocks), dim3(512), args, LDS_BYTES, stream);
    if (e != hipSuccess) fprintf(stderr, "cooperative launch failed: %s (grid %d)\n", hipGetErrorString(e), grid_blocks);
}
```

```cpp
#include <hip/hip_runtime.h>
#include <hip/hip_cooperative_groups.h>
#include <cstdio>
namespace cg = cooperative_groups;

#define LAS __attribute__((address_space(3)))
typedef unsigned short bf16_t;
typedef short bf16x8 __attribute__((ext_vector_type(8)));
typedef float f32x4 __attribute__((ext_vector_type(4)));
typedef float f32x2 __attribute__((ext_vector_type(2)));
typedef unsigned u32x4 __attribute__((ext_vector_type(4)));
typedef unsigned u32x2 __attribute__((ext_vector_type(2)));

constexpr int T_ = 8192, NTOK = 16384, NROW = 16896, DM = 2048;
constexpr int LDS_BYTES = 153600;
constexpr float EPS_ = 1e-6f;

constexpr size_t O_MODP = 0;
constexpr size_t O_MOD = O_MODP + 4718592;
constexpr size_t O_ROPE = O_MOD + 147456;
constexpr size_t O_DD = O_ROPE + 32768;
constexpr size_t O_BASE = O_DD + 1081344;
constexpr size_t O_W2IN = O_BASE;
constexpr size_t O_WMRG = O_W2IN + 25165824;
constexpr size_t O_WOUT = O_WMRG + 16777216;
constexpr size_t O_H = O_WOUT + 8388608;
constexpr size_t O_XR = O_H + 69206016;
constexpr size_t O_QA = O_XR + 33554432;
constexpr size_t O_KA = O_QA + 67108864;
constexpr size_t O_VAT = O_KA + 17301504;
constexpr size_t O_KB = O_VAT + 17301504;
constexpr size_t O_QB = O_KB + 34603008;
constexpr size_t O_VBT = O_QB + 33554432;
constexpr size_t O_LR = O_VBT + 69206016;
constexpr size_t O_QF = O_LR + 2162688;
constexpr size_t O_KT = O_QF + 33554432;
constexpr size_t O_MIXEND = O_KT + 69206016;
constexpr size_t O_OF = O_QA;
constexpr size_t O_GA = O_QB;
constexpr size_t O_M = O_QA;
constexpr size_t O_WUP = O_BASE;
constexpr size_t O_WDN = O_WUP + 46137344;
constexpr size_t O_H2 = O_WDN + 23068672;
constexpr size_t O_U = O_H2 + 67108864;

struct P {
    const float *x, *c, *ctx, *c_ctx, *w_mod, *b_mod, *g_mix, *w_in, *q_norm, *k_norm, *sink, *wgf, *bgf, *wgb, *bgb, *gla_norm,
        *w_attn_o, *w_gla_o, *w_out, *g_ffn, *w_up, *conv_w, *conv_b, *w_down;
    float* out;
    unsigned char* ws;
    long long o_act;
    int ns[4];
    int nsmax, pad;
};

typedef __bf16 bf16x2_t __attribute__((ext_vector_type(2)));
__device__ __forceinline__ unsigned cvt_pk_bf16(float lo, float hi) { const f32x2 v = {lo, hi}; const bf16x2_t b = __builtin_convertvector(v, bf16x2_t); return __builtin_bit_cast(unsigned, b); }
__device__ __forceinline__ float bf2f(unsigned short b) { return __uint_as_float(((unsigned)b) << 16); }
__device__ __forceinline__ float bflo(unsigned u) { return __uint_as_float(u << 16); }
__device__ __forceinline__ float bfhi(unsigned u) { return __uint_as_float(u & 0xffff0000u); }
__device__ __forceinline__ bf16_t f2bf(float f) { return (bf16_t)(cvt_pk_bf16(f, 0.f) & 0xffffu); }
__device__ __forceinline__ float wave_sum(float v) {
#pragma unroll
    for (int o = 32; o >= 1; o >>= 1) v += __shfl_xor(v, o);
    return v;
}
__device__ __forceinline__ float sigmoidf_(float x) { return 1.0f / (1.0f + __expf(-x)); }
__device__ __forceinline__ float siluf_(float x) { return x / (1.0f + __expf(-x)); }
__device__ __forceinline__ void unpack8(const u32x4 v, float* f) {
    f[0] = bflo(v.x); f[1] = bfhi(v.x); f[2] = bflo(v.y); f[3] = bfhi(v.y); f[4] = bflo(v.z); f[5] = bfhi(v.z); f[6] = bflo(v.w); f[7] = bfhi(v.w);
}
__device__ __forceinline__ u32x4 pack8(const float* f) {
    u32x4 w; w.x = cvt_pk_bf16(f[0], f[1]); w.y = cvt_pk_bf16(f[2], f[3]); w.z = cvt_pk_bf16(f[4], f[5]); w.w = cvt_pk_bf16(f[6], f[7]); return w;
}
__device__ __forceinline__ int opaque0() { int z; asm volatile("v_mov_b32 %0, 0" : "=v"(z)); return z; }
#define LDS_BARRIER() do { asm volatile("s_waitcnt lgkmcnt(0)" ::: "memory"); __builtin_amdgcn_s_barrier(); asm volatile("" ::: "memory"); } while (0)
#define MFMA16(a, b, c) __builtin_amdgcn_mfma_f32_16x16x32_bf16((a), (b), (c), 0, 0, 0)

namespace pg8 {
constexpr int BM = 256, BK = 64, HALF = 128, HTB = HALF * BK * 2, STAGE_BYTES = 8 * HTB, NXCD = 8, WGM = 8;
__device__ __forceinline__ int lds_byte(int r, int c) { const int st = (r >> 4) * 2 + (c >> 5), rr = r & 15, cc = c & 31, ob = rr * 64 + cc * 2; return st * 1024 + (ob ^ (((ob >> 9) & 1) << 5)); }
__device__ __forceinline__ void stage_rc(int b, int& R, int& C) { const int st = b / 1024, sb = b % 1024, swz = sb ^ (((sb >> 9) & 1) << 5); R = (st >> 1) * 16 + swz / 64; C = (st & 1) * 32 + (swz % 64) / 2; }
__device__ __forceinline__ int perm32(int rho) { const int n = rho >> 4, i = rho & 15; return 8 * (i >> 2) + 4 * n + (i & 3); }

struct Unit { const char* A; const char* B; char* out; int ldc; int kind; int row0; int col0; };

__device__ __forceinline__ void rect_map(int L, int nM, int nN, int& pm, int& pn) {
    const int nwg = nM * nN; int wgid = L;
    { const int q = nwg / NXCD, r = nwg % NXCD, xcd = wgid % NXCD, off = wgid / NXCD; wgid = (xcd < r ? xcd * (q + 1) : r * (q + 1) + (xcd - r) * q) + off; }
    const int nig = WGM * nN, gid = wgid / nig, fm = gid * WGM, gsz = (nM - fm) < WGM ? (nM - fm) : WGM;
    pm = fm + ((wgid % nig) % gsz); pn = (wgid % nig) / gsz;
}

template <class Epi, class Sched>
__device__ __forceinline__ void gemm_phase(LAS unsigned char* lds, const int K, const Sched& S, const Epi& E) {
    const int tid = threadIdx.x + opaque0(), wid = __builtin_amdgcn_readfirstlane(tid >> 6), lane = tid & 63, wr = wid >> 2, wc = wid & 3, fr = lane & 15, fq = lane >> 4;
    const int nt = K / BK;
    unsigned voffA[2], voffB[2];
#pragma unroll
    for (int i = 0; i < 2; ++i) { int R, C; stage_rc(tid * 16 + i * 8192, R, C); const int Rb = (R & ~31) + perm32(R & 31);
        voffA[i] = (unsigned)(R * K + C) * 2u; voffB[i] = (unsigned)(Rb * K + C) * 2u; }
    const size_t kstep = (size_t)(BK * 2);
    const size_t hstep = (size_t)HALF * K * 2;
    const unsigned ldsw = (unsigned)wid * 1024u;
    const int aoff = lds_byte(wr * 64 + fr, fq * 8), boff = lds_byte(wc * 32 + fr, fq * 8);
#define PG8_SA(b, h) (((b) * 2 + (h)) * HTB)
#define PG8_SB(b, h) ((4 + (b) * 2 + (h)) * HTB)
#define PG8_STAGE(bufoff, gbase, voff) do { _Pragma("unroll") for (int _i = 0; _i < 2; ++_i) \
        __builtin_amdgcn_global_load_lds((const unsigned*)((const char*)(gbase) + (voff)[_i]), (LAS unsigned*)(lds + (bufoff) + ldsw + _i * 8192), 16, 0, 0); } while (0)
#define PG8_LDA(dst, b, h) do { _Pragma("unroll") for (int m = 0; m < 4; ++m) _Pragma("unroll") for (int k = 0; k < 2; ++k) dst[m][k] = *(const LAS bf16x8*)(lds + PG8_SA(b, h) + aoff + m * 2048 + k * 1024); } while (0)
#define PG8_LDB(dst, b, h) do { _Pragma("unroll") for (int n = 0; n < 2; ++n) _Pragma("unroll") for (int k = 0; k < 2; ++k) dst[n][k] = *(const LAS bf16x8*)(lds + PG8_SB(b, h) + boff + n * 2048 + k * 1024); } while (0)
#define PG8_MMA(ai, bj, At, Bt) do { __builtin_amdgcn_s_setprio(1); _Pragma("unroll") for (int m = 0; m < 4; ++m) _Pragma("unroll") for (int n = 0; n < 2; ++n) _Pragma("unroll") for (int k = 0; k < 2; ++k) \
        acc[ai][bj][m][n] = __builtin_amdgcn_mfma_f32_16x16x32_bf16(Bt[n][k], At[m][k], acc[ai][bj][m][n], 0, 0, 0); __builtin_amdgcn_s_setprio(0); } while (0)
#define PG8_WAIT_V(n) asm volatile("s_waitcnt vmcnt(" #n ")" ::: "memory")
#define PG8_WAIT_L(n) asm volatile("s_waitcnt lgkmcnt(" #n ")" ::: "memory")
#define PG8_BAR __builtin_amdgcn_s_barrier()
#define PG8_SCHED __builtin_amdgcn_sched_barrier(0)
    Unit cur, nxt; int ui = 0;
    if (!S.next(0, cur)) return;
    f32x4 acc[2][2][4][2];
#pragma unroll
    for (int a = 0; a < 2; ++a)
#pragma unroll
        for (int b = 0; b < 2; ++b)
#pragma unroll
            for (int m = 0; m < 4; ++m)
#pragma unroll
                for (int n = 0; n < 2; ++n) acc[a][b][m][n] = (f32x4){0.f, 0.f, 0.f, 0.f};
    bf16x8 At[4][2], B0[2][2], B1[2][2];
    const char* cA = cur.A; const char* cB = cur.B;
    PG8_STAGE(PG8_SB(0, 0), cB, voffB); PG8_STAGE(PG8_SA(0, 0), cA, voffA); PG8_STAGE(PG8_SB(0, 1), cB + hstep, voffB); PG8_STAGE(PG8_SA(0, 1), cA + hstep, voffA);
    if (wr == 1) PG8_BAR;
    PG8_WAIT_V(4); PG8_BAR;
    PG8_STAGE(PG8_SB(1, 0), cB + kstep, voffB); PG8_STAGE(PG8_SA(1, 0), cA + kstep, voffA); PG8_STAGE(PG8_SB(1, 1), cB + hstep + kstep, voffB);
    PG8_WAIT_V(6); PG8_BAR;
    for (;;) {
        const bool has_next = S.next(ui + 1, nxt);
        const char* nA = has_next ? nxt.A : cA; const char* nB = has_next ? nxt.B : cB;
        for (int t = 0; t < nt; t += 2) {
            const bool last = (t == nt - 2);
            if constexpr (Epi::MID) { if (t == (nt >> 1)) E.mid(acc, cur, wr, wc, fr, fq); }
            const char* a1 = cA + (size_t)(t + 1) * kstep;
            const char* a2 = last ? nA : cA + (size_t)(t + 2) * kstep; const char* b2 = last ? nB : cB + (size_t)(t + 2) * kstep;
            const char* a3 = a2 + kstep; const char* b3 = b2 + kstep;
            PG8_LDB(B0, 0, 0); PG8_SCHED; PG8_LDA(At, 0, 0); PG8_STAGE(PG8_SA(1, 1), a1 + hstep, voffA);
            PG8_WAIT_L(8); PG8_BAR; PG8_WAIT_L(0); PG8_MMA(0, 0, At, B0); PG8_BAR; PG8_SCHED;
            PG8_LDB(B1, 0, 1); PG8_STAGE(PG8_SB(0, 0), b2, voffB);
            PG8_BAR; PG8_WAIT_L(0); PG8_MMA(0, 1, At, B1); PG8_BAR;
            PG8_LDA(At, 0, 1); PG8_STAGE(PG8_SA(0, 0), a2, voffA);
            PG8_BAR; PG8_WAIT_L(0); PG8_MMA(1, 0, At, B0); PG8_BAR; PG8_SCHED;
            PG8_STAGE(PG8_SB(0, 1), b2 + hstep, voffB);
            PG8_WAIT_V(6); PG8_BAR; PG8_MMA(1, 1, At, B1); PG8_BAR;
            PG8_LDB(B0, 1, 0); PG8_SCHED; PG8_LDA(At, 1, 0); PG8_STAGE(PG8_SA(0, 1), a2 + hstep, voffA);
            PG8_WAIT_L(8); PG8_BAR; PG8_WAIT_L(0); PG8_MMA(0, 0, At, B0); PG8_BAR; PG8_SCHED;
            PG8_LDB(B1, 1, 1); PG8_STAGE(PG8_SB(1, 0), b3, voffB);
            PG8_BAR; PG8_WAIT_L(0); PG8_MMA(0, 1, At, B1); PG8_BAR;
            PG8_LDA(At, 1, 1); PG8_STAGE(PG8_SA(1, 0), a3, voffA);
            PG8_BAR; PG8_WAIT_L(0); PG8_MMA(1, 0, At, B0); PG8_BAR; PG8_SCHED;
            PG8_STAGE(PG8_SB(1, 1), b3 + hstep, voffB);
            PG8_WAIT_V(6); PG8_BAR; PG8_MMA(1, 1, At, B1); PG8_BAR;
        }
        E(acc, cur, wr, wc, fr, fq);
        if (!has_next) break;
#pragma unroll
        for (int a = 0; a < 2; ++a)
#pragma unroll
            for (int b = 0; b < 2; ++b)
#pragma unroll
                for (int m = 0; m < 4; ++m)
#pragma unroll
                    for (int n = 0; n < 2; ++n) acc[a][b][m][n] = (f32x4){0.f, 0.f, 0.f, 0.f};
        cur = nxt; cA = nA; cB = nB; ++ui;
    }
    PG8_WAIT_V(0);
    if (wr == 0) PG8_BAR;
    PG8_BAR;
#undef PG8_SA
#undef PG8_SB
#undef PG8_STAGE
#undef PG8_LDA
#undef PG8_LDB
#undef PG8_MMA
#undef PG8_WAIT_V
#undef PG8_WAIT_L
#undef PG8_BAR
#undef PG8_SCHED
}
}
using pg8::Unit;
typedef f32x4 Acc[2][2][4][2];

__device__ __forceinline__ void store_tile_bf16(const Acc& acc, const Unit& u, int wr, int wc, int fr, int fq) {
    bf16_t* base = (bf16_t*)u.out + (size_t)(wr * 64 + fr) * u.ldc + wc * 32 + 8 * fq;
#pragma unroll
    for (int ai = 0; ai < 2; ++ai)
#pragma unroll
        for (int m = 0; m < 4; ++m) {
            bf16_t* rowp = base + (size_t)(ai * 128 + m * 16) * u.ldc;
#pragma unroll
            for (int bj = 0; bj < 2; ++bj) {
                const f32x4 v0 = acc[ai][bj][m][0], v1 = acc[ai][bj][m][1];
                u32x4 w; w.x = cvt_pk_bf16(v0[0], v0[1]); w.y = cvt_pk_bf16(v0[2], v0[3]); w.z = cvt_pk_bf16(v1[0], v1[1]); w.w = cvt_pk_bf16(v1[2], v1[3]);
                *(u32x4*)(rowp + bj * 128) = w;
            }
        }
}

struct SchedProj1 {
    const char* h; const char* w; unsigned char* ws; int G, c;
    __device__ bool next(int i, Unit& u) const {
        const int L = i * G + c; int pm, pn;
        if (L < 64 * 29) pg8::rect_map(L, 64, 29, pm, pn);
        else { const int e = L - 64 * 29; if (e >= 34) return false; pm = 64 + e / 17; const int q = e % 17; pn = q < 4 ? 8 + q : (q < 16 ? 12 + q : 28); }
        const char* ha = h + (size_t)pm * 256 * DM * 2; const char* wa = w + (size_t)pn * 256 * DM * 2;
        u.A = ha; u.B = wa; u.kind = 0; u.row0 = pm * 256; u.col0 = pn * 256;
        if (pn < 8) { u.out = (char*)(ws + O_QA) + ((size_t)pm * 256 * 2048 + pn * 256) * 2; u.ldc = 2048; }
        else if (pn < 10) { u.out = (char*)(ws + O_KA) + ((size_t)pm * 256 * 512 + (pn - 8) * 256) * 2; u.ldc = 512; }
        else if (pn < 12) { u.A = wa; u.B = ha; u.out = (char*)(ws + O_VAT) + ((size_t)(pn - 10) * 256 * NROW + pm * 256) * 2; u.ldc = NROW; }
        else if (pn < 16) { u.out = (char*)(ws + O_QB) + ((size_t)pm * 256 * 1024 + (pn - 12) * 256) * 2; u.ldc = 1024; }
        else if (pn < 20) { u.out = (char*)(ws + O_KB) + ((size_t)pm * 256 * 1024 + (pn - 16) * 256) * 2; u.ldc = 1024; }
        else if (pn < 28) { u.A = wa; u.B = ha; u.out = (char*)(ws + O_VBT) + ((size_t)(pn - 20) * 256 * NROW + pm * 256) * 2; u.ldc = NROW; }
        else { u.kind = 1; u.out = (char*)(ws + O_LR) + (size_t)pm * 256 * 32 * 4; u.ldc = 32; }
        return true;
    }
};
struct EpiProj1 {
    static constexpr bool MID = false;
    __device__ __forceinline__ void mid(Acc&, const Unit&, int, int, int, int) const {}
    __device__ __forceinline__ void operator()(const Acc& acc, const Unit& u, int wr, int wc, int fr, int fq) const {
        if (u.kind == 0) { store_tile_bf16(acc, u, wr, wc, fr, fq); return; }
        if (wc == 0) {
            float* base = (float*)u.out + (size_t)(wr * 64 + fr) * 32 + 8 * fq;
#pragma unroll
            for (int ai = 0; ai < 2; ++ai)
#pragma unroll
                for (int m = 0; m < 4; ++m) { float* rowp = base + (size_t)(ai * 128 + m * 16) * 32; *(f32x4*)rowp = acc[ai][0][m][0]; *(f32x4*)(rowp + 4) = acc[ai][0][m][1]; }
        }
    }
};
struct SchedProj2 {
    const char* h; const char* w; unsigned char* ws; bf16_t* cc; int G, c;
    __device__ bool next(int i, Unit& u) const {
        const int L = i * G + c; if (L >= 64 * 24) return false; int pm, pn; pg8::rect_map(L, 64, 24, pm, pn);
        u.A = h + (size_t)pm * 256 * DM * 2; u.B = w + (size_t)pn * 256 * DM * 2; u.row0 = pm * 256; u.col0 = pn * 256;
        if (pn < 8) { u.kind = 2; u.out = (char*)(cc + (size_t)pm * 256 * 4096 + 2048 + pn * 256); u.ldc = 4096; }
        else if (pn < 16) { u.kind = 0; u.out = (char*)(ws + O_GA) + ((size_t)pm * 256 * 2048 + (pn - 8) * 256) * 2; u.ldc = 2048; }
        else { u.kind = 0; u.out = (char*)(ws + O_GA + 67108864) + ((size_t)pm * 256 * 2048 + (pn - 16) * 256) * 2; u.ldc = 2048; }
        return true;
    }
};
struct EpiProj2 {
    static constexpr bool MID = false;
    __device__ __forceinline__ void mid(Acc&, const Unit&, int, int, int, int) const {}
    __device__ __forceinline__ void operator()(const Acc& acc, const Unit& u, int wr, int wc, int fr, int fq) const {
        if (u.kind == 0) { store_tile_bf16(acc, u, wr, wc, fr, fq); return; }
        bf16_t* base = (bf16_t*)u.out + (size_t)(wr * 64 + fr) * u.ldc + wc * 32 + 8 * fq;
#pragma unroll
        for (int ai = 0; ai < 2; ++ai)
#pragma unroll
            for (int m = 0; m < 4; ++m) {
                bf16_t* rowp = base + (size_t)(ai * 128 + m * 16) * u.ldc;
#pragma unroll
                for (int bj = 0; bj < 2; ++bj) {
                    const f32x4 v0 = acc[ai][bj][m][0], v1 = acc[ai][bj][m][1];
                    float y[8]; unpack8(*(const u32x4*)(rowp + bj * 128), y);
                    y[0] *= siluf_(v0[0]); y[1] *= siluf_(v0[1]); y[2] *= siluf_(v0[2]); y[3] *= siluf_(v0[3]);
                    y[4] *= siluf_(v1[0]); y[5] *= siluf_(v1[1]); y[6] *= siluf_(v1[2]); y[7] *= siluf_(v1[3]);
                    *(u32x4*)(rowp + bj * 128) = pack8(y);
                }
            }
    }
};
struct SchedMerge {
    const char* a; const char* w; unsigned char* ws; int G, c;
    __device__ bool next(int i, Unit& u) const {
        const int L = i * G + c; if (L >= 64 * 8) return false; int pm, pn; pg8::rect_map(L, 64, 8, pm, pn);
        u.A = a + (size_t)pm * 256 * 4096 * 2; u.B = w + (size_t)pn * 256 * 4096 * 2; u.row0 = pm * 256; u.col0 = pn * 256; u.kind = 0;
        u.out = (char*)(ws + O_M) + ((size_t)pm * 256 * 2048 + pn * 256) * 2; u.ldc = 2048; return true;
    }
};
struct EpiMerge {
    static constexpr bool MID = true;
    const bf16_t* ga; const bf16_t* gb;
    __device__ __forceinline__ void mid(Acc& acc, const Unit& u, int wr, int wc, int fr, int fq) const {
        const unsigned lo = (unsigned)(((wr * 64 + fr) * 2048 + wc * 32 + 8 * fq) * 2 + opaque0());
#pragma unroll
        for (int ai = 0; ai < 2; ++ai)
#pragma unroll
            for (int m = 0; m < 4; ++m)
#pragma unroll
                for (int bj = 0; bj < 2; ++bj) {
                    const size_t ub = ((size_t)(u.row0 + ai * 128 + m * 16) * 2048 + u.col0 + bj * 128) * 2;
                    float a[8], b[8]; unpack8(*(const u32x4*)((const char*)ga + ub + lo), a); unpack8(*(const u32x4*)((const char*)gb + ub + lo), b);
#pragma unroll
                    for (int e = 0; e < 8; ++e) { const float r = (1.0f + __expf(-b[e])) / (1.0f + __expf(-a[e])); acc[ai][bj][m][e >> 2][e & 3] *= r; }
                    __builtin_amdgcn_sched_barrier(0);
                }
    }
    __device__ __forceinline__ void operator()(const Acc& acc, const Unit& u, int wr, int wc, int fr, int fq) const {
        const unsigned lo = (unsigned)(((wr * 64 + fr) * 2048 + wc * 32 + 8 * fq) * 2 + opaque0());
        char* outp = (char*)u.out - ((size_t)u.row0 * 2048 + u.col0) * 2;
#pragma unroll
        for (int ai = 0; ai < 2; ++ai)
#pragma unroll
            for (int m = 0; m < 4; ++m)
#pragma unroll
                for (int bj = 0; bj < 2; ++bj) {
                    const size_t ub = ((size_t)(u.row0 + ai * 128 + m * 16) * 2048 + u.col0 + bj * 128) * 2;
                    float b[8], y[8]; unpack8(*(const u32x4*)((const char*)gb + ub + lo), b);
#pragma unroll
                    for (int e = 0; e < 8; ++e) y[e] = acc[ai][bj][m][e >> 2][e & 3] * sigmoidf_(b[e]);
                    *(u32x4*)(outp + ub + lo) = pack8(y);
                    __builtin_amdgcn_sched_barrier(0);
                }
    }
};
struct SchedRes {
    const char* a; const char* w; int K, G, c;
    __device__ bool next(int i, Unit& u) const {
        const int L = i * G + c; if (L >= 64 * 8) return false; int pm, pn; pg8::rect_map(L, 64, 8, pm, pn);
        u.A = a + (size_t)pm * 256 * K * 2; u.B = w + (size_t)pn * 256 * K * 2; u.row0 = pm * 256; u.col0 = pn * 256; u.kind = 0; u.out = nullptr; u.ldc = 2048; return true;
    }
};
struct EpiRes {
    static constexpr bool MID = false;
    const float* base; float* out; const float* gate;
    __device__ __forceinline__ void mid(Acc&, const Unit&, int, int, int, int) const {}
    __device__ __forceinline__ void operator()(const Acc& acc, const Unit& u, int wr, int wc, int fr, int fq) const {
        const int col = u.col0 + wc * 32 + 8 * fq;
        const float* gp = gate + (size_t)(u.row0 >> 13) * 12288 + col;
        f32x4 g[2][2];
#pragma unroll
        for (int bj = 0; bj < 2; ++bj) { g[bj][0] = *(const f32x4*)(gp + bj * 128); g[bj][1] = *(const f32x4*)(gp + bj * 128 + 4); }
        const size_t o0 = (size_t)(u.row0 + wr * 64 + fr) * 2048 + col;
#pragma unroll
        for (int ai = 0; ai < 2; ++ai)
#pragma unroll
            for (int m = 0; m < 4; ++m)
#pragma unroll
                for (int bj = 0; bj < 2; ++bj) {
                    const size_t o = o0 + (size_t)(ai * 128 + m * 16) * 2048 + bj * 128;
                    const f32x4 x0 = *(const f32x4*)(base + o), x1 = *(const f32x4*)(base + o + 4);
                    *(f32x4*)(out + o) = x0 + g[bj][0] * acc[ai][bj][m][0];
                    *(f32x4*)(out + o + 4) = x1 + g[bj][1] * acc[ai][bj][m][1];
                }
    }
};
struct SchedUp {
    const char* a; const char* w; char* uo; int j0, ns, ldu, G, c;
    __device__ bool next(int i, Unit& u) const {
        const int L = i * G + c; if (L >= 64 * ns) return false; int pm, pn; pg8::rect_map(L, 64, ns, pm, pn);
        u.A = a + (size_t)pm * 256 * DM * 2; u.B = w + (size_t)(j0 + pn) * 256 * DM * 2; u.row0 = pm * 256; u.col0 = pn * 256; u.kind = 0;
        u.out = uo + ((size_t)pm * 256 * ldu + pn * 256) * 2; u.ldc = ldu; return true;
    }
};
struct EpiStore {
    static constexpr bool MID = false;
    __device__ __forceinline__ void mid(Acc&, const Unit&, int, int, int, int) const {}
    __device__ __forceinline__ void operator()(const Acc& acc, const Unit& u, int wr, int wc, int fr, int fq) const { store_tile_bf16(acc, u, wr, wc, fr, fq); }
};

__device__ __forceinline__ int srccol(int kind, int n) {
    if (kind == 0) return n;
    if (kind == 1) return n < 7168 ? n : (n < 7200 ? n + 2048 : -1);
    if (kind == 2) return n < 2048 ? 7168 + n : 9248 + (n - 2048);
    const int j = n >> 8, i = n & 255; return i < 128 ? 128 * j + i : 5632 + 128 * j + (i - 128);
}
__device__ void transpose_tile(LAS float* tl, const float* __restrict__ src, int ld_src, bf16_t* dst, int ld_dst, int k0, int n0, int kind, int koff) {
    const int tid = threadIdx.x + opaque0();
    { const int kr = tid >> 4, nq = (tid & 15) * 4; const int sc = srccol(kind, n0 + nq);
#pragma unroll
      for (int pass = 0; pass < 2; ++pass) { const int k = kr + 32 * pass;
          f32x4 v = (f32x4){0.f, 0.f, 0.f, 0.f}; if (sc >= 0) v = *(const f32x4*)(src + (size_t)(k0 + k) * ld_src + sc);
          tl[(nq + 0) * 65 + k] = v[0]; tl[(nq + 1) * 65 + k] = v[1]; tl[(nq + 2) * 65 + k] = v[2]; tl[(nq + 3) * 65 + k] = v[3]; } }
    __syncthreads();
    { const int n = tid >> 3, kc = (tid & 7) * 8; float f[8];
#pragma unroll
      for (int e = 0; e < 8; ++e) f[e] = tl[n * 65 + kc + e];
      *(u32x4*)(dst + (size_t)(n0 + n) * ld_dst + koff + k0 + kc) = pack8(f); }
    __syncthreads();
}
__device__ void transpose_job(LAS float* tl, const float* src, int ld_src, bf16_t* dst, int ld_dst, int K, int N, int kind, int koff, int it) {
    const int nnt = N / 64; const int kt = it / nnt, ntl = it % nnt; (void)K;
    transpose_tile(tl, src, ld_src, dst, ld_dst, kt * 64, ntl * 64, kind, koff);
}

__device__ void phase0(LAS unsigned char* lds, const P& p) {
    LAS float* tl = (LAS float*)lds;
    unsigned char* ws = p.ws;
    const int nb = gridDim.x, bid = blockIdx.x, tid = threadIdx.x + opaque0();
    for (int it = bid; it < 256; it += nb) {
        const int kc = it >> 3, nch = it & 7; float a[3][3];
#pragma unroll
        for (int v = 0; v < 3; ++v)
#pragma unroll
            for (int j = 0; j < 3; ++j) a[v][j] = 0.f;
        for (int k = kc * 64; k < kc * 64 + 64; ++k) {
            const float s0 = siluf_(p.c[k]), s1 = siluf_(p.c[2048 + k]), s2 = siluf_(p.c_ctx[k]);
            const float* wr = p.w_mod + (size_t)k * 12288 + nch * 1536 + tid;
#pragma unroll
            for (int j = 0; j < 3; ++j) { const float w = wr[j * 512]; a[0][j] += s0 * w; a[1][j] += s1 * w; a[2][j] += s2 * w; }
        }
        float* mp = (float*)(ws + O_MODP) + (size_t)kc * 3 * 12288 + nch * 1536 + tid;
#pragma unroll
        for (int v = 0; v < 3; ++v)
#pragma unroll
            for (int j = 0; j < 3; ++j) mp[(size_t)v * 12288 + j * 512] = a[v][j];
    }
    for (int i = bid * 512 + tid; i < 128 * 32; i += nb * 512) {
        const int pos = i >> 5, f = i & 31;
        const float inv = exp2f(-(float)f * (13.287712379549449f / 32.0f));
        const float ang = (float)pos * inv;
        const double ad = (double)ang; const double n = rint(ad * 0.15915494309189535); double r = ad - n * 6.283185307179586476925;
        r *= 0.125; const double r2 = r * r;
        double s = r * (1.0 + r2 * (-1.0 / 6 + r2 * (1.0 / 120 + r2 * (-1.0 / 5040 + r2 * (1.0 / 362880 + r2 * (-1.0 / 39916800))))));
        double c = 1.0 + r2 * (-0.5 + r2 * (1.0 / 24 + r2 * (-1.0 / 720 + r2 * (1.0 / 40320 + r2 * (-1.0 / 3628800 + r2 * (1.0 / 479001600))))));
#pragma unroll
        for (int q = 0; q < 3; ++q) { const double s2 = 2.0 * s * c, c2 = c * c - s * s; s = s2; c = c2; }
        ((f32x2*)(ws + O_ROPE))[i] = (f32x2){(float)c, (float)s};
    }
    const int J0 = 32 * 116, J1 = 32 * 96, J2 = 1024, J3 = 1024, J4 = 1024;
    for (int it = bid; it < J0 + J1 + J2 + J3 + J4; it += nb) {
        int q = it;
        if (q < J0) { transpose_job(tl, p.w_in, 13344, (bf16_t*)(ws + O_XR), 2048, 2048, 7424, 1, 0, q); continue; } q -= J0;
        if (q < J1) { transpose_job(tl, p.w_in, 13344, (bf16_t*)(ws + O_W2IN), 2048, 2048, 6144, 2, 0, q); continue; } q -= J1;
        if (q < J2) { transpose_job(tl, p.w_attn_o, 2048, (bf16_t*)(ws + O_WMRG), 4096, 2048, 2048, 0, 0, q); continue; } q -= J2;
        if (q < J3) { transpose_job(tl, p.w_gla_o, 2048, (bf16_t*)(ws + O_WMRG), 4096, 2048, 2048, 0, 2048, q); continue; } q -= J3;
        transpose_job(tl, p.w_out, 2048, (bf16_t*)(ws + O_WOUT), 2048, 2048, 2048, 0, 0, q);
    }
}
__device__ void phase_modreduce(const P& p) {
    const float* mp = (const float*)(p.ws + O_MODP); float* mod = (float*)(p.ws + O_MOD);
    for (int i = blockIdx.x * 512 + threadIdx.x; i < 3 * 12288; i += gridDim.x * 512) {
        float s = p.b_mod[i % 12288];
        for (int kc = 0; kc < 32; ++kc) s += mp[(size_t)kc * 3 * 12288 + i];
        mod[i] = s;
    }
}
__device__ void phase_modulate(const float* xlat, const float* xctx, const float* g, const float* mod, int sh, int sc, bf16_t* h, int nrows) {
    const int tix = threadIdx.x + opaque0(); const int lane = tix & 63, gw = blockIdx.x * 8 + (tix >> 6), nw = gridDim.x * 8;
    for (int r = gw; r < nrows; r += nw) {
        const float* xr = r < NTOK ? xlat + (size_t)r * DM : xctx + (size_t)(r - NTOK) * DM;
        const float* mv = mod + (size_t)(r < NTOK ? (r >> 13) : 2) * 12288;
        f32x4 v[8]; float ss = 0.f;
#pragma unroll
        for (int i = 0; i < 8; ++i) { v[i] = *(const f32x4*)(xr + (i * 64 + lane) * 4); ss += v[i][0] * v[i][0] + v[i][1] * v[i][1] + v[i][2] * v[i][2] + v[i][3] * v[i][3]; }
        ss = wave_sum(ss); const float rs = rsqrtf(ss * (1.0f / DM) + EPS_);
#pragma unroll
        for (int i = 0; i < 8; ++i) { const int cidx = (i * 64 + lane) * 4;
            const f32x4 gg = *(const f32x4*)(g + cidx), s1 = *(const f32x4*)(mv + sc * 2048 + cidx), s0 = *(const f32x4*)(mv + sh * 2048 + cidx);
            const f32x4 y = v[i] * rs * gg * (s1 + 1.0f) + s0;
            u32x2 w; w.x = cvt_pk_bf16(y[0], y[1]); w.y = cvt_pk_bf16(y[2], y[3]); *(u32x2*)(h + (size_t)r * DM + cidx) = w; }
    }
}

__device__ __forceinline__ void normrope8x4(float (&y)[4][8], const float* nw, int dofs, float rs, bool rope, int t, const f32x2* tab) {
#pragma unroll
    for (int s = 0; s < 4; ++s) { const f32x4 w0 = *(const f32x4*)(nw + s * 32 + dofs), w1 = *(const f32x4*)(nw + s * 32 + dofs + 4);
#pragma unroll
        for (int e = 0; e < 4; ++e) { y[s][e] *= rs * w0[e]; y[s][4 + e] *= rs * w1[e]; } }
    if (rope) {
#pragma unroll
        for (int s = 0; s < 2; ++s) { const int pos = s == 0 ? (t >> 6) : (t & 63); const f32x2* tp = tab + pos * 32 + dofs;
#pragma unroll
            for (int e = 0; e < 8; ++e) { const f32x2 cs = tp[e]; const float x1 = y[s][e], x2 = y[s + 2][e]; y[s][e] = x1 * cs.x - x2 * cs.y; y[s + 2][e] = x2 * cs.x + x1 * cs.y; } }
    }
}
__device__ void attn_item(LAS unsigned char* lds, const P& p, bf16_t* cc, int item) {
    const int tid = threadIdx.x + opaque0(), w = __builtin_amdgcn_readfirstlane(tid >> 6), lane = tid & 63, fr = lane & 15, fq = lane >> 4;
    const int pair = item & 1, kvh = (item >> 1) & 3, qb = (item >> 3) & 63, b = item >> 9;
    LAS bf16_t* Ks = (LAS bf16_t*)lds; LAS bf16_t* Vs = Ks + 128 * 136; LAS bf16_t* Ps = Vs + 128 * 136 + w * (32 * 136);
    const bf16_t* QA = (const bf16_t*)(p.ws + O_QA); const bf16_t* KA = (const bf16_t*)(p.ws + O_KA); const bf16_t* VAT = (const bf16_t*)(p.ws + O_VAT);
    const f32x2* tab = (const f32x2*)(p.ws + O_ROPE);
    const int hq = kvh * 4 + pair * 2 + (w >> 2), rc = w & 3, qrow0 = qb * 128 + rc * 32;
    const float SC = 0.08838834764831845f * 1.4426950408889634f;
    bf16x8 qf[2][4];
#pragma unroll
    for (int mt = 0; mt < 2; ++mt) {
        const int t = qrow0 + mt * 16 + fr; const bf16_t* src = QA + (size_t)(b * T_ + t) * 2048 + hq * 128 + fq * 8;
        float y[4][8]; float ss = 0.f;
#pragma unroll
        for (int s = 0; s < 4; ++s) { unpack8(*(const u32x4*)(src + s * 32), y[s]);
#pragma unroll
            for (int e = 0; e < 8; ++e) ss += y[s][e] * y[s][e]; }
        ss += __shfl_xor(ss, 16); ss += __shfl_xor(ss, 32);
        const float rs = rsqrtf(ss * (1.0f / 128) + EPS_);
        normrope8x4(y, p.q_norm, fq * 8, rs, true, t, tab);
#pragma unroll
        for (int s = 0; s < 4; ++s) {
#pragma unroll
            for (int e = 0; e < 8; ++e) y[s][e] *= SC;
            const u32x4 pk = pack8(y[s]); qf[mt][s] = *(const bf16x8*)&pk; }
    }
    f32x4 o[2][8];
#pragma unroll
    for (int mt = 0; mt < 2; ++mt)
#pragma unroll
        for (int n = 0; n < 8; ++n) o[mt][n] = (f32x4){0.f, 0.f, 0.f, 0.f};
    float mrun[2][4], lrun[2][4];
    { const float sk = p.sink[hq] * 1.4426950408889634f;
#pragma unroll
      for (int mt = 0; mt < 2; ++mt)
#pragma unroll
          for (int j = 0; j < 4; ++j) { mrun[mt][j] = sk; lrun[mt][j] = fr == 0 ? 1.0f : 0.0f; } }
    for (int jj = 0; jj < 5; ++jj) {
        int tokbase, mtype = 0, tpos0 = 0; bool lat = jj < 3;
        if (lat) { const int j = qb - 1 + jj; if (j < 0 || j > 63) continue; tokbase = b * T_ + j * 128; tpos0 = j * 128; mtype = jj == 0 ? 1 : (jj == 2 ? 2 : 0); }
        else tokbase = NTOK + b * 256 + (jj - 3) * 128;
        const int mlo = mtype == 1 ? 0 : -100000, mhi = mtype == 2 ? 0 : 100000;
        const int dl = fr - rc * 32 - fq * 4 + opaque0();
        __syncthreads();
        {
            const int key = tid >> 2, part = tid & 3; const bf16_t* src = KA + (size_t)(tokbase + key) * 512 + kvh * 128 + part * 8;
            float y[4][8]; float ss = 0.f;
#pragma unroll
            for (int s = 0; s < 4; ++s) { unpack8(*(const u32x4*)(src + s * 32), y[s]);
#pragma unroll
                for (int e = 0; e < 8; ++e) ss += y[s][e] * y[s][e]; }
            ss += __shfl_xor(ss, 1); ss += __shfl_xor(ss, 2);
            const float rs = rsqrtf(ss * (1.0f / 128) + EPS_);
            normrope8x4(y, p.k_norm, part * 8, rs, lat, tpos0 + key, tab);
#pragma unroll
            for (int s = 0; s < 4; ++s) *(LAS u32x4*)(Ks + key * 136 + s * 32 + part * 8) = pack8(y[s]);
            const bf16_t* vsrc = VAT + (size_t)(kvh * 128 + key) * NROW + tokbase + part * 8;
#pragma unroll
            for (int s = 0; s < 4; ++s) *(LAS u32x4*)(Vs + key * 136 + s * 32 + part * 8) = *(const u32x4*)(vsrc + s * 32);
        }
        __syncthreads();
#pragma unroll
        for (int mt = 0; mt < 2; ++mt) {
            f32x4 sacc[8];
#pragma unroll
            for (int n = 0; n < 8; ++n) sacc[n] = (f32x4){0.f, 0.f, 0.f, 0.f};
#pragma unroll
            for (int s = 0; s < 4; ++s) {
#pragma unroll
                for (int n = 0; n < 8; ++n) { const bf16x8 kf = *(const LAS bf16x8*)(Ks + (n * 16 + fr) * 136 + s * 32 + fq * 8); sacc[n] = MFMA16(qf[mt][s], kf, sacc[n]); }
                __builtin_amdgcn_sched_barrier(0); }
#pragma unroll
            for (int j = 0; j < 4; ++j) {
                float mx = -INFINITY;
#pragma unroll
                for (int n = 0; n < 8; ++n) { const int dkq = dl + (n * 16 - mt * 16 - j); float v = sacc[n][j];
                    if (dkq < mlo || dkq > mhi) v = -INFINITY; sacc[n][j] = v; mx = fmaxf(mx, v); }
                mx = fmaxf(mx, __shfl_xor(mx, 1)); mx = fmaxf(mx, __shfl_xor(mx, 2)); mx = fmaxf(mx, __shfl_xor(mx, 4)); mx = fmaxf(mx, __shfl_xor(mx, 8));
                const float mn = fmaxf(mrun[mt][j], mx), al = exp2f(mrun[mt][j] - mn); mrun[mt][j] = mn;
                float ps = 0.f;
#pragma unroll
                for (int n = 0; n < 8; ++n) { const float pv = exp2f(sacc[n][j] - mn); ps += pv; o[mt][n][j] *= al;
                    Ps[(mt * 16 + fq * 4 + j) * 136 + n * 16 + fr] = f2bf(pv); }
                lrun[mt][j] = lrun[mt][j] * al + ps;
            }
            __builtin_amdgcn_sched_barrier(0);
        }
        __syncthreads();
#pragma unroll
        for (int s = 0; s < 4; ++s) {
            const bf16x8 p0 = *(const LAS bf16x8*)(Ps + fr * 136 + s * 32 + fq * 8), p1 = *(const LAS bf16x8*)(Ps + (16 + fr) * 136 + s * 32 + fq * 8);
#pragma unroll
            for (int n = 0; n < 8; ++n) { const bf16x8 vf = *(const LAS bf16x8*)(Vs + (n * 16 + fr) * 136 + s * 32 + fq * 8);
                o[0][n] = MFMA16(p0, vf, o[0][n]); o[1][n] = MFMA16(p1, vf, o[1][n]); }
            __builtin_amdgcn_sched_barrier(0);
        }
    }
#pragma unroll
    for (int mt = 0; mt < 2; ++mt)
#pragma unroll
        for (int j = 0; j < 4; ++j) {
            float l = lrun[mt][j]; l += __shfl_xor(l, 1); l += __shfl_xor(l, 2); l += __shfl_xor(l, 4); l += __shfl_xor(l, 8);
            const float inv = 1.0f / l; bf16_t* dst = cc + (size_t)(b * T_ + qrow0 + mt * 16 + fq * 4 + j) * 4096 + hq * 128 + fr;
#pragma unroll
            for (int n = 0; n < 8; ++n) dst[n * 16] = f2bf(o[mt][n][j] * inv);
        }
}

__device__ void glaprep_item(LAS unsigned char* lds, const P& p, int item) {
    const int tid = threadIdx.x + opaque0(), w = __builtin_amdgcn_readfirstlane(tid >> 6), lane = tid & 63, fr = lane & 15, fq = lane >> 4;
    const int ck = item % 66, h = (item / 66) & 3, b = item / 264;
    const bool lat = ck < 64; const int r0 = lat ? b * T_ + ck * 128 : NTOK + b * 256 + (ck - 64) * 128;
    LAS bf16_t* Qs = (LAS bf16_t*)lds; LAS bf16_t* Ks = Qs + 128 * 264; LAS float* lrs = (LAS float*)(lds + 2 * 128 * 264 * 2); LAS float* seg = lrs + 128 * 32;
    unsigned char* ws = p.ws;
    bf16_t* QB = (bf16_t*)(ws + O_QB); bf16_t* QF = (bf16_t*)(ws + O_QF); const bf16_t* KB = (const bf16_t*)(ws + O_KB);
    __syncthreads();
    { const f32x4* src = (const f32x4*)((const float*)(ws + O_LR) + (size_t)r0 * 32); ((LAS f32x4*)lrs)[tid] = src[tid]; ((LAS f32x4*)lrs)[tid + 512] = src[tid + 512]; }
    const int half = tid >> 8, d = tid & 255, gc = h * 256 + d;
    for (int dir = 0; dir < 2; ++dir) {
        const int chain = dir * 8 + b * 4 + h;
        const float* wg = dir == 0 ? p.wgf : p.wgb; const float bias = (dir == 0 ? p.bgf : p.bgb)[gc];
        float wv[16];
#pragma unroll
        for (int j = 0; j < 16; ++j) wv[j] = wg[j * 1024 + gc];
        __syncthreads();
        float carry = 0.f;
        bf16_t* qdst = dir == 0 ? QF : QB;
#pragma unroll 1
        for (int rnd = 0; rnd < 2; ++rnd) {
            float bl[32]; float run = 0.f;
            const int ibase = rnd * 64 + half * 32;
#pragma unroll
            for (int ii = 0; ii < 32; ++ii) {
                const int i = ibase + ii, tok = dir == 0 ? i : 127 - i;
                const LAS f32x4* lp = (const LAS f32x4*)(lrs + tok * 32 + dir * 16);
                float xg = bias;
#pragma unroll
                for (int q = 0; q < 4; ++q) { const f32x4 l4 = lp[q]; xg += l4[0] * wv[q * 4] + l4[1] * wv[q * 4 + 1] + l4[2] * wv[q * 4 + 2] + l4[3] * wv[q * 4 + 3]; }
                const float ls = fminf(xg, 0.f) - __logf(1.0f + __expf(-fabsf(xg)));
                run += ls * 0.0625f; bl[ii] = run;
            }
            __syncthreads();
            seg[half * 256 + d] = run;
            __syncthreads();
            const float s0 = seg[d], s1 = seg[256 + d];
            const float off = carry + (half == 1 ? s0 : 0.f);
            carry += s0 + s1;
#pragma unroll
            for (int ii = 0; ii < 32; ++ii) {
                const int i = ibase + ii, tok = dir == 0 ? i : 127 - i;
                const float bb = bl[ii] + off; const float eb = __expf(bb), ieb = __expf(-bb);
                const size_t gi = (size_t)(r0 + tok) * 1024 + gc;
                Ks[tok * 264 + d] = f2bf(bf2f(KB[gi]) * ieb);
                if (lat) { const bf16_t qv = f2bf(bf2f(QB[gi]) * 0.0625f * eb); Qs[tok * 264 + d] = qv; qdst[gi] = qv; }
                if ((ii & 7) == 7) __builtin_amdgcn_sched_barrier(0);
            }
        }
        if (half == 1) ((float*)(ws + O_DD))[((size_t)chain * 66 + ck) * 256 + d] = __expf(carry);
        __syncthreads();
        if (lat) {
            f32x4 a[8];
#pragma unroll
            for (int n = 0; n < 8; ++n) a[n] = (f32x4){0.f, 0.f, 0.f, 0.f};
#pragma unroll
            for (int s = 0; s < 8; ++s) { const bf16x8 qfr = *(const LAS bf16x8*)(Qs + (16 * w + fr) * 264 + s * 32 + fq * 8);
#pragma unroll
                for (int n = 0; n < 8; ++n) { const bf16x8 kfr = *(const LAS bf16x8*)(Ks + (n * 16 + fr) * 264 + s * 32 + fq * 8); a[n] = MFMA16(kfr, qfr, a[n]); }
                __builtin_amdgcn_sched_barrier(0); }
            bf16_t* ab = (bf16_t*)(ws + O_XR) + ((size_t)(chain * 64 + ck) * 128 + 16 * w + fr) * 128;
            const int cmr = (fq * 4 - 16 * w - fr + opaque0()) * (dir == 0 ? 1 : -1);
#pragma unroll
            for (int n = 0; n < 8; ++n) { float v[4];
#pragma unroll
                for (int j = 0; j < 4; ++j) { const int dcr = cmr + (dir == 0 ? (n * 16 + j) : -(n * 16 + j)); v[j] = dcr <= 0 ? a[n][j] : 0.f; }
                u32x2 pk; pk.x = cvt_pk_bf16(v[0], v[1]); pk.y = cvt_pk_bf16(v[2], v[3]); *(u32x2*)(ab + n * 16 + fq * 4) = pk; }
        }
        {
            bf16_t* kt = (bf16_t*)(ws + O_KT) + ((size_t)dir * 1024 + (size_t)gc) * NROW + r0;
#pragma unroll
            for (int it = 0; it < 8; ++it) { const int tc = it * 2 + half; unsigned short e[8];
#pragma unroll
                for (int q = 0; q < 8; ++q) e[q] = Ks[(tc * 8 + q) * 264 + d];
                u32x4 pk; pk.x = e[0] | ((unsigned)e[1] << 16); pk.y = e[2] | ((unsigned)e[3] << 16); pk.z = e[4] | ((unsigned)e[5] << 16); pk.w = e[6] | ((unsigned)e[7] << 16);
                *(u32x4*)(kt + tc * 8) = pk; }
        }
    }
}

__device__ void glaseq_item(LAS unsigned char* lds, const P& p, int item) {
    const int tid = threadIdx.x + opaque0(), w = __builtin_amdgcn_readfirstlane(tid >> 6), lane = tid & 63, fr = lane & 15, fq = lane >> 4;
    const int chain = item & 15, sl = item >> 4, dir = chain >> 3, b = (chain >> 2) & 1, h = chain & 3;
    unsigned char* ws = p.ws;
    LAS bf16_t* Ss = (LAS bf16_t*)lds;
    const bf16_t* VBT = (const bf16_t*)(ws + O_VBT) + (size_t)(h * 512 + sl * 32 + fr) * NROW + fq * 8;
    const bf16_t* KT = (const bf16_t*)(ws + O_KT) + ((size_t)dir * 1024 + h * 256 + 32 * w + fr) * NROW + fq * 8;
    const bf16_t* QT = (const bf16_t*)(ws + (dir == 0 ? O_QF : O_QB));
    const bf16_t* AB = (const bf16_t*)(ws + O_XR) + (size_t)chain * 64 * 128 * 128;
    const float* DD = (const float*)(ws + O_DD) + (size_t)chain * 66 * 256 + 32 * w + fq * 4;
    bf16_t* OB = (bf16_t*)(ws + O_OF) + (size_t)dir * NTOK * 2048;
    f32x4 st[2][2];
#pragma unroll
    for (int t = 0; t < 2; ++t)
#pragma unroll
        for (int n = 0; n < 2; ++n) st[t][n] = (f32x4){0.f, 0.f, 0.f, 0.f};
#define GS_CK(s_) (dir == 0 ? ((s_) < 2 ? 64 + (s_) : (s_) - 2) : 65 - (s_))
#define GS_R0(s_, ck_) ((s_) >= 2 ? b * T_ + (ck_) * 128 : NTOK + b * 256 + ((ck_) - 64) * 128)
#define GS_LOAD(VF, KF, DDv, s_) do { const int ck_ = GS_CK(s_); const int r0_ = GS_R0(s_, ck_); \
        _Pragma("unroll") for (int n = 0; n < 2; ++n) _Pragma("unroll") for (int q = 0; q < 4; ++q) { \
            VF[n][q] = *(const bf16x8*)(VBT + (size_t)n * 16 * NROW + r0_ + q * 32); KF[n][q] = *(const bf16x8*)(KT + (size_t)n * 16 * NROW + r0_ + q * 32); } \
        DDv[0] = *(const f32x4*)(DD + (size_t)ck_ * 256); DDv[1] = *(const f32x4*)(DD + (size_t)ck_ * 256 + 16); } while (0)
#define GS_UPDATE(VF, KF, DDv) do { _Pragma("unroll") for (int t = 0; t < 2; ++t) _Pragma("unroll") for (int n = 0; n < 2; ++n) { f32x4 tmp = st[t][n]; \
        _Pragma("unroll") for (int q = 0; q < 4; ++q) tmp = MFMA16(KF[t][q], VF[n][q], tmp); st[t][n] = tmp * DDv[t]; } } while (0)
#define GS_LOADQA(s_) do { const int ck_ = GS_CK(s_); const int r0_ = GS_R0(s_, ck_); \
        const bf16_t* qp_ = QT + (size_t)(r0_ + 16 * w + fr) * 1024 + h * 256 + fq * 8; const bf16_t* ap_ = AB + ((size_t)ck_ * 128 + 16 * w + fr) * 128 + fq * 8; \
        _Pragma("unroll") for (int q = 0; q < 8; ++q) qfr[q] = *(const bf16x8*)(qp_ + q * 32); \
        _Pragma("unroll") for (int q = 0; q < 4; ++q) af[q] = *(const bf16x8*)(ap_ + q * 32); } while (0)
    bf16x8 vfA[2][4], kfA[2][4], vfB[2][4], kfB[2][4], qfr[8], af[4]; f32x4 ddA[2], ddB[2];
    __syncthreads();
    GS_LOAD(vfA, kfA, ddA, 0); GS_LOAD(vfB, kfB, ddB, 1);
    GS_UPDATE(vfA, kfA, ddA);
    GS_LOAD(vfA, kfA, ddA, 2); GS_LOADQA(2);
    GS_UPDATE(vfB, kfB, ddB);
#define GS_STEP(VF, KF, DDv, VFN, KFN, DDN, s_) do { \
        const int sn_ = (s_) + 1 < 66 ? (s_) + 1 : 65; \
        GS_LOAD(VFN, KFN, DDN, sn_); \
        LDS_BARRIER(); \
        _Pragma("unroll") for (int t = 0; t < 2; ++t) _Pragma("unroll") for (int n = 0; n < 2; ++n) { u32x2 pk; pk.x = cvt_pk_bf16(st[t][n][0], st[t][n][1]); pk.y = cvt_pk_bf16(st[t][n][2], st[t][n][3]); \
            *(LAS u32x2*)(Ss + (n * 16 + fr) * 264 + 32 * w + t * 16 + fq * 4) = pk; } \
        LDS_BARRIER(); \
        GS_UPDATE(VF, KF, DDv); \
        f32x4 oo[2] = {(f32x4){0.f, 0.f, 0.f, 0.f}, (f32x4){0.f, 0.f, 0.f, 0.f}}; \
        _Pragma("unroll") for (int q = 0; q < 4; ++q) _Pragma("unroll") for (int n = 0; n < 2; ++n) oo[n] = MFMA16(VF[n][q], af[q], oo[n]); \
        _Pragma("unroll") for (int q = 0; q < 8; ++q) _Pragma("unroll") for (int n = 0; n < 2; ++n) { \
            const bf16x8 sf = *(const LAS bf16x8*)(Ss + (n * 16 + fr) * 264 + q * 32 + fq * 8); oo[n] = MFMA16(sf, qfr[q], oo[n]); } \
        { const int ck_ = GS_CK(s_); const int r0_ = GS_R0(s_, ck_); bf16_t* op = OB + (size_t)(r0_ + 16 * w + fr) * 2048 + h * 512 + sl * 32 + fq * 4; \
          _Pragma("unroll") for (int n = 0; n < 2; ++n) { u32x2 pk; pk.x = cvt_pk_bf16(oo[n][0], oo[n][1]); pk.y = cvt_pk_bf16(oo[n][2], oo[n][3]); *(u32x2*)(op + n * 16) = pk; } } \
        GS_LOADQA(sn_); \
    } while (0)
#pragma unroll 1
    for (int s = 2; s < 66; s += 2) {
        GS_STEP(vfA, kfA, ddA, vfB, kfB, ddB, s);
        GS_STEP(vfB, kfB, ddB, vfA, kfA, ddA, s + 1);
    }
#undef GS_CK
#undef GS_R0
#undef GS_LOAD
#undef GS_UPDATE
#undef GS_LOADQA
#undef GS_STEP
}

__device__ void phase_glafinal(const P& p, bf16_t* cc) {
    const int tix = threadIdx.x + opaque0(); const int lane = tix & 63, gw = blockIdx.x * 8 + (tix >> 6), nw = gridDim.x * 8;
    const bf16_t* OF = (const bf16_t*)(p.ws + O_OF); const bf16_t* OBk = OF + (size_t)NTOK * 2048;
    f32x4 g0 = *(const f32x4*)(p.gla_norm + lane * 8), g1 = *(const f32x4*)(p.gla_norm + lane * 8 + 4);
    for (int i = gw; i < NTOK * 4; i += nw) {
        const size_t o = (size_t)i * 512 + lane * 8;
        float a[8], c[8]; unpack8(*(const u32x4*)(OF + o), a); unpack8(*(const u32x4*)(OBk + o), c);
        float ss = 0.f;
#pragma unroll
        for (int e = 0; e < 8; ++e) { a[e] += c[e]; ss += a[e] * a[e]; }
        ss = wave_sum(ss); const float rs = rsqrtf(ss * (1.0f / 512) + EPS_);
#pragma unroll
        for (int e = 0; e < 4; ++e) { a[e] *= rs * g0[e]; a[4 + e] *= rs * g1[e]; }
        const int r = i >> 2, hh = i & 3;
        *(u32x4*)(cc + (size_t)r * 4096 + 2048 + hh * 512 + lane * 8) = pack8(a);
    }
}

__device__ void phase_conv(const P& p, const bf16_t* U, int ldu, int j0, int ns, bf16_t* act) {
    const int ncg = ns * 16, ntask = 256 * ncg;
    for (int task = blockIdx.x * 512 + threadIdx.x + opaque0(); task < ntask; task += gridDim.x * 512) {
        const int run = task / ncg, cgi = task % ncg, jl = cgi >> 4, i8 = (cgi & 15) * 8;
        const int ch = 128 * (j0 + jl) + i8; const int ucol = jl * 256 + i8;
        float wa[3][8], wg[3][8], ba[8], bg[8];
#pragma unroll
        for (int j = 0; j < 3; ++j)
#pragma unroll
            for (int e = 0; e < 8; ++e) { wa[j][e] = p.conv_w[j * 11264 + ch + e]; wg[j][e] = p.conv_w[j * 11264 + 5632 + ch + e]; }
#pragma unroll
        for (int e = 0; e < 8; ++e) { ba[e] = p.conv_b[ch + e]; bg[e] = p.conv_b[5632 + ch + e]; }
        const int rw0 = run * 64; const int tl0 = rw0 & (T_ - 1);
        float pa[8], pg[8], ca[8], cg_[8], na[8], ng[8];
        const bf16_t* up = U + (size_t)rw0 * ldu + ucol;
        if (tl0 > 0) { unpack8(*(const u32x4*)(up - ldu), pa); unpack8(*(const u32x4*)(up - ldu + 128), pg); }
        else {
#pragma unroll
            for (int e = 0; e < 8; ++e) { pa[e] = 0.f; pg[e] = 0.f; } }
        unpack8(*(const u32x4*)(up), ca); unpack8(*(const u32x4*)(up + 128), cg_);
        for (int i = 0; i < 64; ++i) {
            const bool has_next = (tl0 + i + 1) < T_;
            if (has_next) { unpack8(*(const u32x4*)(up + (size_t)(i + 1) * ldu), na); unpack8(*(const u32x4*)(up + (size_t)(i + 1) * ldu + 128), ng); }
            else {
#pragma unroll
                for (int e = 0; e < 8; ++e) { na[e] = 0.f; ng[e] = 0.f; } }
            float y[8];
#pragma unroll
            for (int e = 0; e < 8; ++e) { const float av = wa[0][e] * pa[e] + wa[1][e] * ca[e] + wa[2][e] * na[e] + ba[e]; const float gv = wg[0][e] * pg[e] + wg[1][e] * cg_[e] + wg[2][e] * ng[e] + bg[e];
                y[e] = siluf_(av) * gv; pa[e] = ca[e]; pg[e] = cg_[e]; ca[e] = na[e]; cg_[e] = ng[e]; }
            *(u32x4*)(act + (size_t)(rw0 + i) * 5632 + ch) = pack8(y);
        }
    }
}


#ifdef DBG_STOP
__device__ void dbg_dump(cg::grid_group& grid, const P& p, const bf16_t* src, size_t ld, int rows, int cols) {
    bf16_t* tmp = (bf16_t*)(p.ws + O_MIXEND);
    grid.sync();
    const size_t n = (size_t)rows * cols;
    for (size_t i = (size_t)blockIdx.x * 512 + threadIdx.x; i < n; i += (size_t)gridDim.x * 512) tmp[i] = src[(i / cols) * ld + (i % cols)];
    grid.sync();
    for (size_t i = (size_t)blockIdx.x * 512 + threadIdx.x; i < (size_t)NTOK * DM; i += (size_t)gridDim.x * 512) {
        const size_t r = i / DM, c = i % DM; p.out[i] = (r < (size_t)rows && c < (size_t)cols) ? bf2f(tmp[r * cols + c]) : 0.f; }
}
#define DBG_AT(k, src, ld, rows, cols) if (DBG_STOP == k) { dbg_dump(grid, p, (const bf16_t*)(src), ld, rows, cols); return; }
#else
#define DBG_AT(k, src, ld, rows, cols)
#endif

#ifdef DBG_STOP
__device__ void dbg_nancount(cg::grid_group& grid, const P& p, const bf16_t* src, size_t n, int mode) {
    unsigned* cnt = (unsigned*)(p.ws + O_MIXEND);
    grid.sync();
    if (blockIdx.x == 0 && threadIdx.x == 0) { cnt[0] = 0; cnt[1] = 0; }
    grid.sync();
    unsigned c = 0; float mx = 0.f;
    for (size_t i = (size_t)blockIdx.x * 512 + threadIdx.x; i < n; i += (size_t)gridDim.x * 512) { const unsigned short v = src[i]; if ((v & 0x7f80) == 0x7f80) ++c; else mx = fmaxf(mx, fabsf(bf2f(v))); }
    if (c) atomicAdd(cnt, c);
    atomicMax(cnt + 1, __float_as_uint(mx));
    grid.sync();
    for (size_t i = (size_t)blockIdx.x * 512 + threadIdx.x; i < (size_t)NTOK * DM; i += (size_t)gridDim.x * 512) p.out[i] = 0.f;
    grid.sync();
    if (blockIdx.x == 0 && threadIdx.x == 0) p.out[0] = mode == 0 ? (float)cnt[0] : __uint_as_float(cnt[1]);
}
#define DBG_NAN(k, src, n) if (DBG_STOP == k) { dbg_nancount(grid, p, (const bf16_t*)(src), n, 0); return; } if (DBG_STOP == k + 100) { dbg_nancount(grid, p, (const bf16_t*)(src), n, 1); return; }
#else
#define DBG_NAN(k, src, n)
#endif
__global__ void __launch_bounds__(512) fwd_megakernel(P p) {
    extern __shared__ __attribute__((aligned(16))) unsigned char shm[];
    LAS unsigned char* lds = (LAS unsigned char*)shm;
    cg::grid_group grid = cg::this_grid();
    unsigned char* ws = p.ws; const int nb = gridDim.x, bid = blockIdx.x;
    float* mod = (float*)(ws + O_MOD);
    bf16_t* cc = (bf16_t*)p.out;

#ifndef PHMASK
#define PHMASK 0xffff
#endif
    if (PHMASK & 1) phase0(lds, p);
    grid.sync();
#ifdef DBL_P0
    phase0(lds, p);
    grid.sync();
#endif
    if (PHMASK & 1) phase_modreduce(p);
    grid.sync();
    if (PHMASK & 1) phase_modulate(p.x, p.ctx, p.g_mix, mod, 0, 1, (bf16_t*)(ws + O_H), NROW);
    grid.sync();
    if (PHMASK & 2) { SchedProj1 S{(const char*)(ws + O_H), (const char*)(ws + O_XR), ws, nb, bid}; EpiProj1 E; pg8::gemm_phase(lds, 2048, S, E); }
    grid.sync();
    DBG_AT(1, ws + O_QA, 2048, 8192, 2048)
    DBG_AT(2, ws + O_VBT, NROW, 2048, 2048)
    DBG_AT(11, ws + O_H, 2048, 8192, 2048)
    DBG_AT(12, ws + O_KB, 1024, 8192, 1024)
    if (PHMASK & 4) for (int it = bid; it < 1024; it += nb) attn_item(lds, p, cc, it);
#ifdef DBL_ATTN
    grid.sync();
    for (int it = bid; it < 1024; it += nb) attn_item(lds, p, cc, it);
#endif
    if (PHMASK & 8) for (int it = nb - 1 - bid; it < 528; it += nb) glaprep_item(lds, p, it);
    grid.sync();
    DBG_AT(3, cc, 4096, 8192, 2048)
    DBG_AT(4, ws + O_QF, 1024, 8192, 1024)
    DBG_AT(5, ws + O_XR, 2048, 8192, 2048)
    DBG_AT(6, ws + O_KT, NROW, 2048, 2048)
    DBG_AT(13, ws + O_QB, 1024, 8192, 1024)
#if defined(DBG_STOP) && DBG_STOP == 16
    { grid.sync(); for (size_t i = (size_t)bid * 512 + threadIdx.x; i < (size_t)NTOK * DM; i += (size_t)nb * 512) p.out[i] = i < 270336 ? ((const float*)(ws + O_DD))[i] : 0.f; return; }
#endif
    if (PHMASK & 16) for (int it = bid; it < 256; it += nb) glaseq_item(lds, p, it);
    grid.sync();
#ifdef DBL_SEQ
    for (int it = bid; it < 256; it += nb) glaseq_item(lds, p, it);
    grid.sync();
#endif
    DBG_AT(7, ws + O_OF, 2048, 8192, 2048)
    DBG_NAN(20, ws + O_OF, (size_t)2 * NTOK * 2048)
    DBG_NAN(21, ws + O_KT, (size_t)2 * 1024 * NROW)
    DBG_AT(14, ws + O_OF + 67108864, 2048, 8192, 2048)
    if (PHMASK & 32) phase_glafinal(p, cc);
    grid.sync();
    DBG_AT(8, cc + 2048, 4096, 8192, 2048)
    if (PHMASK & 64) { SchedProj2 S{(const char*)(ws + O_H), (const char*)(ws + O_W2IN), ws, cc, nb, bid}; EpiProj2 E; pg8::gemm_phase(lds, 2048, S, E); }
    grid.sync();
    DBG_AT(9, ws + O_GA, 2048, 8192, 2048)
    DBG_AT(15, cc + 2048, 4096, 8192, 2048)
    if (PHMASK & 128) { SchedMerge S{(const char*)cc, (const char*)(ws + O_WMRG), ws, nb, bid}; EpiMerge E{(const bf16_t*)(ws + O_GA), (const bf16_t*)(ws + O_GA + 67108864)}; pg8::gemm_phase(lds, 4096, S, E); }
    grid.sync();
    DBG_AT(10, ws + O_M, 2048, 8192, 2048)
    if (PHMASK & 256) { SchedRes S{(const char*)(ws + O_M), (const char*)(ws + O_WOUT), 2048, nb, bid}; EpiRes E{p.x, p.out, mod + 2 * 2048}; pg8::gemm_phase(lds, 2048, S, E); }
    grid.sync();
#ifdef DBG_STOP_WOUT
    return;
#endif
    if (PHMASK & 512) phase_modulate(p.out, p.out, p.g_ffn, mod, 3, 4, (bf16_t*)(ws + O_H2), NTOK);
    if (PHMASK & 512) { LAS float* tl = (LAS float*)lds; const int J5 = 32 * 176, J6 = 88 * 32;
      for (int it = bid; it < J5 + J6; it += nb) {
          if (it < J5) transpose_job(tl, p.w_up, 11264, (bf16_t*)(ws + O_WUP), 2048, 2048, 11264, 3, 0, it);
          else transpose_job(tl, p.w_down, 2048, (bf16_t*)(ws + O_WDN), 5632, 5632, 2048, 0, 0, it - J5); } }
    grid.sync();
    { int j0 = 0; const int ldu = p.nsmax * 256;
      for (int si = 0; si < 4 && p.ns[si] > 0; ++si) {
          const int ns = p.ns[si];
          if (PHMASK & 1024) { SchedUp S{(const char*)(ws + O_H2), (const char*)(ws + O_WUP), (char*)(ws + O_U), j0, ns, ldu, nb, bid}; EpiStore E; pg8::gemm_phase(lds, 2048, S, E); }
          grid.sync();
          if (PHMASK & 2048) phase_conv(p, (const bf16_t*)(ws + O_U), ldu, j0, ns, (bf16_t*)(ws + p.o_act));
          grid.sync();
          j0 += ns; } }
    if (PHMASK & 4096) { SchedRes S{(const char*)(ws + p.o_act), (const char*)(ws + O_WDN), 5632, nb, bid}; EpiRes E{p.out, p.out, mod + 5 * 2048}; pg8::gemm_phase(lds, 5632, S, E); }
#ifdef DBG_COPYX
    grid.sync();
    for (size_t i = (size_t)bid * 512 + threadIdx.x; i < (size_t)NTOK * DM / 4; i += (size_t)nb * 512) ((f32x4*)p.out)[i] = ((const f32x4*)p.x)[i];
#endif
}

extern "C" void kernel_launch(void* const* d_in, const int* in_sizes, int n_in, void* d_out, int out_size, void* d_ws, size_t ws_size, hipStream_t stream) {
    static int grid_blocks = 0;
    if (grid_blocks == 0) {
        int dev = 0, cus = 0, per_cu = 0;
        hipGetDevice(&dev); hipDeviceGetAttribute(&cus, hipDeviceAttributeMultiprocessorCount, dev);
        if (hipFuncSetAttribute((const void*)fwd_megakernel, hipFuncAttributeMaxDynamicSharedMemorySize, LDS_BYTES) != hipSuccess) { fprintf(stderr, "kernel_launch: hipFuncSetAttribute failed\n"); grid_blocks = -1; return; }
        if (hipOccupancyMaxActiveBlocksPerMultiprocessor(&per_cu, (const void*)fwd_megakernel, 512, LDS_BYTES) != hipSuccess || per_cu < 1) { fprintf(stderr, "kernel_launch: occupancy query gave %d\n", per_cu); per_cu = 1; }
        (void)hipGetLastError();
        grid_blocks = cus * 1;
    }
    if (grid_blocks < 0) return;
    P p{};
    const float** f = (const float**)&p;
    for (int i = 0; i < 24; ++i) f[i] = (const float*)d_in[i];
    p.out = (float*)d_out; p.ws = (unsigned char*)d_ws;
    const size_t act_bytes = 184549376;
    if (ws_size >= O_U + (size_t)24 * 256 * NTOK * 2 + act_bytes) { p.ns[0] = 20; p.ns[1] = 24; p.ns[2] = 0; p.nsmax = 24; }
    else { p.ns[0] = 16; p.ns[1] = 16; p.ns[2] = 12; p.ns[3] = 0; p.nsmax = 16; }
    p.o_act = (long long)(O_U + (size_t)p.nsmax * 256 * NTOK * 2);
    if (ws_size < (size_t)p.o_act + act_bytes || ws_size < O_MIXEND) { fprintf(stderr, "kernel_launch: workspace too small (%zu)\n", ws_size); return; }
    void* args[] = {&p};
    hipError_t e = hipLaunchCooperativeKernel((void*)fwd_megakernel, dim3(grid_blocks), dim3(512), args, LDS_BYTES, stream);
    if (e != hipSuccess) fprintf(stderr, "cooperative launch failed: %s (grid %d)\n", hipGetErrorString(e), grid_blocks);
}
```

```cpp
#include <hip/hip_runtime.h>
#include <hip/hip_cooperative_groups.h>
#include <cstdio>
namespace cg = cooperative_groups;

#define LAS __attribute__((address_space(3)))
typedef unsigned short bf16_t;
typedef short bf16x8 __attribute__((ext_vector_type(8)));
typedef float f32x4 __attribute__((ext_vector_type(4)));
typedef float f32x2 __attribute__((ext_vector_type(2)));
typedef unsigned u32x4 __attribute__((ext_vector_type(4)));
typedef unsigned u32x2 __attribute__((ext_vector_type(2)));

constexpr int T_ = 8192, NTOK = 16384, NROW = 16896, DM = 2048;
constexpr int LDS_BYTES = 153616;
constexpr size_t O_BAR = 530000896;
constexpr float EPS_ = 1e-6f;

constexpr size_t O_MODP = 0;
constexpr size_t O_MOD = O_MODP + 4718592;
constexpr size_t O_ROPE = O_MOD + 147456;
constexpr size_t O_DD = O_ROPE + 32768;
constexpr size_t O_BASE = O_DD + 1081344;
constexpr size_t O_W2IN = O_BASE;
constexpr size_t O_WMRG = O_W2IN + 25165824;
constexpr size_t O_WOUT = O_WMRG + 16777216;
constexpr size_t O_H = O_WOUT + 8388608;
constexpr size_t O_XR = O_H + 69206016;
constexpr size_t O_QA = O_XR + 33554432;
constexpr size_t O_KA = O_QA + 67108864;
constexpr size_t O_VAT = O_KA + 17301504;
constexpr size_t O_KB = O_VAT + 17301504;
constexpr size_t O_QB = O_KB + 34603008;
constexpr size_t O_VBT = O_QB + 33554432;
constexpr size_t O_LR = O_VBT + 69206016;
constexpr size_t O_QF = O_LR + 2162688;
constexpr size_t O_KT = O_QF + 33554432;
constexpr size_t O_MIXEND = O_KT + 69206016;
constexpr size_t O_D1 = 400000000;
constexpr size_t O_OF = O_QA;
constexpr size_t O_GA = O_QB;
constexpr size_t O_M = O_QA;
constexpr size_t O_WUP = O_BASE;
constexpr size_t O_WDN = O_WUP + 46137344;
constexpr size_t O_H2 = O_WDN + 23068672;
constexpr size_t O_U = O_H2 + 67108864;

struct P {
    const float *x, *c, *ctx, *c_ctx, *w_mod, *b_mod, *g_mix, *w_in, *q_norm, *k_norm, *sink, *wgf, *bgf, *wgb, *bgb, *gla_norm,
        *w_attn_o, *w_gla_o, *w_out, *g_ffn, *w_up, *conv_w, *conv_b, *w_down;
    float* out;
    unsigned char* ws;
    long long o_act;
    int ns[4];
    int nsmax, pad;
};

typedef __bf16 bf16x2_t __attribute__((ext_vector_type(2)));
__device__ __forceinline__ unsigned cvt_pk_bf16(float lo, float hi) { const f32x2 v = {lo, hi}; const bf16x2_t b = __builtin_convertvector(v, bf16x2_t); return __builtin_bit_cast(unsigned, b); }
__device__ __forceinline__ float bf2f(unsigned short b) { return __uint_as_float(((unsigned)b) << 16); }
__device__ __forceinline__ float bflo(unsigned u) { return __uint_as_float(u << 16); }
__device__ __forceinline__ float bfhi(unsigned u) { return __uint_as_float(u & 0xffff0000u); }
__device__ __forceinline__ bf16_t f2bf(float f) { return (bf16_t)(cvt_pk_bf16(f, 0.f) & 0xffffu); }
__device__ __forceinline__ float wave_sum(float v) {
#pragma unroll
    for (int o = 32; o >= 1; o >>= 1) v += __shfl_xor(v, o);
    return v;
}
__device__ __forceinline__ float sigmoidf_(float x) { return __builtin_amdgcn_rcpf(1.0f + __expf(-x)); }
__device__ __forceinline__ float siluf_(float x) { return x * __builtin_amdgcn_rcpf(1.0f + __expf(-x)); }
__device__ __forceinline__ void unpack8(const u32x4 v, float* f) {
    f[0] = bflo(v.x); f[1] = bfhi(v.x); f[2] = bflo(v.y); f[3] = bfhi(v.y); f[4] = bflo(v.z); f[5] = bfhi(v.z); f[6] = bflo(v.w); f[7] = bfhi(v.w);
}
__device__ __forceinline__ u32x4 pack8(const float* f) {
    u32x4 w; w.x = cvt_pk_bf16(f[0], f[1]); w.y = cvt_pk_bf16(f[2], f[3]); w.z = cvt_pk_bf16(f[4], f[5]); w.w = cvt_pk_bf16(f[6], f[7]); return w;
}
__device__ __forceinline__ int opaque0() { int z; asm volatile("v_mov_b32 %0, 0" : "=v"(z)); return z; }
#define LDS_BARRIER() do { asm volatile("s_waitcnt lgkmcnt(0)" ::: "memory"); __builtin_amdgcn_s_barrier(); asm volatile("" ::: "memory"); } while (0)
#define MFMA16(a, b, c) __builtin_amdgcn_mfma_f32_16x16x32_bf16((a), (b), (c), 0, 0, 0)

namespace pg8 {
constexpr int BM = 256, BK = 64, HALF = 128, HTB = HALF * BK * 2, STAGE_BYTES = 8 * HTB, NXCD = 8, WGM = 8;
__device__ __forceinline__ int lds_byte(int r, int c) { const int st = (r >> 4) * 2 + (c >> 5), rr = r & 15, cc = c & 31, ob = rr * 64 + cc * 2; return st * 1024 + (ob ^ (((ob >> 9) & 1) << 5)); }
__device__ __forceinline__ void stage_rc(int b, int& R, int& C) { const int st = b / 1024, sb = b % 1024, swz = sb ^ (((sb >> 9) & 1) << 5); R = (st >> 1) * 16 + swz / 64; C = (st & 1) * 32 + (swz % 64) / 2; }
__device__ __forceinline__ int perm32(int rho) { const int n = rho >> 4, i = rho & 15; return 8 * (i >> 2) + 4 * n + (i & 3); }

struct Unit { const char* A; const char* B; char* out; int ldc; int kind; int row0; int col0; };

__device__ __forceinline__ void rect_map(int L, int nM, int nN, int& pm, int& pn) {
    const int nwg = nM * nN; int wgid = L;
    { const int q = nwg / NXCD, r = nwg % NXCD, xcd = wgid % NXCD, off = wgid / NXCD; wgid = (xcd < r ? xcd * (q + 1) : r * (q + 1) + (xcd - r) * q) + off; }
    const int nig = WGM * nN, gid = wgid / nig, fm = gid * WGM, gsz = (nM - fm) < WGM ? (nM - fm) : WGM;
    pm = fm + ((wgid % nig) % gsz); pn = (wgid % nig) / gsz;
}

template <class Epi, class Sched>
__device__ __forceinline__ void gemm_phase(LAS unsigned char* lds, const int K, const Sched& S, const Epi& E) {
    const int tid = threadIdx.x + opaque0(), wid = __builtin_amdgcn_readfirstlane(tid >> 6), lane = tid & 63, wr = wid >> 2, wc = wid & 3, fr = lane & 15, fq = lane >> 4;
    const int nt = K / BK;
    unsigned voffA[2], voffB[2];
#pragma unroll
    for (int i = 0; i < 2; ++i) { int R, C; stage_rc(tid * 16 + i * 8192, R, C); const int Rb = (R & ~31) + perm32(R & 31);
        voffA[i] = (unsigned)(R * K + C) * 2u; voffB[i] = (unsigned)(Rb * K + C) * 2u; }
    const size_t kstep = (size_t)(BK * 2);
    const size_t hstep = (size_t)HALF * K * 2;
    const unsigned ldsw = (unsigned)wid * 1024u;
    const int aoff = lds_byte(wr * 64 + fr, fq * 8), boff = lds_byte(wc * 32 + fr, fq * 8);
#define PG8_SA(b, h) (((b) * 2 + (h)) * HTB)
#define PG8_SB(b, h) ((4 + (b) * 2 + (h)) * HTB)
#define PG8_STAGE(bufoff, gbase, voff) do { _Pragma("unroll") for (int _i = 0; _i < 2; ++_i) \
        __builtin_amdgcn_global_load_lds((const unsigned*)((const char*)(gbase) + (voff)[_i]), (LAS unsigned*)(lds + (bufoff) + ldsw + _i * 8192), 16, 0, 0); } while (0)
#define PG8_LDA(dst, b, h) do { _Pragma("unroll") for (int m = 0; m < 4; ++m) _Pragma("unroll") for (int k = 0; k < 2; ++k) dst[m][k] = *(const LAS bf16x8*)(lds + PG8_SA(b, h) + aoff + m * 2048 + k * 1024); } while (0)
#define PG8_LDB(dst, b, h) do { _Pragma("unroll") for (int n = 0; n < 2; ++n) _Pragma("unroll") for (int k = 0; k < 2; ++k) dst[n][k] = *(const LAS bf16x8*)(lds + PG8_SB(b, h) + boff + n * 2048 + k * 1024); } while (0)
#define PG8_MMA(ai, bj, At, Bt) do { __builtin_amdgcn_s_setprio(1); _Pragma("unroll") for (int m = 0; m < 4; ++m) _Pragma("unroll") for (int n = 0; n < 2; ++n) _Pragma("unroll") for (int k = 0; k < 2; ++k) \
        acc[ai][bj][m][n] = __builtin_amdgcn_mfma_f32_16x16x32_bf16(Bt[n][k], At[m][k], acc[ai][bj][m][n], 0, 0, 0); __builtin_amdgcn_s_setprio(0); } while (0)
#define PG8_WAIT_V(n) asm volatile("s_waitcnt vmcnt(" #n ")" ::: "memory")
#define PG8_WAIT_L(n) asm volatile("s_waitcnt lgkmcnt(" #n ")" ::: "memory")
#define PG8_BAR __builtin_amdgcn_s_barrier()
#define PG8_SCHED __builtin_amdgcn_sched_barrier(0)
    Unit cur, nxt; int ui = 0;
    if (!S.next(0, cur)) return;
    f32x4 acc[2][2][4][2];
#pragma unroll
    for (int a = 0; a < 2; ++a)
#pragma unroll
        for (int b = 0; b < 2; ++b)
#pragma unroll
            for (int m = 0; m < 4; ++m)
#pragma unroll
                for (int n = 0; n < 2; ++n) acc[a][b][m][n] = (f32x4){0.f, 0.f, 0.f, 0.f};
    bf16x8 At[4][2], B0[2][2], B1[2][2];
    const char* cA = cur.A; const char* cB = cur.B;
    PG8_STAGE(PG8_SB(0, 0), cB, voffB); PG8_STAGE(PG8_SA(0, 0), cA, voffA); PG8_STAGE(PG8_SB(0, 1), cB + hstep, voffB); PG8_STAGE(PG8_SA(0, 1), cA + hstep, voffA);
    if (wr == 1) PG8_BAR;
    PG8_WAIT_V(4); PG8_BAR;
    PG8_STAGE(PG8_SB(1, 0), cB + kstep, voffB); PG8_STAGE(PG8_SA(1, 0), cA + kstep, voffA); PG8_STAGE(PG8_SB(1, 1), cB + hstep + kstep, voffB);
    PG8_WAIT_V(6); PG8_BAR;
    for (;;) {
        const bool has_next = S.next(ui + 1, nxt);
        const char* nA = has_next ? nxt.A : cA; const char* nB = has_next ? nxt.B : cB;
        for (int t = 0; t < nt; t += 2) {
            const bool last = (t == nt - 2);
            if constexpr (Epi::MID) { if (t == (nt >> 1)) E.mid(acc, cur, wr, wc, fr, fq); }
            const char* a1 = cA + (size_t)(t + 1) * kstep;
            const char* a2 = last ? nA : cA + (size_t)(t + 2) * kstep; const char* b2 = last ? nB : cB + (size_t)(t + 2) * kstep;
            const char* a3 = a2 + kstep; const char* b3 = b2 + kstep;
            PG8_LDB(B0, 0, 0); PG8_SCHED; PG8_LDA(At, 0, 0); PG8_STAGE(PG8_SA(1, 1), a1 + hstep, voffA);
            PG8_WAIT_L(8); PG8_BAR; PG8_WAIT_L(0); PG8_MMA(0, 0, At, B0); PG8_BAR; PG8_SCHED;
            PG8_LDB(B1, 0, 1); PG8_STAGE(PG8_SB(0, 0), b2, voffB);
            PG8_BAR; PG8_WAIT_L(0); PG8_MMA(0, 1, At, B1); PG8_BAR;
            PG8_LDA(At, 0, 1); PG8_STAGE(PG8_SA(0, 0), a2, voffA);
            PG8_BAR; PG8_WAIT_L(0); PG8_MMA(1, 0, At, B0); PG8_BAR; PG8_SCHED;
            PG8_STAGE(PG8_SB(0, 1), b2 + hstep, voffB);
            PG8_WAIT_V(6); PG8_BAR; PG8_MMA(1, 1, At, B1); PG8_BAR;
            PG8_LDB(B0, 1, 0); PG8_SCHED; PG8_LDA(At, 1, 0); PG8_STAGE(PG8_SA(0, 1), a2 + hstep, voffA);
            PG8_WAIT_L(8); PG8_BAR; PG8_WAIT_L(0); PG8_MMA(0, 0, At, B0); PG8_BAR; PG8_SCHED;
            PG8_LDB(B1, 1, 1); PG8_STAGE(PG8_SB(1, 0), b3, voffB);
            PG8_BAR; PG8_WAIT_L(0); PG8_MMA(0, 1, At, B1); PG8_BAR;
            PG8_LDA(At, 1, 1); PG8_STAGE(PG8_SA(1, 0), a3, voffA);
            PG8_BAR; PG8_WAIT_L(0); PG8_MMA(1, 0, At, B0); PG8_BAR; PG8_SCHED;
            PG8_STAGE(PG8_SB(1, 1), b3 + hstep, voffB);
            PG8_WAIT_V(6); PG8_BAR; PG8_MMA(1, 1, At, B1); PG8_BAR;
        }
        E(acc, cur, wr, wc, fr, fq);
        if (!has_next) break;
#pragma unroll
        for (int a = 0; a < 2; ++a)
#pragma unroll
            for (int b = 0; b < 2; ++b)
#pragma unroll
                for (int m = 0; m < 4; ++m)
#pragma unroll
                    for (int n = 0; n < 2; ++n) acc[a][b][m][n] = (f32x4){0.f, 0.f, 0.f, 0.f};
        cur = nxt; cA = nA; cB = nB; ++ui;
    }
    PG8_WAIT_V(0);
    if (wr == 0) PG8_BAR;
    PG8_BAR;
#undef PG8_SA
#undef PG8_SB
#undef PG8_STAGE
#undef PG8_LDA
#undef PG8_LDB
#undef PG8_MMA
#undef PG8_WAIT_V
#undef PG8_WAIT_L
#undef PG8_BAR
#undef PG8_SCHED
}
}
using pg8::Unit;
typedef f32x4 Acc[2][2][4][2];

__device__ __forceinline__ void store_tile_bf16(const Acc& acc, const Unit& u, int wr, int wc, int fr, int fq) {
    bf16_t* base = (bf16_t*)u.out + (size_t)(wr * 64 + fr) * u.ldc + wc * 32 + 8 * fq;
#pragma unroll
    for (int ai = 0; ai < 2; ++ai)
#pragma unroll
        for (int m = 0; m < 4; ++m) {
            bf16_t* rowp = base + (size_t)(ai * 128 + m * 16) * u.ldc;
#pragma unroll
            for (int bj = 0; bj < 2; ++bj) {
                const f32x4 v0 = acc[ai][bj][m][0], v1 = acc[ai][bj][m][1];
                u32x4 w; w.x = cvt_pk_bf16(v0[0], v0[1]); w.y = cvt_pk_bf16(v0[2], v0[3]); w.z = cvt_pk_bf16(v1[0], v1[1]); w.w = cvt_pk_bf16(v1[2], v1[3]);
                *(u32x4*)(rowp + bj * 128) = w;
            }
        }
}

struct SchedProj1 {
    const char* h; const char* w; unsigned char* ws; int G, c;
    __device__ bool next(int i, Unit& u) const {
        const int L = i * G + c; int pm, pn;
        if (L < 64 * 29) pg8::rect_map(L, 64, 29, pm, pn);
        else { const int e = L - 64 * 29; if (e >= 34) return false; pm = 64 + e / 17; const int q = e % 17; pn = q < 4 ? 8 + q : (q < 16 ? 12 + q : 28); }
        const char* ha = h + (size_t)pm * 256 * DM * 2; const char* wa = w + (size_t)pn * 256 * DM * 2;
        u.A = ha; u.B = wa; u.kind = 0; u.row0 = pm * 256; u.col0 = pn * 256;
        if (pn < 8) { u.out = (char*)(ws + O_QA) + ((size_t)pm * 256 * 2048 + pn * 256) * 2; u.ldc = 2048; }
        else if (pn < 10) { u.out = (char*)(ws + O_KA) + ((size_t)pm * 256 * 512 + (pn - 8) * 256) * 2; u.ldc = 512; }
        else if (pn < 12) { u.A = wa; u.B = ha; u.out = (char*)(ws + O_VAT) + ((size_t)(pn - 10) * 256 * NROW + pm * 256) * 2; u.ldc = NROW; }
        else if (pn < 16) { u.out = (char*)(ws + O_QB) + ((size_t)pm * 256 * 1024 + (pn - 12) * 256) * 2; u.ldc = 1024; }
        else if (pn < 20) { u.out = (char*)(ws + O_KB) + ((size_t)pm * 256 * 1024 + (pn - 16) * 256) * 2; u.ldc = 1024; }
        else if (pn < 28) { u.A = wa; u.B = ha; u.out = (char*)(ws + O_VBT) + ((size_t)(pn - 20) * 256 * NROW + pm * 256) * 2; u.ldc = NROW; }
        else { u.kind = 1; u.out = (char*)(ws + O_LR) + (size_t)pm * 256 * 32 * 4; u.ldc = 32; }
        return true;
    }
};
struct EpiProj1 {
    static constexpr bool MID = false;
    __device__ __forceinline__ void mid(Acc&, const Unit&, int, int, int, int) const {}
    __device__ __forceinline__ void operator()(const Acc& acc, const Unit& u, int wr, int wc, int fr, int fq) const {
        if (u.kind == 0) { store_tile_bf16(acc, u, wr, wc, fr, fq); return; }
        if (wc == 0) {
            float* base = (float*)u.out + (size_t)(wr * 64 + fr) * 32 + 8 * fq;
#pragma unroll
            for (int ai = 0; ai < 2; ++ai)
#pragma unroll
                for (int m = 0; m < 4; ++m) { float* rowp = base + (size_t)(ai * 128 + m * 16) * 32; *(f32x4*)rowp = acc[ai][0][m][0]; *(f32x4*)(rowp + 4) = acc[ai][0][m][1]; }
        }
    }
};
struct SchedProj2 {
    const char* h; const char* w; unsigned char* ws; bf16_t* cc; int G, c;
    __device__ bool next(int i, Unit& u) const {
        const int L = i * G + c; if (L >= 64 * 24) return false; int pm, pn; pg8::rect_map(L, 64, 24, pm, pn);
        u.A = h + (size_t)pm * 256 * DM * 2; u.B = w + (size_t)pn * 256 * DM * 2; u.row0 = pm * 256; u.col0 = pn * 256;
        if (pn < 8) { u.kind = 2; u.out = (char*)(cc + (size_t)pm * 256 * 4096 + 2048 + pn * 256); u.ldc = 4096; }
        else if (pn < 16) { u.kind = 0; u.out = (char*)(ws + O_GA) + ((size_t)pm * 256 * 2048 + (pn - 8) * 256) * 2; u.ldc = 2048; }
        else { u.kind = 0; u.out = (char*)(ws + O_GA + 67108864) + ((size_t)pm * 256 * 2048 + (pn - 16) * 256) * 2; u.ldc = 2048; }
        return true;
    }
};
struct EpiProj2 {
    static constexpr bool MID = false;
    __device__ __forceinline__ void mid(Acc&, const Unit&, int, int, int, int) const {}
    __device__ __forceinline__ void operator()(const Acc& acc, const Unit& u, int wr, int wc, int fr, int fq) const {
        if (u.kind == 0) { store_tile_bf16(acc, u, wr, wc, fr, fq); return; }
        bf16_t* base = (bf16_t*)u.out + (size_t)(wr * 64 + fr) * u.ldc + wc * 32 + 8 * fq;
#pragma unroll
        for (int ai = 0; ai < 2; ++ai)
#pragma unroll
            for (int m = 0; m < 4; ++m) {
                bf16_t* rowp = base + (size_t)(ai * 128 + m * 16) * u.ldc;
#pragma unroll
                for (int bj = 0; bj < 2; ++bj) {
                    const f32x4 v0 = acc[ai][bj][m][0], v1 = acc[ai][bj][m][1];
                    float y[8]; unpack8(*(const u32x4*)(rowp + bj * 128), y);
                    y[0] *= siluf_(v0[0]); y[1] *= siluf_(v0[1]); y[2] *= siluf_(v0[2]); y[3] *= siluf_(v0[3]);
                    y[4] *= siluf_(v1[0]); y[5] *= siluf_(v1[1]); y[6] *= siluf_(v1[2]); y[7] *= siluf_(v1[3]);
                    *(u32x4*)(rowp + bj * 128) = pack8(y);
                }
            }
    }
};
struct SchedMerge {
    const char* a; const char* w; unsigned char* ws; int G, c;
    __device__ bool next(int i, Unit& u) const {
        const int L = i * G + c; if (L >= 64 * 8) return false; int pm, pn; pg8::rect_map(L, 64, 8, pm, pn);
        u.A = a + (size_t)pm * 256 * 4096 * 2; u.B = w + (size_t)pn * 256 * 4096 * 2; u.row0 = pm * 256; u.col0 = pn * 256; u.kind = 0;
        u.out = (char*)(ws + O_M) + ((size_t)pm * 256 * 2048 + pn * 256) * 2; u.ldc = 2048; return true;
    }
};
struct EpiMerge {
    static constexpr bool MID = true;
    const bf16_t* ga; const bf16_t* gb;
    __device__ __forceinline__ void mid(Acc& acc, const Unit& u, int wr, int wc, int fr, int fq) const {
        const unsigned lo = (unsigned)(((wr * 64 + fr) * 2048 + wc * 32 + 8 * fq) * 2 + opaque0());
#pragma unroll
        for (int g4 = 0; g4 < 4; ++g4) {
            u32x4 ra[4], rb[4];
#pragma unroll
            for (int c = 0; c < 4; ++c) { const int cb = g4 * 4 + c, ai = cb >> 3, m = (cb >> 1) & 3, bj = cb & 1;
                const size_t ub = ((size_t)(u.row0 + ai * 128 + m * 16) * 2048 + u.col0 + bj * 128) * 2;
                ra[c] = *(const u32x4*)((const char*)ga + ub + lo); rb[c] = *(const u32x4*)((const char*)gb + ub + lo); }
#pragma unroll
            for (int c = 0; c < 4; ++c) { const int cb = g4 * 4 + c, ai = cb >> 3, m = (cb >> 1) & 3, bj = cb & 1;
                float a[8], b[8]; unpack8(ra[c], a); unpack8(rb[c], b);
#pragma unroll
                for (int e = 0; e < 8; ++e) { const float r = (1.0f + __expf(-b[e])) * __builtin_amdgcn_rcpf(1.0f + __expf(-a[e])); acc[ai][bj][m][e >> 2][e & 3] *= r; } }
            __builtin_amdgcn_sched_barrier(0);
        }
    }
    __device__ __forceinline__ void operator()(const Acc& acc, const Unit& u, int wr, int wc, int fr, int fq) const {
        const unsigned lo = (unsigned)(((wr * 64 + fr) * 2048 + wc * 32 + 8 * fq) * 2 + opaque0());
        char* outp = (char*)u.out - ((size_t)u.row0 * 2048 + u.col0) * 2;
#pragma unroll
        for (int g4 = 0; g4 < 4; ++g4) {
            u32x4 rb[4];
#pragma unroll
            for (int c = 0; c < 4; ++c) { const int cb = g4 * 4 + c, ai = cb >> 3, m = (cb >> 1) & 3, bj = cb & 1;
                const size_t ub = ((size_t)(u.row0 + ai * 128 + m * 16) * 2048 + u.col0 + bj * 128) * 2;
                rb[c] = *(const u32x4*)((const char*)gb + ub + lo); }
#pragma unroll
            for (int c = 0; c < 4; ++c) { const int cb = g4 * 4 + c, ai = cb >> 3, m = (cb >> 1) & 3, bj = cb & 1;
                const size_t ub = ((size_t)(u.row0 + ai * 128 + m * 16) * 2048 + u.col0 + bj * 128) * 2;
                float b[8], y[8]; unpack8(rb[c], b);
#pragma unroll
                for (int e = 0; e < 8; ++e) y[e] = acc[ai][bj][m][e >> 2][e & 3] * sigmoidf_(b[e]);
                *(u32x4*)(outp + ub + lo) = pack8(y); }
            __builtin_amdgcn_sched_barrier(0);
        }
    }
};
struct SchedRes {
    const char* a; const char* w; int K, G, c;
    __device__ bool next(int i, Unit& u) const {
        const int L = i * G + c; if (L >= 64 * 8) return false; int pm, pn; pg8::rect_map(L, 64, 8, pm, pn);
        u.A = a + (size_t)pm * 256 * K * 2; u.B = w + (size_t)pn * 256 * K * 2; u.row0 = pm * 256; u.col0 = pn * 256; u.kind = 0; u.out = nullptr; u.ldc = 2048; return true;
    }
};
struct EpiRes {
    static constexpr bool MID = false;
    const float* base; float* out; const float* gate;
    __device__ __forceinline__ void mid(Acc&, const Unit&, int, int, int, int) const {}
    __device__ __forceinline__ void operator()(const Acc& acc, const Unit& u, int wr, int wc, int fr, int fq) const {
        const int col = u.col0 + wc * 32 + 8 * fq;
        const float* gp = gate + (size_t)(u.row0 >> 13) * 12288 + col;
        f32x4 g[2][2];
#pragma unroll
        for (int bj = 0; bj < 2; ++bj) { g[bj][0] = *(const f32x4*)(gp + bj * 128); g[bj][1] = *(const f32x4*)(gp + bj * 128 + 4); }
        const size_t o0 = (size_t)(u.row0 + wr * 64 + fr) * 2048 + col;
#pragma unroll
        for (int ai = 0; ai < 2; ++ai)
#pragma unroll
            for (int m = 0; m < 4; ++m)
#pragma unroll
                for (int bj = 0; bj < 2; ++bj) {
                    const size_t o = o0 + (size_t)(ai * 128 + m * 16) * 2048 + bj * 128;
                    const f32x4 x0 = *(const f32x4*)(base + o), x1 = *(const f32x4*)(base + o + 4);
                    *(f32x4*)(out + o) = x0 + g[bj][0] * acc[ai][bj][m][0];
                    *(f32x4*)(out + o + 4) = x1 + g[bj][1] * acc[ai][bj][m][1];
                }
    }
};

struct EpiDelta {
    static constexpr bool MID = false;
    bf16_t* d1; const float* gate;
    __device__ __forceinline__ void mid(Acc&, const Unit&, int, int, int, int) const {}
    __device__ __forceinline__ void operator()(const Acc& acc, const Unit& u, int wr, int wc, int fr, int fq) const {
        const int col = u.col0 + wc * 32 + 8 * fq;
        const float* gp = gate + (size_t)(u.row0 >> 13) * 12288 + col;
        f32x4 g[2][2];
#pragma unroll
        for (int bj = 0; bj < 2; ++bj) { g[bj][0] = *(const f32x4*)(gp + bj * 128); g[bj][1] = *(const f32x4*)(gp + bj * 128 + 4); }
        bf16_t* base = d1 + (size_t)(u.row0 + wr * 64 + fr) * 2048 + col;
#pragma unroll
        for (int ai = 0; ai < 2; ++ai)
#pragma unroll
            for (int m = 0; m < 4; ++m) {
                bf16_t* rowp = base + (size_t)(ai * 128 + m * 16) * 2048;
#pragma unroll
                for (int bj = 0; bj < 2; ++bj) {
                    const f32x4 v0 = g[bj][0] * acc[ai][bj][m][0], v1 = g[bj][1] * acc[ai][bj][m][1];
                    u32x4 w; w.x = cvt_pk_bf16(v0[0], v0[1]); w.y = cvt_pk_bf16(v0[2], v0[3]); w.z = cvt_pk_bf16(v1[0], v1[1]); w.w = cvt_pk_bf16(v1[2], v1[3]);
                    *(u32x4*)(rowp + bj * 128) = w;
                }
            }
    }
};
struct EpiRes2 {
    static constexpr bool MID = false;
    const float* x; const bf16_t* d1; float* out; const float* gate;
    __device__ __forceinline__ void mid(Acc&, const Unit&, int, int, int, int) const {}
    __device__ __forceinline__ void operator()(const Acc& acc, const Unit& u, int wr, int wc, int fr, int fq) const {
        const int col = u.col0 + wc * 32 + 8 * fq;
        const float* gp = gate + (size_t)(u.row0 >> 13) * 12288 + col;
        f32x4 g[2][2];
#pragma unroll
        for (int bj = 0; bj < 2; ++bj) { g[bj][0] = *(const f32x4*)(gp + bj * 128); g[bj][1] = *(const f32x4*)(gp + bj * 128 + 4); }
        const size_t o0 = (size_t)(u.row0 + wr * 64 + fr) * 2048 + col;
#pragma unroll
        for (int ai = 0; ai < 2; ++ai)
#pragma unroll
            for (int m = 0; m < 4; ++m)
#pragma unroll
                for (int bj = 0; bj < 2; ++bj) {
                    const size_t o = o0 + (size_t)(ai * 128 + m * 16) * 2048 + bj * 128;
                    const f32x4 x0 = *(const f32x4*)(x + o), x1 = *(const f32x4*)(x + o + 4);
                    float d[8]; unpack8(*(const u32x4*)(d1 + o), d);
                    *(f32x4*)(out + o) = x0 + (f32x4){d[0], d[1], d[2], d[3]} + g[bj][0] * acc[ai][bj][m][0];
                    *(f32x4*)(out + o + 4) = x1 + (f32x4){d[4], d[5], d[6], d[7]} + g[bj][1] * acc[ai][bj][m][1];
                }
    }
};
struct SchedUp {
    const char* a; const char* w; char* uo; int j0, ns, ldu, G, c;
    __device__ bool next(int i, Unit& u) const {
        const int L = i * G + c; if (L >= 64 * ns) return false; int pm, pn; pg8::rect_map(L, 64, ns, pm, pn);
        u.A = a + (size_t)pm * 256 * DM * 2; u.B = w + (size_t)(j0 + pn) * 256 * DM * 2; u.row0 = pm * 256; u.col0 = pn * 256; u.kind = 0;
        u.out = uo + ((size_t)pm * 256 * ldu + pn * 256) * 2; u.ldc = ldu; return true;
    }
};
struct EpiStore {
    static constexpr bool MID = false;
    __device__ __forceinline__ void mid(Acc&, const Unit&, int, int, int, int) const {}
    __device__ __forceinline__ void operator()(const Acc& acc, const Unit& u, int wr, int wc, int fr, int fq) const { store_tile_bf16(acc, u, wr, wc, fr, fq); }
};


__device__ __forceinline__ float dpp_ror1(float v) { return __builtin_bit_cast(float, __builtin_amdgcn_update_dpp(0, __builtin_bit_cast(int, v), 0x121, 0xF, 0xF, false)); }
__device__ __forceinline__ float dpp_rol1(float v) { return __builtin_bit_cast(float, __builtin_amdgcn_update_dpp(0, __builtin_bit_cast(int, v), 0x12F, 0xF, 0xF, false)); }
struct SchedUpC {
    const char* a; const char* w; int G, c;
    __device__ bool next(int i, Unit& u) const {
        const int L = i * G + c; if (L >= 64 * 44) return false; int pm, pn; pg8::rect_map(L, 64, 44, pm, pn);
        u.A = a + (size_t)pm * 256 * DM * 2; u.B = w + (size_t)pn * 256 * DM * 2; u.row0 = pm * 256; u.col0 = pn * 256; u.kind = 0; u.out = nullptr; u.ldc = 0; return true;
    }
};
struct EpiUpConv {
    static constexpr bool MID = false;
    const float* cw; const float* cb; bf16_t* act; float* halo; LAS unsigned char* lds;
    __device__ __forceinline__ void mid(Acc&, const Unit&, int, int, int, int) const {}
    __device__ __forceinline__ void operator()(const Acc& acc, const Unit& u, int wr, int wc, int fr, int fq) const {
        LAS float* X = (LAS float*)(lds + 131072);
        const int c8 = wc * 32 + 8 * fq, pm = u.row0 >> 8, ch = (u.col0 >> 1) + c8;
        if (fr == 0) {
#pragma unroll
            for (int ai = 0; ai < 2; ++ai)
#pragma unroll
                for (int bj = 0; bj < 2; ++bj)
#pragma unroll
                    for (int n = 0; n < 2; ++n) *(LAS f32x4*)(X + ((((ai * 2 + wr) * 2 + 0) * 2 + bj) * 128 + c8 + 4 * n)) = acc[ai][bj][0][n];
        }
        if (fr == 15) {
#pragma unroll
            for (int ai = 0; ai < 2; ++ai)
#pragma unroll
                for (int bj = 0; bj < 2; ++bj)
#pragma unroll
                    for (int n = 0; n < 2; ++n) *(LAS f32x4*)(X + ((((ai * 2 + wr) * 2 + 1) * 2 + bj) * 128 + c8 + 4 * n)) = acc[ai][bj][3][n];
        }
        asm volatile("s_waitcnt lgkmcnt(0)" ::: "memory"); __builtin_amdgcn_s_barrier(); asm volatile("" ::: "memory"); __builtin_amdgcn_s_barrier(); asm volatile("" ::: "memory");
#pragma unroll
        for (int n = 0; n < 2; ++n) {
            const int chn = ch + 4 * n;
            f32x4 w[3][2], bb[2];
#pragma unroll
            for (int j = 0; j < 3; ++j)
#pragma unroll
                for (int bj = 0; bj < 2; ++bj) w[j][bj] = *(const f32x4*)(cw + j * 11264 + bj * 5632 + chn);
#pragma unroll
            for (int bj = 0; bj < 2; ++bj) bb[bj] = *(const f32x4*)(cb + bj * 5632 + chn);
#pragma unroll
            for (int ai = 0; ai < 2; ++ai) {
                const int g = ai * 2 + wr, gp = g > 0 ? g - 1 : 0, gn = g < 3 ? g + 1 : 3;
                f32x4 upb[2], dnb[2];
#pragma unroll
                for (int bj = 0; bj < 2; ++bj) { upb[bj] = *(const LAS f32x4*)(X + (((gp * 2 + 1) * 2 + bj) * 128 + c8 + 4 * n)); dnb[bj] = *(const LAS f32x4*)(X + (((gn * 2 + 0) * 2 + bj) * 128 + c8 + 4 * n)); }
#pragma unroll
                for (int m = 0; m < 4; ++m) {
                    const int r = 128 * ai + 64 * wr + 16 * m + fr;
                    const bool first = r == 0, last = r == 255;
                    f32x4 pre[2];
#pragma unroll
                    for (int bj = 0; bj < 2; ++bj)
#pragma unroll
                        for (int j = 0; j < 4; ++j) {
                            const float cur = acc[ai][bj][m][n][j];
                            const float ur = dpp_ror1(cur), dr = dpp_rol1(cur);
                            const float ue = m > 0 ? dpp_ror1(acc[ai][bj][m > 0 ? m - 1 : 0][n][j]) : upb[bj][j];
                            const float de = m < 3 ? dpp_rol1(acc[ai][bj][m < 3 ? m + 1 : 3][n][j]) : dnb[bj][j];
                            float up = fr == 0 ? ue : ur, dn = fr == 15 ? de : dr;
                            if (first) up = 0.f; if (last) dn = 0.f;
                            pre[bj][j] = w[0][bj][j] * up + w[1][bj][j] * cur + w[2][bj][j] * dn + bb[bj][j];
                        }
                    if (first || last) {
                        float* hp = halo + ((size_t)(pm * 4 + (last ? 1 : 0)) * 2) * 5632 + chn;
#pragma unroll
                        for (int bj = 0; bj < 2; ++bj) { *(f32x4*)(hp + bj * 5632) = acc[ai][bj][m][n]; *(f32x4*)(hp + (size_t)4 * 5632 + bj * 5632) = pre[bj]; }
                    } else {
                        u32x2 pk; pk.x = cvt_pk_bf16(siluf_(pre[0][0]) * pre[1][0], siluf_(pre[0][1]) * pre[1][1]); pk.y = cvt_pk_bf16(siluf_(pre[0][2]) * pre[1][2], siluf_(pre[0][3]) * pre[1][3]);
                        *(u32x2*)(act + (size_t)(u.row0 + r) * 5632 + chn) = pk;
                    }
                    __builtin_amdgcn_sched_barrier(0);
                }
            }
        }
    }
};
__device__ void phase_convfix(const P& p, const float* halo, bf16_t* act) {
    for (int i = blockIdx.x * 512 + threadIdx.x + opaque0(); i < 64 * 2 * 5632; i += gridDim.x * 512) {
        const int ch = i % 5632, pe = i / 5632, e = pe & 1, pm = pe >> 1;
        float pa = halo[((size_t)(pm * 4 + 2 + e) * 2 + 0) * 5632 + ch], pg = halo[((size_t)(pm * 4 + 2 + e) * 2 + 1) * 5632 + ch];
        if (e == 0 && (pm & 31) > 0) { pa += p.conv_w[ch] * halo[((size_t)((pm - 1) * 4 + 1) * 2 + 0) * 5632 + ch]; pg += p.conv_w[5632 + ch] * halo[((size_t)((pm - 1) * 4 + 1) * 2 + 1) * 5632 + ch]; }
        if (e == 1 && (pm & 31) < 31) { pa += p.conv_w[2 * 11264 + ch] * halo[((size_t)((pm + 1) * 4 + 0) * 2 + 0) * 5632 + ch]; pg += p.conv_w[2 * 11264 + 5632 + ch] * halo[((size_t)((pm + 1) * 4 + 0) * 2 + 1) * 5632 + ch]; }
        act[(size_t)(pm * 256 + (e ? 255 : 0)) * 5632 + ch] = f2bf(siluf_(pa) * pg);
    }
}

__device__ __forceinline__ int srccol(int kind, int n) {
    if (kind == 0) return n;
    if (kind == 1) return n < 7168 ? n : (n < 7200 ? n + 2048 : -1);
    if (kind == 2) return n < 2048 ? 7168 + n : 9248 + (n - 2048);
    const int j = n >> 8, i = n & 255; return i < 128 ? 128 * j + i : 5632 + 128 * j + (i - 128);
}
struct TJob { const float* src; int ld_src; bf16_t* dst; int ld_dst; int k0; int n0; int kind; int koff; };
__device__ __forceinline__ void tj_load(const TJob& j, int tid, f32x4 (&v)[8]) {
    const int kr = tid >> 6, nq = (tid & 63) * 4; const int sc = srccol(j.kind, j.n0 + nq);
#pragma unroll
    for (int pass = 0; pass < 8; ++pass) { v[pass] = (f32x4){0.f, 0.f, 0.f, 0.f}; if (sc >= 0) v[pass] = *(const f32x4*)(j.src + (size_t)(j.k0 + kr + 8 * pass) * j.ld_src + sc); }
}
__device__ __forceinline__ void tj_store(LAS float* tl, const TJob& j, int tid, const f32x4 (&v)[8]) {
    { const int kr = tid >> 6, nq = (tid & 63) * 4;
#pragma unroll
      for (int pass = 0; pass < 8; ++pass) { const int k = kr + 8 * pass;
          tl[(nq + 0) * 65 + k] = v[pass][0]; tl[(nq + 1) * 65 + k] = v[pass][1]; tl[(nq + 2) * 65 + k] = v[pass][2]; tl[(nq + 3) * 65 + k] = v[pass][3]; } }
}
__device__ __forceinline__ void tj_flush(LAS float* tl, const TJob& j, int tid) {
    const int nr = tid >> 3, kc = (tid & 7) * 8;
#pragma unroll
    for (int pass = 0; pass < 4; ++pass) { const int n = nr + 64 * pass; float f[8];
#pragma unroll
        for (int e = 0; e < 8; ++e) f[e] = tl[n * 65 + kc + e];
        *(u32x4*)(j.dst + (size_t)(j.n0 + n) * j.ld_dst + j.koff + j.k0 + kc) = pack8(f); }
}
__device__ __forceinline__ TJob tj_make(const float* src, int ld_src, bf16_t* dst, int ld_dst, int N, int kind, int koff, int it) {
    const int nnt = N / 256; TJob j; j.src = src; j.ld_src = ld_src; j.dst = dst; j.ld_dst = ld_dst; j.k0 = (it / nnt) * 64; j.n0 = (it % nnt) * 256; j.kind = kind; j.koff = koff; return j;
}
__device__ void phase0(LAS unsigned char* lds, const P& p) {
    LAS float* tl = (LAS float*)lds;
    unsigned char* ws = p.ws;
    const int nb = gridDim.x, bid = blockIdx.x, tid = threadIdx.x + opaque0();
    for (int it = bid; it < 256; it += nb) {
        const int kc = it >> 3, nch = it & 7; float a[3][3];
#pragma unroll
        for (int v = 0; v < 3; ++v)
#pragma unroll
            for (int j = 0; j < 3; ++j) a[v][j] = 0.f;
#pragma unroll 16
        for (int k = kc * 64; k < kc * 64 + 64; ++k) {
            const float s0 = siluf_(p.c[k]), s1 = siluf_(p.c[2048 + k]), s2 = siluf_(p.c_ctx[k]);
            const float* wr = p.w_mod + (size_t)k * 12288 + nch * 1536 + tid;
#pragma unroll
            for (int j = 0; j < 3; ++j) { const float w = wr[j * 512]; a[0][j] += s0 * w; a[1][j] += s1 * w; a[2][j] += s2 * w; }
        }
        float* mp = (float*)(ws + O_MODP) + (size_t)kc * 3 * 12288 + nch * 1536 + tid;
#pragma unroll
        for (int v = 0; v < 3; ++v)
#pragma unroll
            for (int j = 0; j < 3; ++j) mp[(size_t)v * 12288 + j * 512] = a[v][j];
    }
    for (int i = bid * 512 + tid; i < 128 * 32; i += nb * 512) {
        const int pos = i >> 5, f = i & 31;
        const float inv = exp2f(-(float)f * (13.287712379549449f / 32.0f));
        const float ang = (float)pos * inv;
        const double ad = (double)ang; const double n = rint(ad * 0.15915494309189535); double r = ad - n * 6.283185307179586476925;
        r *= 0.125; const double r2 = r * r;
        double s = r * (1.0 + r2 * (-1.0 / 6 + r2 * (1.0 / 120 + r2 * (-1.0 / 5040 + r2 * (1.0 / 362880 + r2 * (-1.0 / 39916800))))));
        double c = 1.0 + r2 * (-0.5 + r2 * (1.0 / 24 + r2 * (-1.0 / 720 + r2 * (1.0 / 40320 + r2 * (-1.0 / 3628800 + r2 * (1.0 / 479001600))))));
#pragma unroll
        for (int q = 0; q < 3; ++q) { const double s2 = 2.0 * s * c, c2 = c * c - s * s; s = s2; c = c2; }
        ((f32x2*)(ws + O_ROPE))[i] = (f32x2){(float)c, (float)s};
    }
    const int J0 = 32 * 29, J1 = 32 * 24, J2 = 256, J3 = 256, J4 = 256;
    auto job0 = [&](int it) -> TJob {
        int q = it;
        if (q < J0) return tj_make(p.w_in, 13344, (bf16_t*)(ws + O_XR), 2048, 7424, 1, 0, q); q -= J0;
        if (q < J1) return tj_make(p.w_in, 13344, (bf16_t*)(ws + O_W2IN), 2048, 6144, 2, 0, q); q -= J1;
        if (q < J2) return tj_make(p.w_attn_o, 2048, (bf16_t*)(ws + O_WMRG), 4096, 2048, 0, 0, q); q -= J2;
        if (q < J3) return tj_make(p.w_gla_o, 2048, (bf16_t*)(ws + O_WMRG), 4096, 2048, 0, 2048, q); q -= J3;
        return tj_make(p.w_out, 2048, (bf16_t*)(ws + O_WOUT), 2048, 2048, 0, 0, q);
    };
    { const int JT = J0 + J1 + J2 + J3 + J4; int it = bid; f32x4 v[8]; TJob cur;
      if (it < JT) { cur = job0(it); tj_load(cur, tid, v); }
      while (it < JT) {
          LDS_BARRIER(); tj_store(tl, cur, tid, v);
          const int itn = it + nb; TJob nxt = cur; if (itn < JT) { nxt = job0(itn); tj_load(nxt, tid, v); }
          LDS_BARRIER(); tj_flush(tl, cur, tid);
          cur = nxt; it = itn; } }
}
__device__ void phase_modreduce(const P& p) {
    const float* mp = (const float*)(p.ws + O_MODP); float* mod = (float*)(p.ws + O_MOD);
    for (int i = blockIdx.x * 512 + threadIdx.x; i < 3 * 12288; i += gridDim.x * 512) {
        float s = p.b_mod[i % 12288];
#pragma unroll
        for (int kc = 0; kc < 32; ++kc) s += mp[(size_t)kc * 3 * 12288 + i];
        mod[i] = s;
    }
}
__device__ void phase_modulate(const float* xlat, const float* xctx, const float* g, const float* mod, int sh, int sc, bf16_t* h, int nrows) {
    const int tix = threadIdx.x + opaque0(); const int lane = tix & 63, gw = blockIdx.x * 8 + (tix >> 6), nw = gridDim.x * 8;
    for (int r = gw; r < nrows; r += nw) {
        const float* xr = r < NTOK ? xlat + (size_t)r * DM : xctx + (size_t)(r - NTOK) * DM;
        const float* mv = mod + (size_t)(r < NTOK ? (r >> 13) : 2) * 12288;
        f32x4 v[8]; float ss = 0.f;
#pragma unroll
        for (int i = 0; i < 8; ++i) { v[i] = *(const f32x4*)(xr + (i * 64 + lane) * 4); ss += v[i][0] * v[i][0] + v[i][1] * v[i][1] + v[i][2] * v[i][2] + v[i][3] * v[i][3]; }
        ss = wave_sum(ss); const float rs = rsqrtf(ss * (1.0f / DM) + EPS_);
#pragma unroll
        for (int i = 0; i < 8; ++i) { const int cidx = (i * 64 + lane) * 4;
            const f32x4 gg = *(const f32x4*)(g + cidx), s1 = *(const f32x4*)(mv + sc * 2048 + cidx), s0 = *(const f32x4*)(mv + sh * 2048 + cidx);
            const f32x4 y = v[i] * rs * gg * (s1 + 1.0f) + s0;
            u32x2 w; w.x = cvt_pk_bf16(y[0], y[1]); w.y = cvt_pk_bf16(y[2], y[3]); *(u32x2*)(h + (size_t)r * DM + cidx) = w; }
    }
}


__device__ void phase_modulate2(const float* x, const bf16_t* d1, const float* g, const float* mod, int sh, int sc, bf16_t* h) {
    const int tix = threadIdx.x + opaque0(); const int lane = tix & 63, gw = blockIdx.x * 8 + (tix >> 6), nw = gridDim.x * 8;
    for (int r = gw; r < NTOK; r += nw) {
        const float* xr = x + (size_t)r * DM; const bf16_t* dr = d1 + (size_t)r * DM;
        const float* mv = mod + (size_t)(r >> 13) * 12288;
        f32x4 v[8]; float ss = 0.f;
#pragma unroll
        for (int i = 0; i < 8; ++i) { const int cidx = (i * 64 + lane) * 4; v[i] = *(const f32x4*)(xr + cidx); const u32x2 dd = *(const u32x2*)(dr + cidx);
            v[i][0] += bflo(dd.x); v[i][1] += bfhi(dd.x); v[i][2] += bflo(dd.y); v[i][3] += bfhi(dd.y);
            ss += v[i][0] * v[i][0] + v[i][1] * v[i][1] + v[i][2] * v[i][2] + v[i][3] * v[i][3]; }
        ss = wave_sum(ss); const float rs = rsqrtf(ss * (1.0f / DM) + EPS_);
#pragma unroll
        for (int i = 0; i < 8; ++i) { const int cidx = (i * 64 + lane) * 4;
            const f32x4 gg = *(const f32x4*)(g + cidx), s1 = *(const f32x4*)(mv + sc * 2048 + cidx), s0 = *(const f32x4*)(mv + sh * 2048 + cidx);
            const f32x4 y = v[i] * rs * gg * (s1 + 1.0f) + s0;
            u32x2 w; w.x = cvt_pk_bf16(y[0], y[1]); w.y = cvt_pk_bf16(y[2], y[3]); *(u32x2*)(h + (size_t)r * DM + cidx) = w; }
    }
}
__device__ void phase_kprep(const P& p) {
    const int tix = threadIdx.x + opaque0(); const int lane = tix & 63, gw = blockIdx.x * 8 + (tix >> 6), nw = gridDim.x * 8;
    bf16_t* KA = (bf16_t*)(p.ws + O_KA); const f32x2* tab = (const f32x2*)(p.ws + O_ROPE);
    const float w0 = p.k_norm[lane], w1 = p.k_norm[64 + lane];
    for (int r0 = gw * 2; r0 < NROW; r0 += nw * 2) {
        float x1[8], x2[8];
#pragma unroll
        for (int q = 0; q < 8; ++q) { const bf16_t* kp = KA + (size_t)(r0 + (q >> 2)) * 512 + (q & 3) * 128 + lane; x1[q] = bf2f(kp[0]); x2[q] = bf2f(kp[64]); }
#pragma unroll
        for (int q = 0; q < 8; ++q) {
            const int r = r0 + (q >> 2); bf16_t* kp = KA + (size_t)r * 512 + (q & 3) * 128 + lane;
            const float ss = wave_sum(x1[q] * x1[q] + x2[q] * x2[q]); const float rs = rsqrtf(ss * (1.0f / 128) + EPS_);
            float a1 = x1[q] * rs * w0, a2 = x2[q] * rs * w1;
            if (r < NTOK) { const int t = r & (T_ - 1); const int pos = lane < 32 ? (t >> 6) : (t & 63); const f32x2 cs = tab[pos * 32 + (lane & 31)];
                const float y1 = a1 * cs.x - a2 * cs.y, y2 = a2 * cs.x + a1 * cs.y; a1 = y1; a2 = y2; }
            kp[0] = f2bf(a1); kp[64] = f2bf(a2);
        }
    }
}
__device__ __forceinline__ void normrope8x4(float (&y)[4][8], const float* nw, int dofs, float rs, bool rope, int t, const f32x2* tab) {
#pragma unroll
    for (int s = 0; s < 4; ++s) { const f32x4 w0 = *(const f32x4*)(nw + s * 32 + dofs), w1 = *(const f32x4*)(nw + s * 32 + dofs + 4);
#pragma unroll
        for (int e = 0; e < 4; ++e) { y[s][e] *= rs * w0[e]; y[s][4 + e] *= rs * w1[e]; } }
    if (rope) {
#pragma unroll
        for (int s = 0; s < 2; ++s) { const int pos = s == 0 ? (t >> 6) : (t & 63); const f32x2* tp = tab + pos * 32 + dofs;
#pragma unroll
            for (int e = 0; e < 8; ++e) { const f32x2 cs = tp[e]; const float x1 = y[s][e], x2 = y[s + 2][e]; y[s][e] = x1 * cs.x - x2 * cs.y; y[s + 2][e] = x2 * cs.x + x1 * cs.y; } }
    }
}
__device__ void attn_item(LAS unsigned char* lds, const P& p, bf16_t* cc, int item) {
    const int tid = threadIdx.x + opaque0(), w = __builtin_amdgcn_readfirstlane(tid >> 6), lane = tid & 63, fr = lane & 15, fq = lane >> 4;
    const int pair = item & 1, kvh = (item >> 1) & 3, qb = (item >> 3) & 63, b = item >> 9;
    LAS bf16_t* KV0 = (LAS bf16_t*)lds;
    const bf16_t* QA = (const bf16_t*)(p.ws + O_QA); const bf16_t* KA = (const bf16_t*)(p.ws + O_KA); const bf16_t* VAT = (const bf16_t*)(p.ws + O_VAT);
    const f32x2* tab = (const f32x2*)(p.ws + O_ROPE);
    const int hq = kvh * 4 + pair * 2 + (w >> 2), rc = w & 3, qrow0 = qb * 128 + rc * 32;
    const float SC = 0.08838834764831845f * 1.4426950408889634f;
    bf16x8 qf[2][4];
#pragma unroll
    for (int mt = 0; mt < 2; ++mt) {
        const int t = qrow0 + mt * 16 + fr; const bf16_t* src = QA + (size_t)(b * T_ + t) * 2048 + hq * 128 + fq * 8;
        float y[4][8]; float ss = 0.f;
#pragma unroll
        for (int s = 0; s < 4; ++s) { unpack8(*(const u32x4*)(src + s * 32), y[s]);
#pragma unroll
            for (int e = 0; e < 8; ++e) ss += y[s][e] * y[s][e]; }
        ss += __shfl_xor(ss, 16); ss += __shfl_xor(ss, 32);
        const float rs = rsqrtf(ss * (1.0f / 128) + EPS_);
        normrope8x4(y, p.q_norm, fq * 8, rs, true, t, tab);
#pragma unroll
        for (int s = 0; s < 4; ++s) {
#pragma unroll
            for (int e = 0; e < 8; ++e) y[s][e] *= SC;
            const u32x4 pk = pack8(y[s]); qf[mt][s] = *(const bf16x8*)&pk; }
    }
    f32x4 o[2][8];
#pragma unroll
    for (int mt = 0; mt < 2; ++mt)
#pragma unroll
        for (int n = 0; n < 8; ++n) o[mt][n] = (f32x4){0.f, 0.f, 0.f, 0.f};
    float mrun[2], lrun[2];
    { const float sk = p.sink[hq] * 1.4426950408889634f; mrun[0] = sk; mrun[1] = sk; lrun[0] = fq == 0 ? 1.0f : 0.0f; lrun[1] = lrun[0]; }
#define AT_TOKBASE(jj_) ((jj_) < 3 ? b * T_ + (qb - 1 + (jj_)) * 128 : NTOK + b * 256 + ((jj_) - 3) * 128)
#define AT_NEXT(jj_) (((jj_) + 1 == 2 && qb == 63) ? 3 : (jj_) + 1)
#define AT_STAGE(jj_, buf_) do { const int tb_ = AT_TOKBASE(jj_); const int key = tid >> 2, part = tid & 3; \
        LAS bf16_t* kd_ = KV0 + (buf_) * (2 * 128 * 136); LAS bf16_t* vd_ = kd_ + 128 * 136; \
        const bf16_t* src = KA + (size_t)(tb_ + key) * 512 + kvh * 128 + part * 8; const bf16_t* vsrc = VAT + (size_t)(kvh * 128 + key) * NROW + tb_ + part * 8; \
        u32x4 rk_[4], rv_[4]; \
        _Pragma("unroll") for (int s = 0; s < 4; ++s) { rk_[s] = *(const u32x4*)(src + s * 32); rv_[s] = *(const u32x4*)(vsrc + s * 32); } \
        _Pragma("unroll") for (int s = 0; s < 4; ++s) { *(LAS u32x4*)(kd_ + key * 136 + s * 32 + part * 8) = rk_[s]; *(LAS u32x4*)(vd_ + key * 136 + s * 32 + part * 8) = rv_[s]; } } while (0)
    int jn = qb == 0 ? 1 : 0, cur = 0;
    LDS_BARRIER();
    AT_STAGE(jn, 0);
    LDS_BARRIER();
    while (jn < 5) {
        const int jj = jn; jn = AT_NEXT(jj);
        const int mtype = jj == 0 ? 1 : (jj == 2 ? 2 : 0);
        const int mlo = mtype == 1 ? 0 : -100000, mhi = mtype == 2 ? 0 : 100000;
        const int dl = fq * 4 - rc * 32 - fr + opaque0();
        u32x4 rk_[4];
        if (jn < 5) { const int tb_ = AT_TOKBASE(jn); const int key = tid >> 2, part = tid & 3;
            const bf16_t* src = KA + (size_t)(tb_ + key) * 512 + kvh * 128 + part * 8; const bf16_t* vsrc = VAT + (size_t)(kvh * 128 + key) * NROW + tb_ + part * 8;
            LAS bf16_t* vd_ = KV0 + (cur ^ 1) * (2 * 128 * 136) + 128 * 136;
#pragma unroll
            for (int s = 0; s < 4; ++s) rk_[s] = *(const u32x4*)(src + s * 32);
#pragma unroll
            for (int s = 0; s < 4; ++s) *(LAS u32x4*)(vd_ + key * 136 + s * 32 + part * 8) = *(const u32x4*)(vsrc + s * 32); }
        LAS bf16_t* Ks = KV0 + cur * (2 * 128 * 136); LAS bf16_t* Vs = Ks + 128 * 136;
        u32x2 pk[2][8];
#pragma unroll
        for (int mt = 0; mt < 2; ++mt) {
            f32x4 sacc[8];
#pragma unroll
            for (int n = 0; n < 8; ++n) sacc[n] = (f32x4){0.f, 0.f, 0.f, 0.f};
#pragma unroll
            for (int s = 0; s < 4; ++s) {
#pragma unroll
                for (int n = 0; n < 8; ++n) { const bf16x8 kf = *(const LAS bf16x8*)(Ks + (n * 16 + fr) * 136 + s * 32 + fq * 8); sacc[n] = MFMA16(kf, qf[mt][s], sacc[n]); }
                __builtin_amdgcn_sched_barrier(0); }
            float mx = -INFINITY;
            if (mtype != 0) {
#pragma unroll
                for (int n = 0; n < 8; ++n)
#pragma unroll
                    for (int j = 0; j < 4; ++j) { const int dkq = dl + (n * 16 + j - mt * 16); if (dkq < mlo || dkq > mhi) sacc[n][j] = -INFINITY; }
            }
#pragma unroll
            for (int n = 0; n < 8; ++n)
#pragma unroll
                for (int j = 0; j < 4; ++j) mx = fmaxf(mx, sacc[n][j]);
            mx = fmaxf(mx, __shfl_xor(mx, 16)); mx = fmaxf(mx, __shfl_xor(mx, 32));
            const float mn = fmaxf(mrun[mt], mx), al = __builtin_amdgcn_exp2f(mrun[mt] - mn); mrun[mt] = mn;
            if (__any(al != 1.0f)) {
#pragma unroll
                for (int n = 0; n < 8; ++n)
#pragma unroll
                    for (int j = 0; j < 4; ++j) o[mt][n][j] *= al;
            }
            float ps = 0.f;
#pragma unroll
            for (int n = 0; n < 8; ++n) { float pv[4];
#pragma unroll
                for (int j = 0; j < 4; ++j) { pv[j] = __builtin_amdgcn_exp2f(sacc[n][j] - mn); ps += pv[j]; }
                pk[mt][n].x = cvt_pk_bf16(pv[0], pv[1]); pk[mt][n].y = cvt_pk_bf16(pv[2], pv[3]); }
            lrun[mt] = lrun[mt] * al + ps;
            __builtin_amdgcn_sched_barrier(0);
        }
#pragma unroll
        for (int s = 0; s < 4; ++s) {
            const u32x4 pq0 = (u32x4){pk[0][2 * s].x, pk[0][2 * s].y, pk[0][2 * s + 1].x, pk[0][2 * s + 1].y}, pq1 = (u32x4){pk[1][2 * s].x, pk[1][2 * s].y, pk[1][2 * s + 1].x, pk[1][2 * s + 1].y};
            const bf16x8 p0 = __builtin_bit_cast(bf16x8, pq0), p1 = __builtin_bit_cast(bf16x8, pq1);
#pragma unroll
            for (int n = 0; n < 8; ++n) {
                const u32x2 v0 = *(const LAS u32x2*)(Vs + (n * 16 + fr) * 136 + s * 32 + fq * 4), v1 = *(const LAS u32x2*)(Vs + (n * 16 + fr) * 136 + s * 32 + 16 + fq * 4);
                const u32x4 vq = (u32x4){v0.x, v0.y, v1.x, v1.y}; const bf16x8 vf = __builtin_bit_cast(bf16x8, vq);
                o[0][n] = MFMA16(vf, p0, o[0][n]); o[1][n] = MFMA16(vf, p1, o[1][n]); }
            __builtin_amdgcn_sched_barrier(0);
        }
        if (jn < 5) { const int key = tid >> 2, part = tid & 3; LAS bf16_t* kd_ = KV0 + (cur ^ 1) * (2 * 128 * 136); LAS bf16_t* vd_ = kd_ + 128 * 136;
#pragma unroll
            for (int s = 0; s < 4; ++s) *(LAS u32x4*)(kd_ + key * 136 + s * 32 + part * 8) = rk_[s]; (void)vd_; }
        LDS_BARRIER();
        cur ^= 1;
    }
#undef AT_TOKBASE
#undef AT_NEXT
#undef AT_STAGE
#pragma unroll
    for (int mt = 0; mt < 2; ++mt) {
        float l = lrun[mt]; l += __shfl_xor(l, 16); l += __shfl_xor(l, 32);
        const float inv = 1.0f / l; bf16_t* dst = cc + (size_t)(b * T_ + qrow0 + mt * 16 + fr) * 4096 + hq * 128 + fq * 4;
#pragma unroll
        for (int n = 0; n < 8; ++n) { u32x2 pk; pk.x = cvt_pk_bf16(o[mt][n][0] * inv, o[mt][n][1] * inv); pk.y = cvt_pk_bf16(o[mt][n][2] * inv, o[mt][n][3] * inv); *(u32x2*)(dst + n * 16) = pk; }
    }
}

__device__ void glaprep_item(LAS unsigned char* lds, const P& p, int item) {
    const int tid = threadIdx.x + opaque0(), w = __builtin_amdgcn_readfirstlane(tid >> 6), lane = tid & 63, fr = lane & 15, fq = lane >> 4;
    const int ck = item % 66, h = (item / 66) & 3, b = item / 264;
    const bool lat = ck < 64; const int r0 = lat ? b * T_ + ck * 128 : NTOK + b * 256 + (ck - 64) * 128;
    LAS bf16_t* Qs = (LAS bf16_t*)lds; LAS bf16_t* Ks = Qs + 128 * 264; LAS float* lrs = (LAS float*)(lds + 2 * 128 * 264 * 2); LAS float* seg = lrs + 128 * 32;
    unsigned char* ws = p.ws;
    bf16_t* QB = (bf16_t*)(ws + O_QB); bf16_t* QF = (bf16_t*)(ws + O_QF); const bf16_t* KB = (const bf16_t*)(ws + O_KB);
    __syncthreads();
    { const f32x4* src = (const f32x4*)((const float*)(ws + O_LR) + (size_t)r0 * 32); ((LAS f32x4*)lrs)[tid] = src[tid]; ((LAS f32x4*)lrs)[tid + 512] = src[tid + 512]; }
    const int half = tid >> 8, d = tid & 255, gc = h * 256 + d;
    for (int dir = 0; dir < 2; ++dir) {
        const int chain = dir * 8 + b * 4 + h;
        const float* wg = dir == 0 ? p.wgf : p.wgb; const float bias = (dir == 0 ? p.bgf : p.bgb)[gc];
        float wv[16];
#pragma unroll
        for (int j = 0; j < 16; ++j) wv[j] = wg[j * 1024 + gc];
        __syncthreads();
        float carry = 0.f;
        bf16_t* qdst = dir == 0 ? QF : QB;
#pragma unroll 1
        for (int rnd = 0; rnd < 2; ++rnd) {
            float bl[32]; float run = 0.f;
            const int ibase = rnd * 64 + half * 32;
            unsigned short kraw[32], qraw[32];
#pragma unroll
            for (int ii = 0; ii < 32; ++ii) { const int i = ibase + ii, tok = dir == 0 ? i : 127 - i; const size_t gi = (size_t)(r0 + tok) * 1024 + gc;
                kraw[ii] = KB[gi]; qraw[ii] = lat ? QB[gi] : (unsigned short)0; }
#pragma unroll
            for (int ii = 0; ii < 32; ++ii) {
                const int i = ibase + ii, tok = dir == 0 ? i : 127 - i;
                const LAS f32x4* lp = (const LAS f32x4*)(lrs + tok * 32 + dir * 16);
                f32x2 x2 = (f32x2){bias, 0.f};
#pragma unroll
                for (int q = 0; q < 4; ++q) { const f32x4 l4 = lp[q];
                    x2 = __builtin_elementwise_fma((f32x2){l4[0], l4[1]}, (f32x2){wv[q * 4], wv[q * 4 + 1]}, x2);
                    x2 = __builtin_elementwise_fma((f32x2){l4[2], l4[3]}, (f32x2){wv[q * 4 + 2], wv[q * 4 + 3]}, x2); }
                const float xg = x2.x + x2.y;
                const float ls = fminf(xg, 0.f) - __logf(1.0f + __expf(-fabsf(xg)));
                run += ls * 0.0625f; bl[ii] = run;
            }
            __syncthreads();
            seg[half * 256 + d] = run;
            __syncthreads();
            const float s0 = seg[d], s1 = seg[256 + d];
            const float off = carry + (half == 1 ? s0 : 0.f);
            carry += s0 + s1;
#pragma unroll
            for (int ii = 0; ii < 32; ++ii) {
                const int i = ibase + ii, tok = dir == 0 ? i : 127 - i;
                const float bb = bl[ii] + off; const float eb = __expf(bb), ieb = __expf(-bb);
                Ks[tok * 264 + d] = f2bf(bf2f(kraw[ii]) * ieb);
                if (lat) { const bf16_t qv = f2bf(bf2f(qraw[ii]) * 0.0625f * eb); Qs[tok * 264 + d] = qv; }
            }
        }
        if (half == 1) ((float*)(ws + O_DD))[((size_t)chain * 66 + ck) * 256 + d] = __expf(carry);
        __syncthreads();
        if (lat) {
            f32x4 a[8];
#pragma unroll
            for (int n = 0; n < 8; ++n) a[n] = (f32x4){0.f, 0.f, 0.f, 0.f};
#pragma unroll
            for (int s = 0; s < 8; ++s) { const bf16x8 qfr = *(const LAS bf16x8*)(Qs + (16 * w + fr) * 264 + s * 32 + fq * 8);
#pragma unroll
                for (int n = 0; n < 8; ++n) { const bf16x8 kfr = *(const LAS bf16x8*)(Ks + (n * 16 + fr) * 264 + s * 32 + fq * 8); a[n] = MFMA16(kfr, qfr, a[n]); }
                __builtin_amdgcn_sched_barrier(0); }
            bf16_t* ab = (bf16_t*)(ws + O_XR) + (size_t)(chain * 64 + ck) * 16384;
            {
#pragma unroll
                for (int it = 0; it < 8; ++it) { const int idx = it * 512 + tid, f = idx >> 6, L = idx & 63;
                    const u32x4 v = *(const LAS u32x4*)(Qs + (16 * (f >> 3) + (L & 15)) * 264 + (f & 7) * 32 + (L >> 4) * 8);
                    *(u32x4*)(qdst + (size_t)(r0 + 2 * f + (L >> 5)) * 1024 + h * 256 + (L & 31) * 8) = v; }
            }
            const int cmr = (fq * 4 - 16 * w - fr + opaque0()) * (dir == 0 ? 1 : -1);
#pragma unroll
            for (int n = 0; n < 8; ++n) { float v[4];
#pragma unroll
                for (int j = 0; j < 4; ++j) { const int dcr = cmr + (dir == 0 ? (n * 16 + j) : -(n * 16 + j)); v[j] = dcr <= 0 ? a[n][j] : 0.f; }
                u32x2 pk; pk.x = cvt_pk_bf16(v[0], v[1]); pk.y = cvt_pk_bf16(v[2], v[3]);
                *(u32x2*)(ab + ((w * 4 + (n >> 1)) * 64 + ((n & 1) * 2 + (fq >> 1)) * 16 + fr) * 8 + (fq & 1) * 4) = pk; }
        }
        {
            bf16_t* kt = (bf16_t*)(ws + O_KT) + ((size_t)(chain * 66 + ck)) * 32768 + ((size_t)((d >> 5) * 2 + ((d >> 4) & 1)) * 4 * 64 + (d & 15)) * 8;
#pragma unroll
            for (int it = 0; it < 8; ++it) { const int tc = it * 2 + half; unsigned short e[8];
#pragma unroll
                for (int q = 0; q < 8; ++q) e[q] = Ks[(tc * 8 + q) * 264 + d];
                u32x4 pk; pk.x = e[0] | ((unsigned)e[1] << 16); pk.y = e[2] | ((unsigned)e[3] << 16); pk.z = e[4] | ((unsigned)e[5] << 16); pk.w = e[6] | ((unsigned)e[7] << 16);
                *(u32x4*)(kt + ((tc >> 2) * 64 + (tc & 3) * 16) * 8) = pk; }
        }
    }
}

__device__ void glaseq_item(LAS unsigned char* lds, const P& p, int item) {
    const int tid = threadIdx.x + opaque0(), w = __builtin_amdgcn_readfirstlane(tid >> 6), lane = tid & 63, fr = lane & 15, fq = lane >> 4;
    const int chain = item & 15, sl = item >> 4, dir = chain >> 3, b = (chain >> 2) & 1, h = chain & 3;
    unsigned char* ws = p.ws;
    LAS bf16_t* Ss = (LAS bf16_t*)lds;
    const bf16_t* VBT = (const bf16_t*)(ws + O_VBT) + (size_t)(h * 512 + sl * 32 + fr) * NROW + fq * 8;
    const bf16_t* KT = (const bf16_t*)(ws + O_KT) + (size_t)chain * 66 * 32768 + ((size_t)w * 2 * 4 * 64 + lane) * 8;
    const bf16_t* QT = (const bf16_t*)(ws + (dir == 0 ? O_QF : O_QB));
    const bf16_t* AB = (const bf16_t*)(ws + O_XR) + (size_t)chain * 64 * 128 * 128;
    const float* DD = (const float*)(ws + O_DD) + (size_t)chain * 66 * 256 + 32 * w + fq * 4;
    bf16_t* OB = (bf16_t*)(ws + O_OF) + (size_t)dir * NTOK * 2048;
    f32x4 st[2][2];
#pragma unroll
    for (int t = 0; t < 2; ++t)
#pragma unroll
        for (int n = 0; n < 2; ++n) st[t][n] = (f32x4){0.f, 0.f, 0.f, 0.f};
#define GS_CK(s_) (dir == 0 ? ((s_) < 2 ? 64 + (s_) : (s_) - 2) : 65 - (s_))
#define GS_R0(s_, ck_) ((s_) >= 2 ? b * T_ + (ck_) * 128 : NTOK + b * 256 + ((ck_) - 64) * 128)
#define GS_LOADK(KF, DDv, s_) do { const int ck_ = GS_CK(s_); \
        _Pragma("unroll") for (int n = 0; n < 2; ++n) _Pragma("unroll") for (int q = 0; q < 4; ++q) KF[n][q] = *(const bf16x8*)(KT + (size_t)ck_ * 32768 + ((n * 4 + q) * 64) * 8); \
        DDv[0] = *(const f32x4*)(DD + (size_t)ck_ * 256); DDv[1] = *(const f32x4*)(DD + (size_t)ck_ * 256 + 16); } while (0)
#define GS_LOADV8(VF, s_) do { const int ck_ = GS_CK(s_); const int r0_ = GS_R0(s_, ck_); \
        _Pragma("unroll") for (int n = 0; n < 2; ++n) _Pragma("unroll") for (int q = 0; q < 4; ++q) VF[n][q] = *(const bf16x8*)(VBT + (size_t)n * 16 * NROW + r0_ + q * 32); } while (0)
#define GS_VFRAG(dst, s_) do { const int ck_ = GS_CK(s_); const int r0_ = GS_R0(s_, ck_); dst = *(const bf16x8*)(VBT + (size_t)(w >> 2) * 16 * NROW + r0_ + (w & 3) * 32); } while (0)
#define GS_UPDATE(VF, KF, DDv) do { _Pragma("unroll") for (int t = 0; t < 2; ++t) _Pragma("unroll") for (int n = 0; n < 2; ++n) { f32x4 tmp = st[t][n]; \
        _Pragma("unroll") for (int q = 0; q < 4; ++q) tmp = MFMA16(KF[t][q], VF[n][q], tmp); st[t][n] = tmp * DDv[t]; } } while (0)
#define GS_LOADQA(s_) do { const int ck_ = GS_CK(s_); const int r0_ = GS_R0(s_, ck_); \
        const bf16_t* qp_ = QT + (size_t)(r0_ + 16 * w + (lane >> 5)) * 1024 + h * 256 + (lane & 31) * 8; const bf16_t* ap_ = AB + (size_t)ck_ * 16384 + ((size_t)w * 4 * 64 + lane) * 8; \
        _Pragma("unroll") for (int q = 0; q < 8; ++q) qfr[q] = *(const bf16x8*)(qp_ + (size_t)q * 2 * 1024); \
        _Pragma("unroll") for (int q = 0; q < 4; ++q) if (q >= qlo && q <= qhi) af[q] = *(const bf16x8*)(ap_ + q * 64 * 8); } while (0)
    bf16x8 kfA[2][4], kfB[2][4], qfr[8], af[4], vcur; f32x4 ddA[2], ddB[2];
    const int qlo = dir == 0 ? 0 : (w >> 1), qhi = dir == 0 ? (w >> 1) : 3;
#pragma unroll
    for (int q = 0; q < 4; ++q) af[q] = (bf16x8){0, 0, 0, 0, 0, 0, 0, 0};
    LAS bf16x8* Vl = (LAS bf16x8*)(lds + 16896);
    __syncthreads();
    {
        bf16x8 vf0[2][4];
        GS_LOADK(kfA, ddA, 0); GS_LOADV8(vf0, 0); GS_LOADK(kfB, ddB, 1);
        GS_UPDATE(vf0, kfA, ddA);
        GS_LOADV8(vf0, 1);
        GS_LOADK(kfA, ddA, 2); GS_LOADQA(2); GS_VFRAG(vcur, 2);
        GS_UPDATE(vf0, kfB, ddB);
    }
#define GS_STEP(KF, DDv, KFN, DDN, s_) do { \
        const int sn_ = (s_) + 1 < 66 ? (s_) + 1 : 65; \
        GS_LOADK(KFN, DDN, sn_); \
        LDS_BARRIER(); \
        _Pragma("unroll") for (int t = 0; t < 2; ++t) _Pragma("unroll") for (int n = 0; n < 2; ++n) { u32x2 pk; pk.x = cvt_pk_bf16(st[t][n][0], st[t][n][1]); pk.y = cvt_pk_bf16(st[t][n][2], st[t][n][3]); \
            *(LAS u32x2*)(Ss + (n * 16 + fr) * 264 + 32 * w + t * 16 + fq * 4) = pk; } \
        Vl[w * 64 + lane] = vcur; \
        LDS_BARRIER(); \
        bf16x8 vf[2][4]; \
        _Pragma("unroll") for (int n = 0; n < 2; ++n) _Pragma("unroll") for (int q = 0; q < 4; ++q) vf[n][q] = Vl[(n * 4 + q) * 64 + lane]; \
        GS_VFRAG(vcur, sn_); \
        GS_UPDATE(vf, KF, DDv); \
        f32x4 oo[2] = {(f32x4){0.f, 0.f, 0.f, 0.f}, (f32x4){0.f, 0.f, 0.f, 0.f}}; \
        _Pragma("unroll") for (int q = 0; q < 4; ++q) if (q >= qlo && q <= qhi) { _Pragma("unroll") for (int n = 0; n < 2; ++n) oo[n] = MFMA16(vf[n][q], af[q], oo[n]); } \
        _Pragma("unroll") for (int q = 0; q < 8; ++q) _Pragma("unroll") for (int n = 0; n < 2; ++n) { \
            const bf16x8 sf = *(const LAS bf16x8*)(Ss + (n * 16 + fr) * 264 + q * 32 + fq * 8); oo[n] = MFMA16(sf, qfr[q], oo[n]); } \
        { const int ck_ = GS_CK(s_); const int r0_ = GS_R0(s_, ck_); bf16_t* op = OB + (size_t)(r0_ + 16 * w + fr) * 2048 + h * 512 + sl * 32 + fq * 4; \
          _Pragma("unroll") for (int n = 0; n < 2; ++n) { u32x2 pk; pk.x = cvt_pk_bf16(oo[n][0], oo[n][1]); pk.y = cvt_pk_bf16(oo[n][2], oo[n][3]); *(u32x2*)(op + n * 16) = pk; } } \
        GS_LOADQA(sn_); \
    } while (0)
#pragma unroll 1
    for (int s = 2; s < 66; s += 2) {
        GS_STEP(kfA, ddA, kfB, ddB, s);
        GS_STEP(kfB, ddB, kfA, ddA, s + 1);
    }
#undef GS_CK
#undef GS_R0
#undef GS_LOADK
#undef GS_LOADV8
#undef GS_VFRAG
#undef GS_UPDATE
#undef GS_LOADQA
#undef GS_STEP
}

__device__ void phase_glafinal(const P& p, bf16_t* cc) {
    const int tix = threadIdx.x + opaque0(); const int lane = tix & 63, gw = blockIdx.x * 8 + (tix >> 6), nw = gridDim.x * 8;
    const bf16_t* OF = (const bf16_t*)(p.ws + O_OF); const bf16_t* OBk = OF + (size_t)NTOK * 2048;
    f32x4 g0 = *(const f32x4*)(p.gla_norm + lane * 8), g1 = *(const f32x4*)(p.gla_norm + lane * 8 + 4);
    for (int i = gw; i < NTOK * 4; i += nw) {
        const size_t o = (size_t)i * 512 + lane * 8;
        float a[8], c[8]; unpack8(*(const u32x4*)(OF + o), a); unpack8(*(const u32x4*)(OBk + o), c);
        float ss = 0.f;
#pragma unroll
        for (int e = 0; e < 8; ++e) { a[e] += c[e]; ss += a[e] * a[e]; }
        ss = wave_sum(ss); const float rs = rsqrtf(ss * (1.0f / 512) + EPS_);
#pragma unroll
        for (int e = 0; e < 4; ++e) { a[e] *= rs * g0[e]; a[4 + e] *= rs * g1[e]; }
        const int r = i >> 2, hh = i & 3;
        *(u32x4*)(cc + (size_t)r * 4096 + 2048 + hh * 512 + lane * 8) = pack8(a);
    }
}

__device__ void phase_conv(const P& p, const bf16_t* U, int ldu, int j0, int ns, bf16_t* act) {
    const int ncg = ns * 16, ntask = 256 * ncg;
    for (int task = blockIdx.x * 512 + threadIdx.x + opaque0(); task < ntask; task += gridDim.x * 512) {
        const int run = task / ncg, cgi = task % ncg, jl = cgi >> 4, i8 = (cgi & 15) * 8;
        const int ch = 128 * (j0 + jl) + i8; const int ucol = jl * 256 + i8;
        float wa[3][8], wg[3][8], ba[8], bg[8];
#pragma unroll
        for (int j = 0; j < 3; ++j)
#pragma unroll
            for (int e = 0; e < 8; ++e) { wa[j][e] = p.conv_w[j * 11264 + ch + e]; wg[j][e] = p.conv_w[j * 11264 + 5632 + ch + e]; }
#pragma unroll
        for (int e = 0; e < 8; ++e) { ba[e] = p.conv_b[ch + e]; bg[e] = p.conv_b[5632 + ch + e]; }
        const int rw0 = run * 64; const int tl0 = rw0 & (T_ - 1);
        float pa[8], pg[8], ca[8], cg_[8], na[8], ng[8];
        const bf16_t* up = U + (size_t)rw0 * ldu + ucol;
        if (tl0 > 0) { unpack8(*(const u32x4*)(up - ldu), pa); unpack8(*(const u32x4*)(up - ldu + 128), pg); }
        else {
#pragma unroll
            for (int e = 0; e < 8; ++e) { pa[e] = 0.f; pg[e] = 0.f; } }
        unpack8(*(const u32x4*)(up), ca); unpack8(*(const u32x4*)(up + 128), cg_);
#pragma unroll 1
        for (int i0 = 0; i0 < 64; i0 += 8) {
            u32x4 ra[8], rg[8];
#pragma unroll
            for (int k = 0; k < 8; ++k) { const int rn = rw0 + i0 + k + 1; const bf16_t* q = U + (size_t)(rn < NTOK ? rn : NTOK - 1) * ldu + ucol;
                ra[k] = *(const u32x4*)q; rg[k] = *(const u32x4*)(q + 128); }
#pragma unroll
            for (int k = 0; k < 8; ++k) {
                const int i = i0 + k; const bool has_next = (tl0 + i + 1) < T_;
                unpack8(ra[k], na); unpack8(rg[k], ng);
                if (!has_next) {
#pragma unroll
                    for (int e = 0; e < 8; ++e) { na[e] = 0.f; ng[e] = 0.f; } }
                float y[8];
#pragma unroll
                for (int e = 0; e < 8; ++e) { const float av = wa[0][e] * pa[e] + wa[1][e] * ca[e] + wa[2][e] * na[e] + ba[e]; const float gv = wg[0][e] * pg[e] + wg[1][e] * cg_[e] + wg[2][e] * ng[e] + bg[e];
                    y[e] = siluf_(av) * gv; pa[e] = ca[e]; pg[e] = cg_[e]; ca[e] = na[e]; cg_[e] = ng[e]; }
                *(u32x4*)(act + (size_t)(rw0 + i) * 5632 + ch) = pack8(y);
            }
        }
    }
}


#ifdef DBG_STOP
__device__ void dbg_dump(cg::grid_group& grid, const P& p, const bf16_t* src, size_t ld, int rows, int cols) {
    bf16_t* tmp = (bf16_t*)(p.ws + O_MIXEND);
    grid.sync();
    const size_t n = (size_t)rows * cols;
    for (size_t i = (size_t)blockIdx.x * 512 + threadIdx.x; i < n; i += (size_t)gridDim.x * 512) tmp[i] = src[(i / cols) * ld + (i % cols)];
    grid.sync();
    for (size_t i = (size_t)blockIdx.x * 512 + threadIdx.x; i < (size_t)NTOK * DM; i += (size_t)gridDim.x * 512) {
        const size_t r = i / DM, c = i % DM; p.out[i] = (r < (size_t)rows && c < (size_t)cols) ? bf2f(tmp[r * cols + c]) : 0.f; }
}
#define DBG_AT(k, src, ld, rows, cols) if (DBG_STOP == k) { dbg_dump(grid, p, (const bf16_t*)(src), ld, rows, cols); return; }
#else
#define DBG_AT(k, src, ld, rows, cols)
#endif

#ifdef DBG_STOP
__device__ void dbg_nancount(cg::grid_group& grid, const P& p, const bf16_t* src, size_t n, int mode) {
    unsigned* cnt = (unsigned*)(p.ws + O_MIXEND);
    grid.sync();
    if (blockIdx.x == 0 && threadIdx.x == 0) { cnt[0] = 0; cnt[1] = 0; }
    grid.sync();
    unsigned c = 0; float mx = 0.f;
    for (size_t i = (size_t)blockIdx.x * 512 + threadIdx.x; i < n; i += (size_t)gridDim.x * 512) { const unsigned short v = src[i]; if ((v & 0x7f80) == 0x7f80) ++c; else mx = fmaxf(mx, fabsf(bf2f(v))); }
    if (c) atomicAdd(cnt, c);
    atomicMax(cnt + 1, __float_as_uint(mx));
    grid.sync();
    for (size_t i = (size_t)blockIdx.x * 512 + threadIdx.x; i < (size_t)NTOK * DM; i += (size_t)gridDim.x * 512) p.out[i] = 0.f;
    grid.sync();
    if (blockIdx.x == 0 && threadIdx.x == 0) p.out[0] = mode == 0 ? (float)cnt[0] : __uint_as_float(cnt[1]);
}
#define DBG_NAN(k, src, n) if (DBG_STOP == k) { dbg_nancount(grid, p, (const bf16_t*)(src), n, 0); return; } if (DBG_STOP == k + 100) { dbg_nancount(grid, p, (const bf16_t*)(src), n, 1); return; }
#else
#define DBG_NAN(k, src, n)
#endif
#define XB_TMO      128
#define XB_XCNT(j)  (256  + 64 * (j))
#define XB_XSUB(j)  (1280 + 64 * (j))
#define XB_XGEN(j)  (2304 + 64 * (j))
#define XB_TOP      3328
#define XB_TOPGEN   3392
#define XCD_BAR_WORDS 3456
#define XB_SPIN_CAP (1u << 18)

__device__ __forceinline__ unsigned xb_ld(unsigned* p)              { return __hip_atomic_load(p, __ATOMIC_RELAXED, __HIP_MEMORY_SCOPE_AGENT); }
__device__ __forceinline__ unsigned xb_add(unsigned* p, unsigned v) { return __hip_atomic_fetch_add(p, v, __ATOMIC_RELAXED, __HIP_MEMORY_SCOPE_AGENT); }
__device__ __forceinline__ unsigned xb_xcc_id() { return (unsigned)__builtin_amdgcn_s_getreg((3 << 11) | 20) & 0xFu; }
#define XB_SPIN(cond, bar) do { unsigned _sp = 0; while (cond) { __builtin_amdgcn_s_sleep(1); \
    if ((++_sp & 255u) == 0u) { if (xb_ld(&(bar)[XB_TMO])) break; if (_sp > XB_SPIN_CAP) { atomicAdd(&(bar)[XB_TMO], 1u); break; } } } } while (0)

struct XcdBarrier {
    unsigned* bar; unsigned x;
    volatile LAS unsigned* st;
};

__device__ __forceinline__ XcdBarrier xcd_barrier_post(unsigned* bar, volatile LAS unsigned* st) {
    XcdBarrier b; b.bar = bar; b.x = xb_xcc_id(); b.st = st;
    if (threadIdx.x == 0) (void)xb_add(&bar[XB_XCNT(b.x)], 1u);
    return b;
}
__device__ __forceinline__ void xcd_barrier_complete(unsigned* bar, unsigned x, unsigned& nloc, unsigned& nx) {
    const unsigned G = gridDim.x * gridDim.y * gridDim.z;
    unsigned sum, cnt, mine, sp = 0u;
    for (;;) {
        sum = 0u; cnt = 0u; mine = 0u;
#pragma unroll
        for (unsigned j = 0; j < 16; ++j) { const unsigned c = xb_ld(&bar[XB_XCNT(j)]); sum += c; cnt += (c > 0u) ? 1u : 0u; mine = (j == x) ? c : mine; }
        if (sum == G) break;
        __builtin_amdgcn_s_sleep(1);
        if ((++sp & 255u) == 0u) { if (xb_ld(&bar[XB_TMO])) break; if (sp > XB_SPIN_CAP) { atomicAdd(&bar[XB_TMO], 1u); break; } }
    }
    nloc = mine > 0u ? mine : 1u; nx = cnt > 0u ? cnt : 1u;
}

__device__ __forceinline__ void xcd_barrier(const XcdBarrier& b) {
    asm volatile("s_waitcnt vmcnt(0)" ::: "memory");
    __syncthreads();
    if (threadIdx.x == 0) {
        unsigned* bar = b.bar;
        __builtin_amdgcn_s_waitcnt(0);
        unsigned nloc = b.st[0], nx = b.st[1];
        if (nloc == 0u) { xcd_barrier_complete(bar, b.x, nloc, nx); b.st[0] = nloc; b.st[1] = nx; }
        const unsigned old = xb_add(&bar[XB_XSUB(b.x)], 1u);
        const unsigned gen = old / nloc;
        if (old + 1u == (gen + 1u) * nloc) {
            __builtin_amdgcn_fence(__ATOMIC_RELEASE, "agent");
            asm volatile("s_waitcnt vmcnt(0)" ::: "memory");
            const unsigned og = xb_add(&bar[XB_TOP], 1u);
            const unsigned tg = og / nx;
            if (og + 1u == (tg + 1u) * nx) xb_add(&bar[XB_TOPGEN], 1u);
            else XB_SPIN(xb_ld(&bar[XB_TOPGEN]) == tg, bar);
            __builtin_amdgcn_fence(__ATOMIC_ACQUIRE, "agent");
            xb_add(&bar[XB_XGEN(b.x)], 1u);
            asm volatile("s_waitcnt vmcnt(0)" ::: "memory");
        } else {
            XB_SPIN(xb_ld(&bar[XB_XGEN(b.x)]) == gen, bar);
            __builtin_amdgcn_fence(__ATOMIC_ACQUIRE, "agent");
            asm volatile("s_waitcnt vmcnt(0)" ::: "memory");
        }
    }
    __syncthreads();
}


__global__ void __launch_bounds__(512) fwd_megakernel(P p) {
    extern __shared__ __attribute__((aligned(16))) unsigned char shm[];
    LAS unsigned char* lds = (LAS unsigned char*)shm;
    cg::grid_group grid = cg::this_grid();
    volatile LAS unsigned* xst = (volatile LAS unsigned*)(lds + 153600);
    if (threadIdx.x == 0) { xst[0] = 0u; xst[1] = 0u; }
    __syncthreads();
    const XcdBarrier xb = xcd_barrier_post((unsigned*)(p.ws + O_BAR), xst);
#ifdef TIME_A
    unsigned long long ts0 = 0, ts1 = 0, ts2 = 0, ts3 = 0, ts4 = 0, ts5 = 0, ts6 = 0, ts7 = 0, ts8 = 0, ts9 = 0, ts10 = 0, ts11 = 0, ts12 = 0, ts13 = 0;
#define TS(k) ts##k = __builtin_amdgcn_s_memrealtime();
#define TSCAT2(a) ts##a
#define TSCAT(a) TSCAT2(a)
#else
#define TS(k)
#endif
    TS(0)
    unsigned char* ws = p.ws; const int nb = gridDim.x, bid = blockIdx.x;
    float* mod = (float*)(ws + O_MOD);
    bf16_t* cc = (bf16_t*)p.out;

#ifndef PHMASK
#define PHMASK 0xffff
#endif
    if (PHMASK & 1) phase0(lds, p);
    xcd_barrier(xb); if (p.pad == 0x7eadbeef) grid.sync();
    TS(1)
#ifdef DBL_P0
    phase0(lds, p);
    xcd_barrier(xb);
#endif
    if (PHMASK & 1) phase_modreduce(p);
    xcd_barrier(xb);
    TS(2)
    if (PHMASK & 1) phase_modulate(p.x, p.ctx, p.g_mix, mod, 0, 1, (bf16_t*)(ws + O_H), NROW);
    xcd_barrier(xb);
    TS(3)
    if (PHMASK & 2) { SchedProj1 S{(const char*)(ws + O_H), (const char*)(ws + O_XR), ws, nb, bid}; EpiProj1 E; pg8::gemm_phase(lds, 2048, S, E); }
    xcd_barrier(xb);
    TS(4)
    DBG_AT(1, ws + O_QA, 2048, 8192, 2048)
    DBG_AT(2, ws + O_VBT, NROW, 2048, 2048)
    DBG_AT(11, ws + O_H, 2048, 8192, 2048)
    DBG_AT(12, ws + O_KB, 1024, 8192, 1024)
    phase_kprep(p);
    xcd_barrier(xb);
    {
        unsigned* qctr = (unsigned*)(ws + O_BAR + 16384); volatile LAS unsigned* qs = (volatile LAS unsigned*)(lds + 153608);
        for (;;) {
            __syncthreads();
            if (threadIdx.x == 0) qs[0] = __hip_atomic_fetch_add(qctr, 1u, __ATOMIC_RELAXED, __HIP_MEMORY_SCOPE_AGENT);
            __syncthreads();
            const int it = (int)qs[0];
            if (it >= 528 + 1024) break;
            if (it < 528) glaprep_item(lds, p, it); else attn_item(lds, p, cc, it - 528);
        }
    }
    xcd_barrier(xb);
    TS(5)
    DBG_AT(3, cc, 4096, 8192, 2048)
    DBG_AT(4, ws + O_QF, 1024, 8192, 1024)
    DBG_AT(5, ws + O_XR, 2048, 8192, 2048)
    DBG_AT(6, ws + O_KT, NROW, 2048, 2048)
    DBG_AT(13, ws + O_QB, 1024, 8192, 1024)
#if defined(DBG_STOP) && DBG_STOP == 16
    { xcd_barrier(xb); for (size_t i = (size_t)bid * 512 + threadIdx.x; i < (size_t)NTOK * DM; i += (size_t)nb * 512) p.out[i] = i < 270336 ? ((const float*)(ws + O_DD))[i] : 0.f; return; }
#endif
    if (PHMASK & 16) for (int it = bid; it < 256; it += nb) glaseq_item(lds, p, it);
    xcd_barrier(xb);
    TS(6)
#ifdef DBL_SEQ
    for (int it = bid; it < 256; it += nb) glaseq_item(lds, p, it);
    xcd_barrier(xb);
#endif
    DBG_AT(7, ws + O_OF, 2048, 8192, 2048)
    DBG_NAN(20, ws + O_OF, (size_t)2 * NTOK * 2048)
    DBG_NAN(21, ws + O_KT, (size_t)2 * 1024 * NROW)
    DBG_AT(14, ws + O_OF + 67108864, 2048, 8192, 2048)
    if (PHMASK & 32) phase_glafinal(p, cc);
    xcd_barrier(xb);
    TS(7)
    DBG_AT(8, cc + 2048, 4096, 8192, 2048)
    if (PHMASK & 64) { SchedProj2 S{(const char*)(ws + O_H), (const char*)(ws + O_W2IN), ws, cc, nb, bid}; EpiProj2 E; pg8::gemm_phase(lds, 2048, S, E); }
    xcd_barrier(xb);
    TS(8)
    DBG_AT(9, ws + O_GA, 2048, 8192, 2048)
    DBG_AT(15, cc + 2048, 4096, 8192, 2048)
    if (PHMASK & 128) { SchedMerge S{(const char*)cc, (const char*)(ws + O_WMRG), ws, nb, bid}; EpiMerge E{(const bf16_t*)(ws + O_GA), (const bf16_t*)(ws + O_GA + 67108864)}; pg8::gemm_phase(lds, 4096, S, E); }
    xcd_barrier(xb);
    TS(9)
    DBG_AT(10, ws + O_M, 2048, 8192, 2048)
    if (PHMASK & 256) { SchedRes S{(const char*)(ws + O_M), (const char*)(ws + O_WOUT), 2048, nb, bid}; EpiDelta E{(bf16_t*)(ws + O_D1), mod + 2 * 2048}; pg8::gemm_phase(lds, 2048, S, E); }
    xcd_barrier(xb);
    TS(10)
#ifdef DBG_STOP_WOUT
    return;
#endif
    phase_modulate2(p.x, (const bf16_t*)(ws + O_D1), p.g_ffn, mod, 3, 4, (bf16_t*)(ws + O_H2));
    { LAS float* tl = (LAS float*)lds; const int J5 = 32 * 44, J6 = 88 * 8, JT = J5 + J6; const int tid = threadIdx.x + opaque0();
      auto job2 = [&](int it) -> TJob { return it < J5 ? tj_make(p.w_up, 11264, (bf16_t*)(ws + O_WUP), 2048, 11264, 3, 0, it) : tj_make(p.w_down, 2048, (bf16_t*)(ws + O_WDN), 5632, 2048, 0, 0, it - J5); };
      int it = bid; f32x4 v[8]; TJob cur;
      if (it < JT) { cur = job2(it); tj_load(cur, tid, v); }
      while (it < JT) {
          LDS_BARRIER(); tj_store(tl, cur, tid, v);
          const int itn = it + nb; TJob nxt = cur; if (itn < JT) { nxt = job2(itn); tj_load(nxt, tid, v); }
          LDS_BARRIER(); tj_flush(tl, cur, tid);
          cur = nxt; it = itn; } }
    xcd_barrier(xb);
    TS(11)
    { SchedUpC S{(const char*)(ws + O_H2), (const char*)(ws + O_WUP), nb, bid}; EpiUpConv E{p.conv_w, p.conv_b, (bf16_t*)(ws + O_U), (float*)(ws + O_U + 184549376), lds}; pg8::gemm_phase(lds, 2048, S, E); }
    xcd_barrier(xb);
    phase_convfix(p, (const float*)(ws + O_U + 184549376), (bf16_t*)(ws + O_U));
    xcd_barrier(xb);
    TS(12)
    if (PHMASK & 4096) { SchedRes S{(const char*)(ws + O_U), (const char*)(ws + O_WDN), 5632, nb, bid}; EpiRes2 E{p.x, (const bf16_t*)(ws + O_D1), p.out, mod + 5 * 2048}; pg8::gemm_phase(lds, 5632, S, E); }
#ifdef TIME_A
    xcd_barrier(xb); TS(13)
    if (bid == 0 && threadIdx.x == 0) p.out[0] = (float)(TSCAT(TIME_B) - TSCAT(TIME_A));
#endif
#ifdef DBG_COPYX
    xcd_barrier(xb);
    for (size_t i = (size_t)bid * 512 + threadIdx.x; i < (size_t)NTOK * DM / 4; i += (size_t)nb * 512) ((f32x4*)p.out)[i] = ((const f32x4*)p.x)[i];
#endif
}

extern "C" void kernel_launch(void* const* d_in, const int* in_sizes, int n_in, void* d_out, int out_size, void* d_ws, size_t ws_size, hipStream_t stream) {
    static int grid_blocks = 0;
    if (grid_blocks == 0) {
        int dev = 0, cus = 0, per_cu = 0;
        hipGetDevice(&dev); hipDeviceGetAttribute(&cus, hipDeviceAttributeMultiprocessorCount, dev);
        if (hipFuncSetAttribute((const void*)fwd_megakernel, hipFuncAttributeMaxDynamicSharedMemorySize, LDS_BYTES) != hipSuccess) { fprintf(stderr, "kernel_launch: hipFuncSetAttribute failed\n"); grid_blocks = -1; return; }
        if (hipOccupancyMaxActiveBlocksPerMultiprocessor(&per_cu, (const void*)fwd_megakernel, 512, LDS_BYTES) != hipSuccess || per_cu < 1) { fprintf(stderr, "kernel_launch: occupancy query gave %d\n", per_cu); per_cu = 1; }
        (void)hipGetLastError();
        grid_blocks = cus * 1;
    }
    if (grid_blocks < 0) return;
    P p{};
    const float** f = (const float**)&p;
    for (int i = 0; i < 24; ++i) f[i] = (const float*)d_in[i];
    p.out = (float*)d_out; p.ws = (unsigned char*)d_ws;
    const size_t act_bytes = 184549376;
    if (ws_size >= O_U + (size_t)24 * 256 * NTOK * 2 + act_bytes) { p.ns[0] = 20; p.ns[1] = 24; p.ns[2] = 0; p.nsmax = 24; }
    else { p.ns[0] = 16; p.ns[1] = 16; p.ns[2] = 12; p.ns[3] = 0; p.nsmax = 16; }
    p.o_act = (long long)(O_U + (size_t)p.nsmax * 256 * NTOK * 2);
    if (ws_size < (size_t)p.o_act + act_bytes || ws_size < O_MIXEND) { fprintf(stderr, "kernel_launch: workspace too small (%zu)\n", ws_size); return; }
    if (ws_size < O_BAR + 16384 + 256) { fprintf(stderr, "kernel_launch: workspace too small for the barrier words (%zu)\n", ws_size); return; }
    if (hipMemsetAsync((char*)d_ws + O_BAR, 0, 16384 + 256, stream) != hipSuccess) { fprintf(stderr, "kernel_launch: memset failed\n"); return; }
    void* args[] = {&p};
    hipError_t e = hipLaunchCooperativeKernel((void*)fwd_megakernel, dim3(grid_blocks), dim3(512), args, LDS_BYTES, stream);
    if (e != hipSuccess) fprintf(stderr, "cooperative launch failed: %s (grid %d)\n", hipGetErrorString(e), grid_blocks);
}
```

```cpp
#include <hip/hip_runtime.h>
#include <hip/hip_cooperative_groups.h>
#include <cstdio>
namespace cg = cooperative_groups;

#define LAS __attribute__((address_space(3)))
typedef unsigned short bf16_t;
typedef short bf16x8 __attribute__((ext_vector_type(8)));
typedef float f32x4 __attribute__((ext_vector_type(4)));
typedef float f32x2 __attribute__((ext_vector_type(2)));
typedef unsigned u32x4 __attribute__((ext_vector_type(4)));
typedef unsigned u32x2 __attribute__((ext_vector_type(2)));

constexpr int T_ = 8192, NTOK = 16384, NROW = 16896, DM = 2048;
constexpr int LDS_BYTES = 153616;
constexpr size_t O_BAR = 530000896;
constexpr float EPS_ = 1e-6f;

constexpr size_t O_MODP = 0;
constexpr size_t O_MOD = O_MODP + 4718592;
constexpr size_t O_ROPE = O_MOD + 147456;
constexpr size_t O_DD = O_ROPE + 32768;
constexpr size_t O_BASE = O_DD + 1081344;
constexpr size_t O_W2IN = O_BASE;
constexpr size_t O_WMRG = O_W2IN + 25165824;
constexpr size_t O_WOUT = O_WMRG + 16777216;
constexpr size_t O_H = O_WOUT + 8388608;
constexpr size_t O_XR = O_H + 69206016;
constexpr size_t O_QA = O_XR + 33554432;
constexpr size_t O_KA = O_QA + 67108864;
constexpr size_t O_VAT = O_KA + 17301504;
constexpr size_t O_KB = O_VAT + 17301504;
constexpr size_t O_QB = O_KB + 34603008;
constexpr size_t O_VBT = O_QB + 33554432;
constexpr size_t O_LR = O_VBT + 69206016;
constexpr size_t O_QF = O_LR + 2162688;
constexpr size_t O_KT = O_QF + 33554432;
constexpr size_t O_MIXEND = O_KT + 69206016;
constexpr size_t O_D1 = 400000000;
constexpr size_t O_OF = O_QA;
constexpr size_t O_GA = O_QB;
constexpr size_t O_M = O_QA;
constexpr size_t O_WUP = O_BASE;
constexpr size_t O_WDN = O_WUP + 46137344;
constexpr size_t O_H2 = O_WDN + 23068672;
constexpr size_t O_U = O_H2 + 67108864;

struct P {
    const float *x, *c, *ctx, *c_ctx, *w_mod, *b_mod, *g_mix, *w_in, *q_norm, *k_norm, *sink, *wgf, *bgf, *wgb, *bgb, *gla_norm,
        *w_attn_o, *w_gla_o, *w_out, *g_ffn, *w_up, *conv_w, *conv_b, *w_down;
    float* out;
    unsigned char* ws;
    long long o_act;
    int ns[4];
    int nsmax, pad;
};

typedef __bf16 bf16x2_t __attribute__((ext_vector_type(2)));
__device__ __forceinline__ unsigned cvt_pk_bf16(float lo, float hi) { const f32x2 v = {lo, hi}; const bf16x2_t b = __builtin_convertvector(v, bf16x2_t); return __builtin_bit_cast(unsigned, b); }
__device__ __forceinline__ float bf2f(unsigned short b) { return __uint_as_float(((unsigned)b) << 16); }
__device__ __forceinline__ float bflo(unsigned u) { return __uint_as_float(u << 16); }
__device__ __forceinline__ float bfhi(unsigned u) { return __uint_as_float(u & 0xffff0000u); }
__device__ __forceinline__ bf16_t f2bf(float f) { return (bf16_t)(cvt_pk_bf16(f, 0.f) & 0xffffu); }
__device__ __forceinline__ float wave_sum(float v) {
#pragma unroll
    for (int o = 32; o >= 1; o >>= 1) v += __shfl_xor(v, o);
    return v;
}
__device__ __forceinline__ float sigmoidf_(float x) { return __builtin_amdgcn_rcpf(1.0f + __expf(-x)); }
__device__ __forceinline__ float siluf_(float x) { return x * __builtin_amdgcn_rcpf(1.0f + __expf(-x)); }
__device__ __forceinline__ void unpack8(const u32x4 v, float* f) {
    f[0] = bflo(v.x); f[1] = bfhi(v.x); f[2] = bflo(v.y); f[3] = bfhi(v.y); f[4] = bflo(v.z); f[5] = bfhi(v.z); f[6] = bflo(v.w); f[7] = bfhi(v.w);
}
__device__ __forceinline__ u32x4 pack8(const float* f) {
    u32x4 w; w.x = cvt_pk_bf16(f[0], f[1]); w.y = cvt_pk_bf16(f[2], f[3]); w.z = cvt_pk_bf16(f[4], f[5]); w.w = cvt_pk_bf16(f[6], f[7]); return w;
}
__device__ __forceinline__ int opaque0() { int z; asm volatile("v_mov_b32 %0, 0" : "=v"(z)); return z; }
#define LDS_BARRIER() do { asm volatile("s_waitcnt lgkmcnt(0)" ::: "memory"); __builtin_amdgcn_s_barrier(); asm volatile("" ::: "memory"); } while (0)
#define MFMA16(a, b, c) __builtin_amdgcn_mfma_f32_16x16x32_bf16((a), (b), (c), 0, 0, 0)

namespace pg8 {
constexpr int BM = 256, BK = 64, HALF = 128, HTB = HALF * BK * 2, STAGE_BYTES = 8 * HTB, NXCD = 8, WGM = 8;
__device__ __forceinline__ int lds_byte(int r, int c) { const int st = (r >> 4) * 2 + (c >> 5), rr = r & 15, cc = c & 31, ob = rr * 64 + cc * 2; return st * 1024 + (ob ^ (((ob >> 9) & 1) << 5)); }
__device__ __forceinline__ void stage_rc(int b, int& R, int& C) { const int st = b / 1024, sb = b % 1024, swz = sb ^ (((sb >> 9) & 1) << 5); R = (st >> 1) * 16 + swz / 64; C = (st & 1) * 32 + (swz % 64) / 2; }
__device__ __forceinline__ int perm32(int rho) { const int n = rho >> 4, i = rho & 15; return 8 * (i >> 2) + 4 * n + (i & 3); }

struct Unit { const char* A; const char* B; char* out; int ldc; int kind; int row0; int col0; };

__device__ __forceinline__ void rect_map(int L, int nM, int nN, int& pm, int& pn) {
    const int nwg = nM * nN; int wgid = L;
    { const int q = nwg / NXCD, r = nwg % NXCD, xcd = wgid % NXCD, off = wgid / NXCD; wgid = (xcd < r ? xcd * (q + 1) : r * (q + 1) + (xcd - r) * q) + off; }
    const int nig = WGM * nN, gid = wgid / nig, fm = gid * WGM, gsz = (nM - fm) < WGM ? (nM - fm) : WGM;
    pm = fm + ((wgid % nig) % gsz); pn = (wgid % nig) / gsz;
}

template <class Epi, class Sched>
__device__ __forceinline__ void gemm_phase(LAS unsigned char* lds, const int K, const Sched& S, const Epi& E) {
    const int tid = threadIdx.x + opaque0(), wid = __builtin_amdgcn_readfirstlane(tid >> 6), lane = tid & 63, wr = wid >> 2, wc = wid & 3, fr = lane & 15, fq = lane >> 4;
    const int nt = K / BK;
    unsigned voffA[2], voffB[2];
#pragma unroll
    for (int i = 0; i < 2; ++i) { int R, C; stage_rc(tid * 16 + i * 8192, R, C); const int Rb = (R & ~31) + perm32(R & 31);
        voffA[i] = (unsigned)(R * K + C) * 2u; voffB[i] = (unsigned)(Rb * K + C) * 2u; }
    const size_t kstep = (size_t)(BK * 2);
    const size_t hstep = (size_t)HALF * K * 2;
    const unsigned ldsw = (unsigned)wid * 1024u;
    const int aoff = lds_byte(wr * 64 + fr, fq * 8), boff = lds_byte(wc * 32 + fr, fq * 8);
#define PG8_SA(b, h) (((b) * 2 + (h)) * HTB)
#define PG8_SB(b, h) ((4 + (b) * 2 + (h)) * HTB)
#define PG8_STAGE(bufoff, gbase, voff) do { _Pragma("unroll") for (int _i = 0; _i < 2; ++_i) \
        __builtin_amdgcn_global_load_lds((const unsigned*)((const char*)(gbase) + (voff)[_i]), (LAS unsigned*)(lds + (bufoff) + ldsw + _i * 8192), 16, 0, 0); } while (0)
#define PG8_LDA(dst, b, h) do { _Pragma("unroll") for (int m = 0; m < 4; ++m) _Pragma("unroll") for (int k = 0; k < 2; ++k) dst[m][k] = *(const LAS bf16x8*)(lds + PG8_SA(b, h) + aoff + m * 2048 + k * 1024); } while (0)
#define PG8_LDB(dst, b, h) do { _Pragma("unroll") for (int n = 0; n < 2; ++n) _Pragma("unroll") for (int k = 0; k < 2; ++k) dst[n][k] = *(const LAS bf16x8*)(lds + PG8_SB(b, h) + boff + n * 2048 + k * 1024); } while (0)
#define PG8_MMA(ai, bj, At, Bt) do { __builtin_amdgcn_s_setprio(1); _Pragma("unroll") for (int m = 0; m < 4; ++m) _Pragma("unroll") for (int n = 0; n < 2; ++n) _Pragma("unroll") for (int k = 0; k < 2; ++k) \
        acc[ai][bj][m][n] = __builtin_amdgcn_mfma_f32_16x16x32_bf16(Bt[n][k], At[m][k], acc[ai][bj][m][n], 0, 0, 0); __builtin_amdgcn_s_setprio(0); } while (0)
#define PG8_WAIT_V(n) asm volatile("s_waitcnt vmcnt(" #n ")" ::: "memory")
#define PG8_WAIT_L(n) asm volatile("s_waitcnt lgkmcnt(" #n ")" ::: "memory")
#define PG8_BAR __builtin_amdgcn_s_barrier()
#define PG8_SCHED __builtin_amdgcn_sched_barrier(0)
    Unit cur, nxt; int ui = 0;
    if (!S.next(0, cur)) return;
    f32x4 acc[2][2][4][2];
#pragma unroll
    for (int a = 0; a < 2; ++a)
#pragma unroll
        for (int b = 0; b < 2; ++b)
#pragma unroll
            for (int m = 0; m < 4; ++m)
#pragma unroll
                for (int n = 0; n < 2; ++n) acc[a][b][m][n] = (f32x4){0.f, 0.f, 0.f, 0.f};
    bf16x8 At[4][2], B0[2][2], B1[2][2];
    const char* cA = cur.A; const char* cB = cur.B;
    PG8_STAGE(PG8_SB(0, 0), cB, voffB); PG8_STAGE(PG8_SA(0, 0), cA, voffA); PG8_STAGE(PG8_SB(0, 1), cB + hstep, voffB); PG8_STAGE(PG8_SA(0, 1), cA + hstep, voffA);
    if (wr == 1) PG8_BAR;
    PG8_WAIT_V(4); PG8_BAR;
    PG8_STAGE(PG8_SB(1, 0), cB + kstep, voffB); PG8_STAGE(PG8_SA(1, 0), cA + kstep, voffA); PG8_STAGE(PG8_SB(1, 1), cB + hstep + kstep, voffB);
    PG8_WAIT_V(6); PG8_BAR;
    for (;;) {
        const bool has_next = S.next(ui + 1, nxt);
        const char* nA = has_next ? nxt.A : cA; const char* nB = has_next ? nxt.B : cB;
        for (int t = 0; t < nt; t += 2) {
            const bool last = (t == nt - 2);
            if constexpr (Epi::MID) { if (t == (nt >> 1)) E.mid(acc, cur, wr, wc, fr, fq); }
            const char* a1 = cA + (size_t)(t + 1) * kstep;
            const char* a2 = last ? nA : cA + (size_t)(t + 2) * kstep; const char* b2 = last ? nB : cB + (size_t)(t + 2) * kstep;
            const char* a3 = a2 + kstep; const char* b3 = b2 + kstep;
            PG8_LDB(B0, 0, 0); PG8_SCHED; PG8_LDA(At, 0, 0); PG8_STAGE(PG8_SA(1, 1), a1 + hstep, voffA);
            PG8_WAIT_L(8); PG8_BAR; PG8_WAIT_L(0); PG8_MMA(0, 0, At, B0); PG8_BAR; PG8_SCHED;
            PG8_LDB(B1, 0, 1); PG8_STAGE(PG8_SB(0, 0), b2, voffB);
            PG8_BAR; PG8_WAIT_L(0); PG8_MMA(0, 1, At, B1); PG8_BAR;
            PG8_LDA(At, 0, 1); PG8_STAGE(PG8_SA(0, 0), a2, voffA);
            PG8_BAR; PG8_WAIT_L(0); PG8_MMA(1, 0, At, B0); PG8_BAR; PG8_SCHED;
            PG8_STAGE(PG8_SB(0, 1), b2 + hstep, voffB);
            PG8_WAIT_V(6); PG8_BAR; PG8_MMA(1, 1, At, B1); PG8_BAR;
            PG8_LDB(B0, 1, 0); PG8_SCHED; PG8_LDA(At, 1, 0); PG8_STAGE(PG8_SA(0, 1), a2 + hstep, voffA);
            PG8_WAIT_L(8); PG8_BAR; PG8_WAIT_L(0); PG8_MMA(0, 0, At, B0); PG8_BAR; PG8_SCHED;
            PG8_LDB(B1, 1, 1); PG8_STAGE(PG8_SB(1, 0), b3, voffB);
            PG8_BAR; PG8_WAIT_L(0); PG8_MMA(0, 1, At, B1); PG8_BAR;
            PG8_LDA(At, 1, 1); PG8_STAGE(PG8_SA(1, 0), a3, voffA);
            PG8_BAR; PG8_WAIT_L(0); PG8_MMA(1, 0, At, B0); PG8_BAR; PG8_SCHED;
            PG8_STAGE(PG8_SB(1, 1), b3 + hstep, voffB);
            PG8_WAIT_V(6); PG8_BAR; PG8_MMA(1, 1, At, B1); PG8_BAR;
        }
        E(acc, cur, wr, wc, fr, fq);
        if (!has_next) break;
#pragma unroll
        for (int a = 0; a < 2; ++a)
#pragma unroll
            for (int b = 0; b < 2; ++b)
#pragma unroll
                for (int m = 0; m < 4; ++m)
#pragma unroll
                    for (int n = 0; n < 2; ++n) acc[a][b][m][n] = (f32x4){0.f, 0.f, 0.f, 0.f};
        cur = nxt; cA = nA; cB = nB; ++ui;
    }
    PG8_WAIT_V(0);
    if (wr == 0) PG8_BAR;
    PG8_BAR;
#undef PG8_SA
#undef PG8_SB
#undef PG8_STAGE
#undef PG8_LDA
#undef PG8_LDB
#undef PG8_MMA
#undef PG8_WAIT_V
#undef PG8_WAIT_L
#undef PG8_BAR
#undef PG8_SCHED
}
}
using pg8::Unit;
typedef f32x4 Acc[2][2][4][2];

__device__ __forceinline__ void store_tile_bf16(const Acc& acc, const Unit& u, int wr, int wc, int fr, int fq) {
    bf16_t* base = (bf16_t*)u.out + (size_t)(wr * 64 + fr) * u.ldc + wc * 32 + 8 * fq;
#pragma unroll
    for (int ai = 0; ai < 2; ++ai)
#pragma unroll
        for (int m = 0; m < 4; ++m) {
            bf16_t* rowp = base + (size_t)(ai * 128 + m * 16) * u.ldc;
#pragma unroll
            for (int bj = 0; bj < 2; ++bj) {
                const f32x4 v0 = acc[ai][bj][m][0], v1 = acc[ai][bj][m][1];
                u32x4 w; w.x = cvt_pk_bf16(v0[0], v0[1]); w.y = cvt_pk_bf16(v0[2], v0[3]); w.z = cvt_pk_bf16(v1[0], v1[1]); w.w = cvt_pk_bf16(v1[2], v1[3]);
                *(u32x4*)(rowp + bj * 128) = w;
            }
        }
}

struct SchedProj1 {
    const char* h; const char* w; unsigned char* ws; int G, c;
    __device__ bool next(int i, Unit& u) const {
        const int L = i * G + c; int pm, pn;
        if (L < 64 * 29) pg8::rect_map(L, 64, 29, pm, pn);
        else { const int e = L - 64 * 29; if (e >= 34) return false; pm = 64 + e / 17; const int q = e % 17; pn = q < 4 ? 8 + q : (q < 16 ? 12 + q : 28); }
        const char* ha = h + (size_t)pm * 256 * DM * 2; const char* wa = w + (size_t)pn * 256 * DM * 2;
        u.A = ha; u.B = wa; u.kind = 0; u.row0 = pm * 256; u.col0 = pn * 256;
        if (pn < 8) { u.out = (char*)(ws + O_QA) + ((size_t)pm * 256 * 2048 + pn * 256) * 2; u.ldc = 2048; }
        else if (pn < 10) { u.out = (char*)(ws + O_KA) + ((size_t)pm * 256 * 512 + (pn - 8) * 256) * 2; u.ldc = 512; }
        else if (pn < 12) { u.A = wa; u.B = ha; u.out = (char*)(ws + O_VAT) + ((size_t)(pn - 10) * 256 * NROW + pm * 256) * 2; u.ldc = NROW; }
        else if (pn < 16) { u.out = (char*)(ws + O_QB) + ((size_t)pm * 256 * 1024 + (pn - 12) * 256) * 2; u.ldc = 1024; }
        else if (pn < 20) { u.out = (char*)(ws + O_KB) + ((size_t)pm * 256 * 1024 + (pn - 16) * 256) * 2; u.ldc = 1024; }
        else if (pn < 28) { u.A = wa; u.B = ha; u.out = (char*)(ws + O_VBT) + ((size_t)(pn - 20) * 256 * NROW + pm * 256) * 2; u.ldc = NROW; }
        else { u.kind = 1; u.out = (char*)(ws + O_LR) + (size_t)pm * 256 * 32 * 4; u.ldc = 32; }
        return true;
    }
};
struct EpiProj1 {
    static constexpr bool MID = false;
    __device__ __forceinline__ void mid(Acc&, const Unit&, int, int, int, int) const {}
    __device__ __forceinline__ void operator()(const Acc& acc, const Unit& u, int wr, int wc, int fr, int fq) const {
        if (u.kind == 0) { store_tile_bf16(acc, u, wr, wc, fr, fq); return; }
        if (wc == 0) {
            float* base = (float*)u.out + (size_t)(wr * 64 + fr) * 32 + 8 * fq;
#pragma unroll
            for (int ai = 0; ai < 2; ++ai)
#pragma unroll
                for (int m = 0; m < 4; ++m) { float* rowp = base + (size_t)(ai * 128 + m * 16) * 32; *(f32x4*)rowp = acc[ai][0][m][0]; *(f32x4*)(rowp + 4) = acc[ai][0][m][1]; }
        }
    }
};
struct SchedProj2 {
    const char* h; const char* w; unsigned char* ws; bf16_t* cc; int G, c;
    __device__ bool next(int i, Unit& u) const {
        const int L = i * G + c; if (L >= 64 * 24) return false; int pm, pn; pg8::rect_map(L, 64, 24, pm, pn);
        u.A = h + (size_t)pm * 256 * DM * 2; u.B = w + (size_t)pn * 256 * DM * 2; u.row0 = pm * 256; u.col0 = pn * 256;
        if (pn < 8) { u.kind = 2; u.out = (char*)(cc + (size_t)pm * 256 * 4096 + 2048 + pn * 256); u.ldc = 4096; }
        else if (pn < 16) { u.kind = 0; u.out = (char*)(ws + O_GA) + ((size_t)pm * 256 * 2048 + (pn - 8) * 256) * 2; u.ldc = 2048; }
        else { u.kind = 0; u.out = (char*)(ws + O_GA + 67108864) + ((size_t)pm * 256 * 2048 + (pn - 16) * 256) * 2; u.ldc = 2048; }
        return true;
    }
};
struct EpiProj2 {
    static constexpr bool MID = false;
    __device__ __forceinline__ void mid(Acc&, const Unit&, int, int, int, int) const {}
    __device__ __forceinline__ void operator()(const Acc& acc, const Unit& u, int wr, int wc, int fr, int fq) const {
        if (u.kind == 0) { store_tile_bf16(acc, u, wr, wc, fr, fq); return; }
        bf16_t* base = (bf16_t*)u.out + (size_t)(wr * 64 + fr) * u.ldc + wc * 32 + 8 * fq;
#pragma unroll
        for (int ai = 0; ai < 2; ++ai)
#pragma unroll
            for (int m = 0; m < 4; ++m) {
                bf16_t* rowp = base + (size_t)(ai * 128 + m * 16) * u.ldc;
#pragma unroll
                for (int bj = 0; bj < 2; ++bj) {
                    const f32x4 v0 = acc[ai][bj][m][0], v1 = acc[ai][bj][m][1];
                    float y[8]; unpack8(*(const u32x4*)(rowp + bj * 128), y);
                    y[0] *= siluf_(v0[0]); y[1] *= siluf_(v0[1]); y[2] *= siluf_(v0[2]); y[3] *= siluf_(v0[3]);
                    y[4] *= siluf_(v1[0]); y[5] *= siluf_(v1[1]); y[6] *= siluf_(v1[2]); y[7] *= siluf_(v1[3]);
                    *(u32x4*)(rowp + bj * 128) = pack8(y);
                }
            }
    }
};
struct SchedMerge {
    const char* a; const char* w; unsigned char* ws; int G, c;
    __device__ bool next(int i, Unit& u) const {
        const int L = i * G + c; if (L >= 64 * 8) return false; int pm, pn; pg8::rect_map(L, 64, 8, pm, pn);
        u.A = a + (size_t)pm * 256 * 4096 * 2; u.B = w + (size_t)pn * 256 * 4096 * 2; u.row0 = pm * 256; u.col0 = pn * 256; u.kind = 0;
        u.out = (char*)(ws + O_M) + ((size_t)pm * 256 * 2048 + pn * 256) * 2; u.ldc = 2048; return true;
    }
};
struct EpiMerge {
    static constexpr bool MID = true;
    const bf16_t* ga; const bf16_t* gb;
    __device__ __forceinline__ void mid(Acc& acc, const Unit& u, int wr, int wc, int fr, int fq) const {
        const unsigned lo = (unsigned)(((wr * 64 + fr) * 2048 + wc * 32 + 8 * fq) * 2 + opaque0());
#pragma unroll
        for (int g4 = 0; g4 < 4; ++g4) {
            u32x4 ra[4], rb[4];
#pragma unroll
            for (int c = 0; c < 4; ++c) { const int cb = g4 * 4 + c, ai = cb >> 3, m = (cb >> 1) & 3, bj = cb & 1;
                const size_t ub = ((size_t)(u.row0 + ai * 128 + m * 16) * 2048 + u.col0 + bj * 128) * 2;
                ra[c] = *(const u32x4*)((const char*)ga + ub + lo); rb[c] = *(const u32x4*)((const char*)gb + ub + lo); }
#pragma unroll
            for (int c = 0; c < 4; ++c) { const int cb = g4 * 4 + c, ai = cb >> 3, m = (cb >> 1) & 3, bj = cb & 1;
                float a[8], b[8]; unpack8(ra[c], a); unpack8(rb[c], b);
#pragma unroll
                for (int e = 0; e < 8; ++e) { const float r = (1.0f + __expf(-b[e])) * __builtin_amdgcn_rcpf(1.0f + __expf(-a[e])); acc[ai][bj][m][e >> 2][e & 3] *= r; } }
            __builtin_amdgcn_sched_barrier(0);
        }
    }
    __device__ __forceinline__ void operator()(const Acc& acc, const Unit& u, int wr, int wc, int fr, int fq) const {
        const unsigned lo = (unsigned)(((wr * 64 + fr) * 2048 + wc * 32 + 8 * fq) * 2 + opaque0());
        char* outp = (char*)u.out - ((size_t)u.row0 * 2048 + u.col0) * 2;
#pragma unroll
        for (int g4 = 0; g4 < 4; ++g4) {
            u32x4 rb[4];
#pragma unroll
            for (int c = 0; c < 4; ++c) { const int cb = g4 * 4 + c, ai = cb >> 3, m = (cb >> 1) & 3, bj = cb & 1;
                const size_t ub = ((size_t)(u.row0 + ai * 128 + m * 16) * 2048 + u.col0 + bj * 128) * 2;
                rb[c] = *(const u32x4*)((const char*)gb + ub + lo); }
#pragma unroll
            for (int c = 0; c < 4; ++c) { const int cb = g4 * 4 + c, ai = cb >> 3, m = (cb >> 1) & 3, bj = cb & 1;
                const size_t ub = ((size_t)(u.row0 + ai * 128 + m * 16) * 2048 + u.col0 + bj * 128) * 2;
                float b[8], y[8]; unpack8(rb[c], b);
#pragma unroll
                for (int e = 0; e < 8; ++e) y[e] = acc[ai][bj][m][e >> 2][e & 3] * sigmoidf_(b[e]);
                *(u32x4*)(outp + ub + lo) = pack8(y); }
            __builtin_amdgcn_sched_barrier(0);
        }
    }
};
struct SchedRes {
    const char* a; const char* w; int K, G, c;
    __device__ bool next(int i, Unit& u) const {
        const int L = i * G + c; if (L >= 64 * 8) return false; int pm, pn; pg8::rect_map(L, 64, 8, pm, pn);
        u.A = a + (size_t)pm * 256 * K * 2; u.B = w + (size_t)pn * 256 * K * 2; u.row0 = pm * 256; u.col0 = pn * 256; u.kind = 0; u.out = nullptr; u.ldc = 2048; return true;
    }
};
struct EpiRes {
    static constexpr bool MID = false;
    const float* base; float* out; const float* gate;
    __device__ __forceinline__ void mid(Acc&, const Unit&, int, int, int, int) const {}
    __device__ __forceinline__ void operator()(const Acc& acc, const Unit& u, int wr, int wc, int fr, int fq) const {
        const int col = u.col0 + wc * 32 + 8 * fq;
        const float* gp = gate + (size_t)(u.row0 >> 13) * 12288 + col;
        f32x4 g[2][2];
#pragma unroll
        for (int bj = 0; bj < 2; ++bj) { g[bj][0] = *(const f32x4*)(gp + bj * 128); g[bj][1] = *(const f32x4*)(gp + bj * 128 + 4); }
        const size_t o0 = (size_t)(u.row0 + wr * 64 + fr) * 2048 + col;
#pragma unroll
        for (int ai = 0; ai < 2; ++ai)
#pragma unroll
            for (int m = 0; m < 4; ++m)
#pragma unroll
                for (int bj = 0; bj < 2; ++bj) {
                    const size_t o = o0 + (size_t)(ai * 128 + m * 16) * 2048 + bj * 128;
                    const f32x4 x0 = *(const f32x4*)(base + o), x1 = *(const f32x4*)(base + o + 4);
                    *(f32x4*)(out + o) = x0 + g[bj][0] * acc[ai][bj][m][0];
                    *(f32x4*)(out + o + 4) = x1 + g[bj][1] * acc[ai][bj][m][1];
                }
    }
};

struct EpiDelta {
    static constexpr bool MID = false;
    bf16_t* d1; const float* gate;
    __device__ __forceinline__ void mid(Acc&, const Unit&, int, int, int, int) const {}
    __device__ __forceinline__ void operator()(const Acc& acc, const Unit& u, int wr, int wc, int fr, int fq) const {
        const int col = u.col0 + wc * 32 + 8 * fq;
        const float* gp = gate + (size_t)(u.row0 >> 13) * 12288 + col;
        f32x4 g[2][2];
#pragma unroll
        for (int bj = 0; bj < 2; ++bj) { g[bj][0] = *(const f32x4*)(gp + bj * 128); g[bj][1] = *(const f32x4*)(gp + bj * 128 + 4); }
        bf16_t* base = d1 + (size_t)(u.row0 + wr * 64 + fr) * 2048 + col;
#pragma unroll
        for (int ai = 0; ai < 2; ++ai)
#pragma unroll
            for (int m = 0; m < 4; ++m) {
                bf16_t* rowp = base + (size_t)(ai * 128 + m * 16) * 2048;
#pragma unroll
                for (int bj = 0; bj < 2; ++bj) {
                    const f32x4 v0 = g[bj][0] * acc[ai][bj][m][0], v1 = g[bj][1] * acc[ai][bj][m][1];
                    u32x4 w; w.x = cvt_pk_bf16(v0[0], v0[1]); w.y = cvt_pk_bf16(v0[2], v0[3]); w.z = cvt_pk_bf16(v1[0], v1[1]); w.w = cvt_pk_bf16(v1[2], v1[3]);
                    *(u32x4*)(rowp + bj * 128) = w;
                }
            }
    }
};
struct EpiRes2 {
    static constexpr bool MID = false;
    const float* x; const bf16_t* d1; float* out; const float* gate;
    __device__ __forceinline__ void mid(Acc&, const Unit&, int, int, int, int) const {}
    __device__ __forceinline__ void operator()(const Acc& acc, const Unit& u, int wr, int wc, int fr, int fq) const {
        const int col = u.col0 + wc * 32 + 8 * fq;
        const float* gp = gate + (size_t)(u.row0 >> 13) * 12288 + col;
        f32x4 g[2][2];
#pragma unroll
        for (int bj = 0; bj < 2; ++bj) { g[bj][0] = *(const f32x4*)(gp + bj * 128); g[bj][1] = *(const f32x4*)(gp + bj * 128 + 4); }
        const size_t o0 = (size_t)(u.row0 + wr * 64 + fr) * 2048 + col;
#pragma unroll
        for (int ai = 0; ai < 2; ++ai)
#pragma unroll
            for (int m = 0; m < 4; ++m)
#pragma unroll
                for (int bj = 0; bj < 2; ++bj) {
                    const size_t o = o0 + (size_t)(ai * 128 + m * 16) * 2048 + bj * 128;
                    const f32x4 x0 = *(const f32x4*)(x + o), x1 = *(const f32x4*)(x + o + 4);
                    float d[8]; unpack8(*(const u32x4*)(d1 + o), d);
                    *(f32x4*)(out + o) = x0 + (f32x4){d[0], d[1], d[2], d[3]} + g[bj][0] * acc[ai][bj][m][0];
                    *(f32x4*)(out + o + 4) = x1 + (f32x4){d[4], d[5], d[6], d[7]} + g[bj][1] * acc[ai][bj][m][1];
                }
    }
};
struct SchedUp {
    const char* a; const char* w; char* uo; int j0, ns, ldu, G, c;
    __device__ bool next(int i, Unit& u) const {
        const int L = i * G + c; if (L >= 64 * ns) return false; int pm, pn; pg8::rect_map(L, 64, ns, pm, pn);
        u.A = a + (size_t)pm * 256 * DM * 2; u.B = w + (size_t)(j0 + pn) * 256 * DM * 2; u.row0 = pm * 256; u.col0 = pn * 256; u.kind = 0;
        u.out = uo + ((size_t)pm * 256 * ldu + pn * 256) * 2; u.ldc = ldu; return true;
    }
};
struct EpiStore {
    static constexpr bool MID = false;
    __device__ __forceinline__ void mid(Acc&, const Unit&, int, int, int, int) const {}
    __device__ __forceinline__ void operator()(const Acc& acc, const Unit& u, int wr, int wc, int fr, int fq) const { store_tile_bf16(acc, u, wr, wc, fr, fq); }
};


__device__ __forceinline__ float dpp_ror1(float v) { return __builtin_bit_cast(float, __builtin_amdgcn_update_dpp(0, __builtin_bit_cast(int, v), 0x121, 0xF, 0xF, false)); }
__device__ __forceinline__ float dpp_rol1(float v) { return __builtin_bit_cast(float, __builtin_amdgcn_update_dpp(0, __builtin_bit_cast(int, v), 0x12F, 0xF, 0xF, false)); }
struct SchedUpC {
    const char* a; const char* w; int G, c;
    __device__ bool next(int i, Unit& u) const {
        const int L = i * G + c; if (L >= 64 * 44) return false; int pm, pn; pg8::rect_map(L, 64, 44, pm, pn);
        u.A = a + (size_t)pm * 256 * DM * 2; u.B = w + (size_t)pn * 256 * DM * 2; u.row0 = pm * 256; u.col0 = pn * 256; u.kind = 0; u.out = nullptr; u.ldc = 0; return true;
    }
};
struct EpiUpConv {
    static constexpr bool MID = false;
    const float* cw; const float* cb; bf16_t* act; float* halo; LAS unsigned char* lds;
    __device__ __forceinline__ void mid(Acc&, const Unit&, int, int, int, int) const {}
    __device__ __forceinline__ void operator()(const Acc& acc, const Unit& u, int wr, int wc, int fr, int fq) const {
        LAS float* X = (LAS float*)(lds + 131072);
        const int c8 = wc * 32 + 8 * fq, pm = u.row0 >> 8, ch = (u.col0 >> 1) + c8;
        if (fr == 0) {
#pragma unroll
            for (int ai = 0; ai < 2; ++ai)
#pragma unroll
                for (int bj = 0; bj < 2; ++bj)
#pragma unroll
                    for (int n = 0; n < 2; ++n) *(LAS f32x4*)(X + ((((ai * 2 + wr) * 2 + 0) * 2 + bj) * 128 + c8 + 4 * n)) = acc[ai][bj][0][n];
        }
        if (fr == 15) {
#pragma unroll
            for (int ai = 0; ai < 2; ++ai)
#pragma unroll
                for (int bj = 0; bj < 2; ++bj)
#pragma unroll
                    for (int n = 0; n < 2; ++n) *(LAS f32x4*)(X + ((((ai * 2 + wr) * 2 + 1) * 2 + bj) * 128 + c8 + 4 * n)) = acc[ai][bj][3][n];
        }
        asm volatile("s_waitcnt lgkmcnt(0)" ::: "memory"); __builtin_amdgcn_s_barrier(); asm volatile("" ::: "memory"); __builtin_amdgcn_s_barrier(); asm volatile("" ::: "memory");
#pragma unroll
        for (int n = 0; n < 2; ++n) {
            const int chn = ch + 4 * n;
            f32x4 w[3][2], bb[2];
#pragma unroll
            for (int j = 0; j < 3; ++j)
#pragma unroll
                for (int bj = 0; bj < 2; ++bj) w[j][bj] = *(const f32x4*)(cw + j * 11264 + bj * 5632 + chn);
#pragma unroll
            for (int bj = 0; bj < 2; ++bj) bb[bj] = *(const f32x4*)(cb + bj * 5632 + chn);
#pragma unroll
            for (int ai = 0; ai < 2; ++ai) {
                const int g = ai * 2 + wr, gp = g > 0 ? g - 1 : 0, gn = g < 3 ? g + 1 : 3;
                f32x4 upb[2], dnb[2];
#pragma unroll
                for (int bj = 0; bj < 2; ++bj) { upb[bj] = *(const LAS f32x4*)(X + (((gp * 2 + 1) * 2 + bj) * 128 + c8 + 4 * n)); dnb[bj] = *(const LAS f32x4*)(X + (((gn * 2 + 0) * 2 + bj) * 128 + c8 + 4 * n)); }
#pragma unroll
                for (int m = 0; m < 4; ++m) {
                    const int r = 128 * ai + 64 * wr + 16 * m + fr;
                    const bool first = r == 0, last = r == 255;
                    f32x4 pre[2];
#pragma unroll
                    for (int bj = 0; bj < 2; ++bj)
#pragma unroll
                        for (int j = 0; j < 4; ++j) {
                            const float cur = acc[ai][bj][m][n][j];
                            const float ur = dpp_ror1(cur), dr = dpp_rol1(cur);
                            const float ue = m > 0 ? dpp_ror1(acc[ai][bj][m > 0 ? m - 1 : 0][n][j]) : upb[bj][j];
                            const float de = m < 3 ? dpp_rol1(acc[ai][bj][m < 3 ? m + 1 : 3][n][j]) : dnb[bj][j];
                            float up = fr == 0 ? ue : ur, dn = fr == 15 ? de : dr;
                            if (first) up = 0.f; if (last) dn = 0.f;
                            pre[bj][j] = w[0][bj][j] * up + w[1][bj][j] * cur + w[2][bj][j] * dn + bb[bj][j];
                        }
                    if (first || last) {
                        float* hp = halo + ((size_t)(pm * 4 + (last ? 1 : 0)) * 2) * 5632 + chn;
#pragma unroll
                        for (int bj = 0; bj < 2; ++bj) { *(f32x4*)(hp + bj * 5632) = acc[ai][bj][m][n]; *(f32x4*)(hp + (size_t)4 * 5632 + bj * 5632) = pre[bj]; }
                    } else {
                        u32x2 pk; pk.x = cvt_pk_bf16(siluf_(pre[0][0]) * pre[1][0], siluf_(pre[0][1]) * pre[1][1]); pk.y = cvt_pk_bf16(siluf_(pre[0][2]) * pre[1][2], siluf_(pre[0][3]) * pre[1][3]);
                        *(u32x2*)(act + (size_t)(u.row0 + r) * 5632 + chn) = pk;
                    }
                    __builtin_amdgcn_sched_barrier(0);
                }
            }
        }
    }
};
__device__ void phase_convfix(const P& p, const float* halo, bf16_t* act) {
    for (int i = blockIdx.x * 512 + threadIdx.x + opaque0(); i < 64 * 2 * 5632; i += gridDim.x * 512) {
        const int ch = i % 5632, pe = i / 5632, e = pe & 1, pm = pe >> 1;
        float pa = halo[((size_t)(pm * 4 + 2 + e) * 2 + 0) * 5632 + ch], pg = halo[((size_t)(pm * 4 + 2 + e) * 2 + 1) * 5632 + ch];
        if (e == 0 && (pm & 31) > 0) { pa += p.conv_w[ch] * halo[((size_t)((pm - 1) * 4 + 1) * 2 + 0) * 5632 + ch]; pg += p.conv_w[5632 + ch] * halo[((size_t)((pm - 1) * 4 + 1) * 2 + 1) * 5632 + ch]; }
        if (e == 1 && (pm & 31) < 31) { pa += p.conv_w[2 * 11264 + ch] * halo[((size_t)((pm + 1) * 4 + 0) * 2 + 0) * 5632 + ch]; pg += p.conv_w[2 * 11264 + 5632 + ch] * halo[((size_t)((pm + 1) * 4 + 0) * 2 + 1) * 5632 + ch]; }
        act[(size_t)(pm * 256 + (e ? 255 : 0)) * 5632 + ch] = f2bf(siluf_(pa) * pg);
    }
}

__device__ __forceinline__ int srccol(int kind, int n) {
    if (kind == 0) return n;
    if (kind == 1) return n < 7168 ? n : (n < 7200 ? n + 2048 : -1);
    if (kind == 2) return n < 2048 ? 7168 + n : 9248 + (n - 2048);
    const int j = n >> 8, i = n & 255; return i < 128 ? 128 * j + i : 5632 + 128 * j + (i - 128);
}
struct TJob { const float* src; int ld_src; bf16_t* dst; int ld_dst; int k0; int n0; int kind; int koff; };
__device__ __forceinline__ void tj_load(const TJob& j, int tid, f32x4 (&v)[8]) {
    const int kr = tid >> 6, nq = (tid & 63) * 4; const int sc = srccol(j.kind, j.n0 + nq);
#pragma unroll
    for (int pass = 0; pass < 8; ++pass) { v[pass] = (f32x4){0.f, 0.f, 0.f, 0.f}; if (sc >= 0) v[pass] = *(const f32x4*)(j.src + (size_t)(j.k0 + kr + 8 * pass) * j.ld_src + sc); }
}
__device__ __forceinline__ void tj_store(LAS float* tl, const TJob& j, int tid, const f32x4 (&v)[8]) {
    { const int kr = tid >> 6, nq = (tid & 63) * 4;
#pragma unroll
      for (int pass = 0; pass < 8; ++pass) { const int k = kr + 8 * pass;
          tl[(nq + 0) * 65 + k] = v[pass][0]; tl[(nq + 1) * 65 + k] = v[pass][1]; tl[(nq + 2) * 65 + k] = v[pass][2]; tl[(nq + 3) * 65 + k] = v[pass][3]; } }
}
__device__ __forceinline__ void tj_flush(LAS float* tl, const TJob& j, int tid) {
    const int nr = tid >> 3, kc = (tid & 7) * 8;
#pragma unroll
    for (int pass = 0; pass < 4; ++pass) { const int n = nr + 64 * pass; float f[8];
#pragma unroll
        for (int e = 0; e < 8; ++e) f[e] = tl[n * 65 + kc + e];
        *(u32x4*)(j.dst + (size_t)(j.n0 + n) * j.ld_dst + j.koff + j.k0 + kc) = pack8(f); }
}
__device__ __forceinline__ TJob tj_make(const float* src, int ld_src, bf16_t* dst, int ld_dst, int N, int kind, int koff, int it) {
    const int nnt = N / 256; TJob j; j.src = src; j.ld_src = ld_src; j.dst = dst; j.ld_dst = ld_dst; j.k0 = (it / nnt) * 64; j.n0 = (it % nnt) * 256; j.kind = kind; j.koff = koff; return j;
}
__device__ void phase0(LAS unsigned char* lds, const P& p) {
    LAS float* tl = (LAS float*)lds;
    unsigned char* ws = p.ws;
    const int nb = gridDim.x, bid = blockIdx.x, tid = threadIdx.x + opaque0();
    for (int it = bid; it < 256; it += nb) {
        const int kc = it >> 3, nch = it & 7; float a[3][3];
#pragma unroll
        for (int v = 0; v < 3; ++v)
#pragma unroll
            for (int j = 0; j < 3; ++j) a[v][j] = 0.f;
#pragma unroll 16
        for (int k = kc * 64; k < kc * 64 + 64; ++k) {
            const float s0 = siluf_(p.c[k]), s1 = siluf_(p.c[2048 + k]), s2 = siluf_(p.c_ctx[k]);
            const float* wr = p.w_mod + (size_t)k * 12288 + nch * 1536 + tid;
#pragma unroll
            for (int j = 0; j < 3; ++j) { const float w = wr[j * 512]; a[0][j] += s0 * w; a[1][j] += s1 * w; a[2][j] += s2 * w; }
        }
        float* mp = (float*)(ws + O_MODP) + (size_t)kc * 3 * 12288 + nch * 1536 + tid;
#pragma unroll
        for (int v = 0; v < 3; ++v)
#pragma unroll
            for (int j = 0; j < 3; ++j) mp[(size_t)v * 12288 + j * 512] = a[v][j];
    }
    for (int i = bid * 512 + tid; i < 128 * 32; i += nb * 512) {
        const int pos = i >> 5, f = i & 31;
        const float inv = exp2f(-(float)f * (13.287712379549449f / 32.0f));
        const float ang = (float)pos * inv;
        const double ad = (double)ang; const double n = rint(ad * 0.15915494309189535); double r = ad - n * 6.283185307179586476925;
        r *= 0.125; const double r2 = r * r;
        double s = r * (1.0 + r2 * (-1.0 / 6 + r2 * (1.0 / 120 + r2 * (-1.0 / 5040 + r2 * (1.0 / 362880 + r2 * (-1.0 / 39916800))))));
        double c = 1.0 + r2 * (-0.5 + r2 * (1.0 / 24 + r2 * (-1.0 / 720 + r2 * (1.0 / 40320 + r2 * (-1.0 / 3628800 + r2 * (1.0 / 479001600))))));
#pragma unroll
        for (int q = 0; q < 3; ++q) { const double s2 = 2.0 * s * c, c2 = c * c - s * s; s = s2; c = c2; }
        ((f32x2*)(ws + O_ROPE))[i] = (f32x2){(float)c, (float)s};
    }
    const int J0 = 32 * 29, J1 = 32 * 24, J2 = 256, J3 = 256, J4 = 256;
    auto job0 = [&](int it) -> TJob {
        int q = it;
        if (q < J0) return tj_make(p.w_in, 13344, (bf16_t*)(ws + O_XR), 2048, 7424, 1, 0, q); q -= J0;
        if (q < J1) return tj_make(p.w_in, 13344, (bf16_t*)(ws + O_W2IN), 2048, 6144, 2, 0, q); q -= J1;
        if (q < J2) return tj_make(p.w_attn_o, 2048, (bf16_t*)(ws + O_WMRG), 4096, 2048, 0, 0, q); q -= J2;
        if (q < J3) return tj_make(p.w_gla_o, 2048, (bf16_t*)(ws + O_WMRG), 4096, 2048, 0, 2048, q); q -= J3;
        return tj_make(p.w_out, 2048, (bf16_t*)(ws + O_WOUT), 2048, 2048, 0, 0, q);
    };
    { const int JT = J0 + J1 + J2 + J3 + J4; int it = bid; f32x4 v[8]; TJob cur;
      if (it < JT) { cur = job0(it); tj_load(cur, tid, v); }
      while (it < JT) {
          LDS_BARRIER(); tj_store(tl, cur, tid, v);
          const int itn = it + nb; TJob nxt = cur; if (itn < JT) { nxt = job0(itn); tj_load(nxt, tid, v); }
          LDS_BARRIER(); tj_flush(tl, cur, tid);
          cur = nxt; it = itn; } }
}
__device__ void phase_modreduce(const P& p) {
    const float* mp = (const float*)(p.ws + O_MODP); float* mod = (float*)(p.ws + O_MOD);
    for (int i = blockIdx.x * 512 + threadIdx.x; i < 3 * 12288; i += gridDim.x * 512) {
        float s = p.b_mod[i % 12288];
#pragma unroll
        for (int kc = 0; kc < 32; ++kc) s += mp[(size_t)kc * 3 * 12288 + i];
        mod[i] = s;
    }
}
__device__ void phase_modulate(const float* xlat, const float* xctx, const float* g, const float* mod, int sh, int sc, bf16_t* h, int nrows) {
    const int tix = threadIdx.x + opaque0(); const int lane = tix & 63, gw = blockIdx.x * 8 + (tix >> 6), nw = gridDim.x * 8;
    for (int r = gw; r < nrows; r += nw) {
        const float* xr = r < NTOK ? xlat + (size_t)r * DM : xctx + (size_t)(r - NTOK) * DM;
        const float* mv = mod + (size_t)(r < NTOK ? (r >> 13) : 2) * 12288;
        f32x4 v[8]; float ss = 0.f;
#pragma unroll
        for (int i = 0; i < 8; ++i) { v[i] = *(const f32x4*)(xr + (i * 64 + lane) * 4); ss += v[i][0] * v[i][0] + v[i][1] * v[i][1] + v[i][2] * v[i][2] + v[i][3] * v[i][3]; }
        ss = wave_sum(ss); const float rs = rsqrtf(ss * (1.0f / DM) + EPS_);
#pragma unroll
        for (int i = 0; i < 8; ++i) { const int cidx = (i * 64 + lane) * 4;
            const f32x4 gg = *(const f32x4*)(g + cidx), s1 = *(const f32x4*)(mv + sc * 2048 + cidx), s0 = *(const f32x4*)(mv + sh * 2048 + cidx);
            const f32x4 y = v[i] * rs * gg * (s1 + 1.0f) + s0;
            u32x2 w; w.x = cvt_pk_bf16(y[0], y[1]); w.y = cvt_pk_bf16(y[2], y[3]); *(u32x2*)(h + (size_t)r * DM + cidx) = w; }
    }
}


__device__ void phase_modulate2(const float* x, const bf16_t* d1, const float* g, const float* mod, int sh, int sc, bf16_t* h) {
    const int tix = threadIdx.x + opaque0(); const int lane = tix & 63, gw = blockIdx.x * 8 + (tix >> 6), nw = gridDim.x * 8;
    for (int r = gw; r < NTOK; r += nw) {
        const float* xr = x + (size_t)r * DM; const bf16_t* dr = d1 + (size_t)r * DM;
        const float* mv = mod + (size_t)(r >> 13) * 12288;
        f32x4 v[8]; float ss = 0.f;
#pragma unroll
        for (int i = 0; i < 8; ++i) { const int cidx = (i * 64 + lane) * 4; v[i] = *(const f32x4*)(xr + cidx); const u32x2 dd = *(const u32x2*)(dr + cidx);
            v[i][0] += bflo(dd.x); v[i][1] += bfhi(dd.x); v[i][2] += bflo(dd.y); v[i][3] += bfhi(dd.y);
            ss += v[i][0] * v[i][0] + v[i][1] * v[i][1] + v[i][2] * v[i][2] + v[i][3] * v[i][3]; }
        ss = wave_sum(ss); const float rs = rsqrtf(ss * (1.0f / DM) + EPS_);
#pragma unroll
        for (int i = 0; i < 8; ++i) { const int cidx = (i * 64 + lane) * 4;
            const f32x4 gg = *(const f32x4*)(g + cidx), s1 = *(const f32x4*)(mv + sc * 2048 + cidx), s0 = *(const f32x4*)(mv + sh * 2048 + cidx);
            const f32x4 y = v[i] * rs * gg * (s1 + 1.0f) + s0;
            u32x2 w; w.x = cvt_pk_bf16(y[0], y[1]); w.y = cvt_pk_bf16(y[2], y[3]); *(u32x2*)(h + (size_t)r * DM + cidx) = w; }
    }
}
__device__ void phase_kprep(const P& p) {
    const int tix = threadIdx.x + opaque0(); const int lane = tix & 63, gw = blockIdx.x * 8 + (tix >> 6), nw = gridDim.x * 8;
    bf16_t* KA = (bf16_t*)(p.ws + O_KA); const f32x2* tab = (const f32x2*)(p.ws + O_ROPE);
    const float w0 = p.k_norm[lane], w1 = p.k_norm[64 + lane];
    for (int r0 = gw * 2; r0 < NROW; r0 += nw * 2) {
        float x1[8], x2[8];
#pragma unroll
        for (int q = 0; q < 8; ++q) { const bf16_t* kp = KA + (size_t)(r0 + (q >> 2)) * 512 + (q & 3) * 128 + lane; x1[q] = bf2f(kp[0]); x2[q] = bf2f(kp[64]); }
#pragma unroll
        for (int q = 0; q < 8; ++q) {
            const int r = r0 + (q >> 2); bf16_t* kp = KA + (size_t)r * 512 + (q & 3) * 128 + lane;
            const float ss = wave_sum(x1[q] * x1[q] + x2[q] * x2[q]); const float rs = rsqrtf(ss * (1.0f / 128) + EPS_);
            float a1 = x1[q] * rs * w0, a2 = x2[q] * rs * w1;
            if (r < NTOK) { const int t = r & (T_ - 1); const int pos = lane < 32 ? (t >> 6) : (t & 63); const f32x2 cs = tab[pos * 32 + (lane & 31)];
                const float y1 = a1 * cs.x - a2 * cs.y, y2 = a2 * cs.x + a1 * cs.y; a1 = y1; a2 = y2; }
            kp[0] = f2bf(a1); kp[64] = f2bf(a2);
        }
    }
}
__device__ __forceinline__ void normrope8x4(float (&y)[4][8], const float* nw, int dofs, float rs, bool rope, int t, const f32x2* tab) {
#pragma unroll
    for (int s = 0; s < 4; ++s) { const f32x4 w0 = *(const f32x4*)(nw + s * 32 + dofs), w1 = *(const f32x4*)(nw + s * 32 + dofs + 4);
#pragma unroll
        for (int e = 0; e < 4; ++e) { y[s][e] *= rs * w0[e]; y[s][4 + e] *= rs * w1[e]; } }
    if (rope) {
#pragma unroll
        for (int s = 0; s < 2; ++s) { const int pos = s == 0 ? (t >> 6) : (t & 63); const f32x2* tp = tab + pos * 32 + dofs;
#pragma unroll
            for (int e = 0; e < 8; ++e) { const f32x2 cs = tp[e]; const float x1 = y[s][e], x2 = y[s + 2][e]; y[s][e] = x1 * cs.x - x2 * cs.y; y[s + 2][e] = x2 * cs.x + x1 * cs.y; } }
    }
}
__device__ void attn_item(LAS unsigned char* lds, const P& p, bf16_t* cc, int item) {
    const int tid = threadIdx.x + opaque0(), w = __builtin_amdgcn_readfirstlane(tid >> 6), lane = tid & 63, fr = lane & 15, fq = lane >> 4;
    const int pair = item & 1, kvh = (item >> 1) & 3, qb = (item >> 3) & 63, b = item >> 9;
    LAS bf16_t* KV0 = (LAS bf16_t*)lds;
    const bf16_t* QA = (const bf16_t*)(p.ws + O_QA); const bf16_t* KA = (const bf16_t*)(p.ws + O_KA); const bf16_t* VAT = (const bf16_t*)(p.ws + O_VAT);
    const f32x2* tab = (const f32x2*)(p.ws + O_ROPE);
    const int hq = kvh * 4 + pair * 2 + (w >> 2), rc = w & 3, qrow0 = qb * 128 + rc * 32;
    const float SC = 0.08838834764831845f * 1.4426950408889634f;
    bf16x8 qf[2][4];
#pragma unroll
    for (int mt = 0; mt < 2; ++mt) {
        const int t = qrow0 + mt * 16 + fr; const bf16_t* src = QA + (size_t)(b * T_ + t) * 2048 + hq * 128 + fq * 8;
        float y[4][8]; float ss = 0.f;
#pragma unroll
        for (int s = 0; s < 4; ++s) { unpack8(*(const u32x4*)(src + s * 32), y[s]);
#pragma unroll
            for (int e = 0; e < 8; ++e) ss += y[s][e] * y[s][e]; }
        ss += __shfl_xor(ss, 16); ss += __shfl_xor(ss, 32);
        const float rs = rsqrtf(ss * (1.0f / 128) + EPS_);
        normrope8x4(y, p.q_norm, fq * 8, rs, true, t, tab);
#pragma unroll
        for (int s = 0; s < 4; ++s) {
#pragma unroll
            for (int e = 0; e < 8; ++e) y[s][e] *= SC;
            const u32x4 pk = pack8(y[s]); qf[mt][s] = *(const bf16x8*)&pk; }
    }
    f32x4 o[2][8];
#pragma unroll
    for (int mt = 0; mt < 2; ++mt)
#pragma unroll
        for (int n = 0; n < 8; ++n) o[mt][n] = (f32x4){0.f, 0.f, 0.f, 0.f};
    float mrun[2], lrun[2];
    { const float sk = p.sink[hq] * 1.4426950408889634f; mrun[0] = sk; mrun[1] = sk; lrun[0] = fq == 0 ? 1.0f : 0.0f; lrun[1] = lrun[0]; }
#define AT_TOKBASE(jj_) ((jj_) < 3 ? b * T_ + (qb - 1 + (jj_)) * 128 : NTOK + b * 256 + ((jj_) - 3) * 128)
#define AT_NEXT(jj_) (((jj_) + 1 == 2 && qb == 63) ? 3 : (jj_) + 1)
#define AT_STAGE(jj_, buf_) do { const int tb_ = AT_TOKBASE(jj_); const int key = tid >> 2, part = tid & 3; \
        LAS bf16_t* kd_ = KV0 + (buf_) * (2 * 128 * 136); LAS bf16_t* vd_ = kd_ + 128 * 136; \
        const bf16_t* src = KA + (size_t)(tb_ + key) * 512 + kvh * 128 + part * 8; const bf16_t* vsrc = VAT + (size_t)(kvh * 128 + key) * NROW + tb_ + part * 8; \
        u32x4 rk_[4], rv_[4]; \
        _Pragma("unroll") for (int s = 0; s < 4; ++s) { rk_[s] = *(const u32x4*)(src + s * 32); rv_[s] = *(const u32x4*)(vsrc + s * 32); } \
        _Pragma("unroll") for (int s = 0; s < 4; ++s) { *(LAS u32x4*)(kd_ + key * 136 + s * 32 + part * 8) = rk_[s]; *(LAS u32x4*)(vd_ + key * 136 + s * 32 + part * 8) = rv_[s]; } } while (0)
    int jn = qb == 0 ? 1 : 0, cur = 0;
    LDS_BARRIER();
    AT_STAGE(jn, 0);
    LDS_BARRIER();
    while (jn < 5) {
        const int jj = jn; jn = AT_NEXT(jj);
        const int mtype = jj == 0 ? 1 : (jj == 2 ? 2 : 0);
        const int mlo = mtype == 1 ? 0 : -100000, mhi = mtype == 2 ? 0 : 100000;
        const int dl = fq * 4 - rc * 32 - fr + opaque0();
        if (jn < 5) AT_STAGE(jn, cur ^ 1);
        LAS bf16_t* Ks = KV0 + cur * (2 * 128 * 136); LAS bf16_t* Vs = Ks + 128 * 136;
        u32x2 pk[2][8];
#pragma unroll
        for (int mt = 0; mt < 2; ++mt) {
            f32x4 sacc[8];
#pragma unroll
            for (int n = 0; n < 8; ++n) sacc[n] = (f32x4){0.f, 0.f, 0.f, 0.f};
#pragma unroll
            for (int s = 0; s < 4; ++s) {
#pragma unroll
                for (int n = 0; n < 8; ++n) { const bf16x8 kf = *(const LAS bf16x8*)(Ks + (n * 16 + fr) * 136 + s * 32 + fq * 8); sacc[n] = MFMA16(kf, qf[mt][s], sacc[n]); }
                __builtin_amdgcn_sched_barrier(0); }
            float mx = -INFINITY;
            if (mtype != 0) {
#pragma unroll
                for (int n = 0; n < 8; ++n)
#pragma unroll
                    for (int j = 0; j < 4; ++j) { const int dkq = dl + (n * 16 + j - mt * 16); if (dkq < mlo || dkq > mhi) sacc[n][j] = -INFINITY; }
            }
#pragma unroll
            for (int n = 0; n < 8; ++n)
#pragma unroll
                for (int j = 0; j < 4; ++j) mx = fmaxf(mx, sacc[n][j]);
            mx = fmaxf(mx, __shfl_xor(mx, 16)); mx = fmaxf(mx, __shfl_xor(mx, 32));
            const float mn = fmaxf(mrun[mt], mx), al = __builtin_amdgcn_exp2f(mrun[mt] - mn); mrun[mt] = mn;
            if (__any(al != 1.0f)) {
#pragma unroll
                for (int n = 0; n < 8; ++n)
#pragma unroll
                    for (int j = 0; j < 4; ++j) o[mt][n][j] *= al;
            }
            float ps = 0.f;
#pragma unroll
            for (int n = 0; n < 8; ++n) { float pv[4];
#pragma unroll
                for (int j = 0; j < 4; ++j) { pv[j] = __builtin_amdgcn_exp2f(sacc[n][j] - mn); ps += pv[j]; }
                pk[mt][n].x = cvt_pk_bf16(pv[0], pv[1]); pk[mt][n].y = cvt_pk_bf16(pv[2], pv[3]); }
            lrun[mt] = lrun[mt] * al + ps;
            __builtin_amdgcn_sched_barrier(0);
        }
#pragma unroll
        for (int s = 0; s < 4; ++s) {
            const u32x4 pq0 = (u32x4){pk[0][2 * s].x, pk[0][2 * s].y, pk[0][2 * s + 1].x, pk[0][2 * s + 1].y}, pq1 = (u32x4){pk[1][2 * s].x, pk[1][2 * s].y, pk[1][2 * s + 1].x, pk[1][2 * s + 1].y};
            const bf16x8 p0 = __builtin_bit_cast(bf16x8, pq0), p1 = __builtin_bit_cast(bf16x8, pq1);
#pragma unroll
            for (int n = 0; n < 8; ++n) {
                const u32x2 v0 = *(const LAS u32x2*)(Vs + (n * 16 + fr) * 136 + s * 32 + fq * 4), v1 = *(const LAS u32x2*)(Vs + (n * 16 + fr) * 136 + s * 32 + 16 + fq * 4);
                const u32x4 vq = (u32x4){v0.x, v0.y, v1.x, v1.y}; const bf16x8 vf = __builtin_bit_cast(bf16x8, vq);
                o[0][n] = MFMA16(vf, p0, o[0][n]); o[1][n] = MFMA16(vf, p1, o[1][n]); }
            __builtin_amdgcn_sched_barrier(0);
        }
        LDS_BARRIER();
        cur ^= 1;
    }
#undef AT_TOKBASE
#undef AT_NEXT
#undef AT_STAGE
#pragma unroll
    for (int mt = 0; mt < 2; ++mt) {
        float l = lrun[mt]; l += __shfl_xor(l, 16); l += __shfl_xor(l, 32);
        const float inv = 1.0f / l; bf16_t* dst = cc + (size_t)(b * T_ + qrow0 + mt * 16 + fr) * 4096 + hq * 128 + fq * 4;
#pragma unroll
        for (int n = 0; n < 8; ++n) { u32x2 pk; pk.x = cvt_pk_bf16(o[mt][n][0] * inv, o[mt][n][1] * inv); pk.y = cvt_pk_bf16(o[mt][n][2] * inv, o[mt][n][3] * inv); *(u32x2*)(dst + n * 16) = pk; }
    }
}

__device__ void glaprep_item(LAS unsigned char* lds, const P& p, int item) {
    const int tid = threadIdx.x + opaque0(), w = __builtin_amdgcn_readfirstlane(tid >> 6), lane = tid & 63, fr = lane & 15, fq = lane >> 4;
    const int ck = item % 66, h = (item / 66) & 3, b = item / 264;
    const bool lat = ck < 64; const int r0 = lat ? b * T_ + ck * 128 : NTOK + b * 256 + (ck - 64) * 128;
    LAS bf16_t* Qs = (LAS bf16_t*)lds; LAS bf16_t* Ks = Qs + 128 * 264; LAS float* lrs = (LAS float*)(lds + 2 * 128 * 264 * 2); LAS float* seg = lrs + 128 * 32;
    unsigned char* ws = p.ws;
    bf16_t* QB = (bf16_t*)(ws + O_QB); bf16_t* QF = (bf16_t*)(ws + O_QF); const bf16_t* KB = (const bf16_t*)(ws + O_KB);
    __syncthreads();
    { const f32x4* src = (const f32x4*)((const float*)(ws + O_LR) + (size_t)r0 * 32); ((LAS f32x4*)lrs)[tid] = src[tid]; ((LAS f32x4*)lrs)[tid + 512] = src[tid + 512]; }
    const int half = tid >> 8, d = tid & 255, gc = h * 256 + d;
    for (int dir = 0; dir < 2; ++dir) {
        const int chain = dir * 8 + b * 4 + h;
        const float* wg = dir == 0 ? p.wgf : p.wgb; const float bias = (dir == 0 ? p.bgf : p.bgb)[gc];
        float wv[16];
#pragma unroll
        for (int j = 0; j < 16; ++j) wv[j] = wg[j * 1024 + gc];
        __syncthreads();
        float carry = 0.f;
        bf16_t* qdst = dir == 0 ? QF : QB;
#pragma unroll 1
        for (int rnd = 0; rnd < 2; ++rnd) {
            float bl[32]; float run = 0.f;
            const int ibase = rnd * 64 + half * 32;
            unsigned short kraw[32], qraw[32];
#pragma unroll
            for (int ii = 0; ii < 32; ++ii) { const int i = ibase + ii, tok = dir == 0 ? i : 127 - i; const size_t gi = (size_t)(r0 + tok) * 1024 + gc;
                kraw[ii] = KB[gi]; qraw[ii] = lat ? QB[gi] : (unsigned short)0; }
#pragma unroll
            for (int ii = 0; ii < 32; ++ii) {
                const int i = ibase + ii, tok = dir == 0 ? i : 127 - i;
                const LAS f32x4* lp = (const LAS f32x4*)(lrs + tok * 32 + dir * 16);
                f32x2 x2 = (f32x2){bias, 0.f};
#pragma unroll
                for (int q = 0; q < 4; ++q) { const f32x4 l4 = lp[q];
                    x2 = __builtin_elementwise_fma((f32x2){l4[0], l4[1]}, (f32x2){wv[q * 4], wv[q * 4 + 1]}, x2);
                    x2 = __builtin_elementwise_fma((f32x2){l4[2], l4[3]}, (f32x2){wv[q * 4 + 2], wv[q * 4 + 3]}, x2); }
                const float xg = x2.x + x2.y;
                const float ls = fminf(xg, 0.f) - __logf(1.0f + __expf(-fabsf(xg)));
                run += ls * 0.0625f; bl[ii] = run;
            }
            __syncthreads();
            seg[half * 256 + d] = run;
            __syncthreads();
            const float s0 = seg[d], s1 = seg[256 + d];
            const float off = carry + (half == 1 ? s0 : 0.f);
            carry += s0 + s1;
#pragma unroll
            for (int ii = 0; ii < 32; ++ii) {
                const int i = ibase + ii, tok = dir == 0 ? i : 127 - i;
                const float bb = bl[ii] + off; const float eb = __expf(bb), ieb = __expf(-bb);
                Ks[tok * 264 + d] = f2bf(bf2f(kraw[ii]) * ieb);
                if (lat) { const bf16_t qv = f2bf(bf2f(qraw[ii]) * 0.0625f * eb); Qs[tok * 264 + d] = qv; }
            }
        }
        if (half == 1) ((float*)(ws + O_DD))[((size_t)chain * 66 + ck) * 256 + d] = __expf(carry);
        __syncthreads();
        if (lat) {
            f32x4 a[8];
#pragma unroll
            for (int n = 0; n < 8; ++n) a[n] = (f32x4){0.f, 0.f, 0.f, 0.f};
#pragma unroll
            for (int s = 0; s < 8; ++s) { const bf16x8 qfr = *(const LAS bf16x8*)(Qs + (16 * w + fr) * 264 + s * 32 + fq * 8);
#pragma unroll
                for (int n = 0; n < 8; ++n) { const bf16x8 kfr = *(const LAS bf16x8*)(Ks + (n * 16 + fr) * 264 + s * 32 + fq * 8); a[n] = MFMA16(kfr, qfr, a[n]); }
                __builtin_amdgcn_sched_barrier(0); }
            bf16_t* ab = (bf16_t*)(ws + O_XR) + (size_t)(chain * 64 + ck) * 16384;
            {
#pragma unroll
                for (int it = 0; it < 8; ++it) { const int idx = it * 512 + tid, f = idx >> 6, L = idx & 63;
                    const u32x4 v = *(const LAS u32x4*)(Qs + (16 * (f >> 3) + (L & 15)) * 264 + (f & 7) * 32 + (L >> 4) * 8);
                    *(u32x4*)(qdst + (size_t)(r0 + 2 * f + (L >> 5)) * 1024 + h * 256 + (L & 31) * 8) = v; }
            }
            const int cmr = (fq * 4 - 16 * w - fr + opaque0()) * (dir == 0 ? 1 : -1);
#pragma unroll
            for (int n = 0; n < 8; ++n) { float v[4];
#pragma unroll
                for (int j = 0; j < 4; ++j) { const int dcr = cmr + (dir == 0 ? (n * 16 + j) : -(n * 16 + j)); v[j] = dcr <= 0 ? a[n][j] : 0.f; }
                u32x2 pk; pk.x = cvt_pk_bf16(v[0], v[1]); pk.y = cvt_pk_bf16(v[2], v[3]);
                *(u32x2*)(ab + ((w * 4 + (n >> 1)) * 64 + ((n & 1) * 2 + (fq >> 1)) * 16 + fr) * 8 + (fq & 1) * 4) = pk; }
        }
        {
            bf16_t* kt = (bf16_t*)(ws + O_KT) + ((size_t)(chain * 66 + ck)) * 32768 + ((size_t)((d >> 5) * 2 + ((d >> 4) & 1)) * 4 * 64 + (d & 15)) * 8;
#pragma unroll
            for (int it = 0; it < 8; ++it) { const int tc = it * 2 + half; unsigned short e[8];
#pragma unroll
                for (int q = 0; q < 8; ++q) e[q] = Ks[(tc * 8 + q) * 264 + d];
                u32x4 pk; pk.x = e[0] | ((unsigned)e[1] << 16); pk.y = e[2] | ((unsigned)e[3] << 16); pk.z = e[4] | ((unsigned)e[5] << 16); pk.w = e[6] | ((unsigned)e[7] << 16);
                *(u32x4*)(kt + ((tc >> 2) * 64 + (tc & 3) * 16) * 8) = pk; }
        }
    }
}

__device__ void glaseq_item(LAS unsigned char* lds, const P& p, int item) {
    const int tid = threadIdx.x + opaque0(), w = __builtin_amdgcn_readfirstlane(tid >> 6), lane = tid & 63, fr = lane & 15, fq = lane >> 4;
    const int chain = item & 15, sl = item >> 4, dir = chain >> 3, b = (chain >> 2) & 1, h = chain & 3;
    unsigned char* ws = p.ws;
    LAS bf16_t* Ss = (LAS bf16_t*)lds;
    const bf16_t* VBT = (const bf16_t*)(ws + O_VBT) + (size_t)(h * 512 + sl * 32 + fr) * NROW + fq * 8;
    const bf16_t* KT = (const bf16_t*)(ws + O_KT) + (size_t)chain * 66 * 32768 + ((size_t)w * 2 * 4 * 64 + lane) * 8;
    const bf16_t* QT = (const bf16_t*)(ws + (dir == 0 ? O_QF : O_QB));
    const bf16_t* AB = (const bf16_t*)(ws + O_XR) + (size_t)chain * 64 * 128 * 128;
    const float* DD = (const float*)(ws + O_DD) + (size_t)chain * 66 * 256 + 32 * w + fq * 4;
    bf16_t* OB = (bf16_t*)(ws + O_OF) + (size_t)dir * NTOK * 2048;
    f32x4 st[2][2];
#pragma unroll
    for (int t = 0; t < 2; ++t)
#pragma unroll
        for (int n = 0; n < 2; ++n) st[t][n] = (f32x4){0.f, 0.f, 0.f, 0.f};
#define GS_CK(s_) (dir == 0 ? ((s_) < 2 ? 64 + (s_) : (s_) - 2) : 65 - (s_))
#define GS_R0(s_, ck_) ((s_) >= 2 ? b * T_ + (ck_) * 128 : NTOK + b * 256 + ((ck_) - 64) * 128)
#define GS_LOADK(KF, DDv, s_) do { const int ck_ = GS_CK(s_); \
        _Pragma("unroll") for (int n = 0; n < 2; ++n) _Pragma("unroll") for (int q = 0; q < 4; ++q) KF[n][q] = *(const bf16x8*)(KT + (size_t)ck_ * 32768 + ((n * 4 + q) * 64) * 8); \
        DDv[0] = *(const f32x4*)(DD + (size_t)ck_ * 256); DDv[1] = *(const f32x4*)(DD + (size_t)ck_ * 256 + 16); } while (0)
#define GS_LOADV8(VF, s_) do { const int ck_ = GS_CK(s_); const int r0_ = GS_R0(s_, ck_); \
        _Pragma("unroll") for (int n = 0; n < 2; ++n) _Pragma("unroll") for (int q = 0; q < 4; ++q) VF[n][q] = *(const bf16x8*)(VBT + (size_t)n * 16 * NROW + r0_ + q * 32); } while (0)
#define GS_VFRAG(dst, s_) do { const int ck_ = GS_CK(s_); const int r0_ = GS_R0(s_, ck_); dst = *(const bf16x8*)(VBT + (size_t)(w >> 2) * 16 * NROW + r0_ + (w & 3) * 32); } while (0)
#define GS_UPDATE(VF, KF, DDv) do { _Pragma("unroll") for (int t = 0; t < 2; ++t) _Pragma("unroll") for (int n = 0; n < 2; ++n) { f32x4 tmp = st[t][n]; \
        _Pragma("unroll") for (int q = 0; q < 4; ++q) tmp = MFMA16(KF[t][q], VF[n][q], tmp); st[t][n] = tmp * DDv[t]; } } while (0)
#define GS_LOADQA(s_) do { const int ck_ = GS_CK(s_); const int r0_ = GS_R0(s_, ck_); \
        const bf16_t* qp_ = QT + (size_t)(r0_ + 16 * w + (lane >> 5)) * 1024 + h * 256 + (lane & 31) * 8; const bf16_t* ap_ = AB + (size_t)ck_ * 16384 + ((size_t)w * 4 * 64 + lane) * 8; \
        _Pragma("unroll") for (int q = 0; q < 8; ++q) qfr[q] = *(const bf16x8*)(qp_ + (size_t)q * 2 * 1024); \
        _Pragma("unroll") for (int q = 0; q < 4; ++q) if (q >= qlo && q <= qhi) af[q] = *(const bf16x8*)(ap_ + q * 64 * 8); } while (0)
    bf16x8 kfA[2][4], kfB[2][4], qfr[8], af[4], vcur; f32x4 ddA[2], ddB[2];
    const int qlo = dir == 0 ? 0 : (w >> 1), qhi = dir == 0 ? (w >> 1) : 3;
#pragma unroll
    for (int q = 0; q < 4; ++q) af[q] = (bf16x8){0, 0, 0, 0, 0, 0, 0, 0};
    LAS bf16x8* Vl = (LAS bf16x8*)(lds + 2 * 16896);
    __syncthreads();
    {
        bf16x8 vf0[2][4];
        GS_LOADK(kfA, ddA, 0); GS_LOADV8(vf0, 0); GS_LOADK(kfB, ddB, 1);
        GS_UPDATE(vf0, kfA, ddA);
        GS_LOADV8(vf0, 1);
        GS_LOADK(kfA, ddA, 2); GS_LOADQA(2); GS_VFRAG(vcur, 2);
        GS_UPDATE(vf0, kfB, ddB);
    }
#define GS_STEP(KF, DDv, KFN, DDN, s_, BUF) do { \
        const int sn_ = (s_) + 1 < 66 ? (s_) + 1 : 65; \
        GS_LOADK(KFN, DDN, sn_); \
        LAS bf16_t* SsB = Ss + (BUF) * (32 * 264); LAS bf16x8* VlB = Vl + (BUF) * 512; \
        _Pragma("unroll") for (int t = 0; t < 2; ++t) _Pragma("unroll") for (int n = 0; n < 2; ++n) { u32x2 pk; pk.x = cvt_pk_bf16(st[t][n][0], st[t][n][1]); pk.y = cvt_pk_bf16(st[t][n][2], st[t][n][3]); \
            *(LAS u32x2*)(SsB + (n * 16 + fr) * 264 + 32 * w + t * 16 + fq * 4) = pk; } \
        VlB[w * 64 + lane] = vcur; \
        LDS_BARRIER(); \
        bf16x8 vf[2][4]; \
        _Pragma("unroll") for (int n = 0; n < 2; ++n) _Pragma("unroll") for (int q = 0; q < 4; ++q) vf[n][q] = VlB[(n * 4 + q) * 64 + lane]; \
        GS_VFRAG(vcur, sn_); \
        GS_UPDATE(vf, KF, DDv); \
        f32x4 oo[2] = {(f32x4){0.f, 0.f, 0.f, 0.f}, (f32x4){0.f, 0.f, 0.f, 0.f}}; \
        _Pragma("unroll") for (int q = 0; q < 4; ++q) if (q >= qlo && q <= qhi) { _Pragma("unroll") for (int n = 0; n < 2; ++n) oo[n] = MFMA16(vf[n][q], af[q], oo[n]); } \
        _Pragma("unroll") for (int q = 0; q < 8; ++q) _Pragma("unroll") for (int n = 0; n < 2; ++n) { \
            const bf16x8 sf = *(const LAS bf16x8*)(SsB + (n * 16 + fr) * 264 + q * 32 + fq * 8); oo[n] = MFMA16(sf, qfr[q], oo[n]); } \
        { const int ck_ = GS_CK(s_); const int r0_ = GS_R0(s_, ck_); bf16_t* op = OB + (size_t)(r0_ + 16 * w + fr) * 2048 + h * 512 + sl * 32 + fq * 4; \
          _Pragma("unroll") for (int n = 0; n < 2; ++n) { u32x2 pk; pk.x = cvt_pk_bf16(oo[n][0], oo[n][1]); pk.y = cvt_pk_bf16(oo[n][2], oo[n][3]); *(u32x2*)(op + n * 16) = pk; } } \
        GS_LOADQA(sn_); \
    } while (0)
#pragma unroll 1
    for (int s = 2; s < 66; s += 2) {
        GS_STEP(kfA, ddA, kfB, ddB, s, 0);
        GS_STEP(kfB, ddB, kfA, ddA, s + 1, 1);
    }
#undef GS_CK
#undef GS_R0
#undef GS_LOADK
#undef GS_LOADV8
#undef GS_VFRAG
#undef GS_UPDATE
#undef GS_LOADQA
#undef GS_STEP
}

__device__ void phase_glafinal(const P& p, bf16_t* cc) {
    const int tix = threadIdx.x + opaque0(); const int lane = tix & 63, gw = blockIdx.x * 8 + (tix >> 6), nw = gridDim.x * 8;
    const bf16_t* OF = (const bf16_t*)(p.ws + O_OF); const bf16_t* OBk = OF + (size_t)NTOK * 2048;
    f32x4 g0 = *(const f32x4*)(p.gla_norm + lane * 8), g1 = *(const f32x4*)(p.gla_norm + lane * 8 + 4);
    for (int i = gw; i < NTOK * 4; i += nw) {
        const size_t o = (size_t)i * 512 + lane * 8;
        float a[8], c[8]; unpack8(*(const u32x4*)(OF + o), a); unpack8(*(const u32x4*)(OBk + o), c);
        float ss = 0.f;
#pragma unroll
        for (int e = 0; e < 8; ++e) { a[e] += c[e]; ss += a[e] * a[e]; }
        ss = wave_sum(ss); const float rs = rsqrtf(ss * (1.0f / 512) + EPS_);
#pragma unroll
        for (int e = 0; e < 4; ++e) { a[e] *= rs * g0[e]; a[4 + e] *= rs * g1[e]; }
        const int r = i >> 2, hh = i & 3;
        *(u32x4*)(cc + (size_t)r * 4096 + 2048 + hh * 512 + lane * 8) = pack8(a);
    }
}

__device__ void phase_conv(const P& p, const bf16_t* U, int ldu, int j0, int ns, bf16_t* act) {
    const int ncg = ns * 16, ntask = 256 * ncg;
    for (int task = blockIdx.x * 512 + threadIdx.x + opaque0(); task < ntask; task += gridDim.x * 512) {
        const int run = task / ncg, cgi = task % ncg, jl = cgi >> 4, i8 = (cgi & 15) * 8;
        const int ch = 128 * (j0 + jl) + i8; const int ucol = jl * 256 + i8;
        float wa[3][8], wg[3][8], ba[8], bg[8];
#pragma unroll
        for (int j = 0; j < 3; ++j)
#pragma unroll
            for (int e = 0; e < 8; ++e) { wa[j][e] = p.conv_w[j * 11264 + ch + e]; wg[j][e] = p.conv_w[j * 11264 + 5632 + ch + e]; }
#pragma unroll
        for (int e = 0; e < 8; ++e) { ba[e] = p.conv_b[ch + e]; bg[e] = p.conv_b[5632 + ch + e]; }
        const int rw0 = run * 64; const int tl0 = rw0 & (T_ - 1);
        float pa[8], pg[8], ca[8], cg_[8], na[8], ng[8];
        const bf16_t* up = U + (size_t)rw0 * ldu + ucol;
        if (tl0 > 0) { unpack8(*(const u32x4*)(up - ldu), pa); unpack8(*(const u32x4*)(up - ldu + 128), pg); }
        else {
#pragma unroll
            for (int e = 0; e < 8; ++e) { pa[e] = 0.f; pg[e] = 0.f; } }
        unpack8(*(const u32x4*)(up), ca); unpack8(*(const u32x4*)(up + 128), cg_);
#pragma unroll 1
        for (int i0 = 0; i0 < 64; i0 += 8) {
            u32x4 ra[8], rg[8];
#pragma unroll
            for (int k = 0; k < 8; ++k) { const int rn = rw0 + i0 + k + 1; const bf16_t* q = U + (size_t)(rn < NTOK ? rn : NTOK - 1) * ldu + ucol;
                ra[k] = *(const u32x4*)q; rg[k] = *(const u32x4*)(q + 128); }
#pragma unroll
            for (int k = 0; k < 8; ++k) {
                const int i = i0 + k; const bool has_next = (tl0 + i + 1) < T_;
                unpack8(ra[k], na); unpack8(rg[k], ng);
                if (!has_next) {
#pragma unroll
                    for (int e = 0; e < 8; ++e) { na[e] = 0.f; ng[e] = 0.f; } }
                float y[8];
#pragma unroll
                for (int e = 0; e < 8; ++e) { const float av = wa[0][e] * pa[e] + wa[1][e] * ca[e] + wa[2][e] * na[e] + ba[e]; const float gv = wg[0][e] * pg[e] + wg[1][e] * cg_[e] + wg[2][e] * ng[e] + bg[e];
                    y[e] = siluf_(av) * gv; pa[e] = ca[e]; pg[e] = cg_[e]; ca[e] = na[e]; cg_[e] = ng[e]; }
                *(u32x4*)(act + (size_t)(rw0 + i) * 5632 + ch) = pack8(y);
            }
        }
    }
}


#ifdef DBG_STOP
__device__ void dbg_dump(cg::grid_group& grid, const P& p, const bf16_t* src, size_t ld, int rows, int cols) {
    bf16_t* tmp = (bf16_t*)(p.ws + O_MIXEND);
    grid.sync();
    const size_t n = (size_t)rows * cols;
    for (size_t i = (size_t)blockIdx.x * 512 + threadIdx.x; i < n; i += (size_t)gridDim.x * 512) tmp[i] = src[(i / cols) * ld + (i % cols)];
    grid.sync();
    for (size_t i = (size_t)blockIdx.x * 512 + threadIdx.x; i < (size_t)NTOK * DM; i += (size_t)gridDim.x * 512) {
        const size_t r = i / DM, c = i % DM; p.out[i] = (r < (size_t)rows && c < (size_t)cols) ? bf2f(tmp[r * cols + c]) : 0.f; }
}
#define DBG_AT(k, src, ld, rows, cols) if (DBG_STOP == k) { dbg_dump(grid, p, (const bf16_t*)(src), ld, rows, cols); return; }
#else
#define DBG_AT(k, src, ld, rows, cols)
#endif

#ifdef DBG_STOP
__device__ void dbg_nancount(cg::grid_group& grid, const P& p, const bf16_t* src, size_t n, int mode) {
    unsigned* cnt = (unsigned*)(p.ws + O_MIXEND);
    grid.sync();
    if (blockIdx.x == 0 && threadIdx.x == 0) { cnt[0] = 0; cnt[1] = 0; }
    grid.sync();
    unsigned c = 0; float mx = 0.f;
    for (size_t i = (size_t)blockIdx.x * 512 + threadIdx.x; i < n; i += (size_t)gridDim.x * 512) { const unsigned short v = src[i]; if ((v & 0x7f80) == 0x7f80) ++c; else mx = fmaxf(mx, fabsf(bf2f(v))); }
    if (c) atomicAdd(cnt, c);
    atomicMax(cnt + 1, __float_as_uint(mx));
    grid.sync();
    for (size_t i = (size_t)blockIdx.x * 512 + threadIdx.x; i < (size_t)NTOK * DM; i += (size_t)gridDim.x * 512) p.out[i] = 0.f;
    grid.sync();
    if (blockIdx.x == 0 && threadIdx.x == 0) p.out[0] = mode == 0 ? (float)cnt[0] : __uint_as_float(cnt[1]);
}
#define DBG_NAN(k, src, n) if (DBG_STOP == k) { dbg_nancount(grid, p, (const bf16_t*)(src), n, 0); return; } if (DBG_STOP == k + 100) { dbg_nancount(grid, p, (const bf16_t*)(src), n, 1); return; }
#else
#define DBG_NAN(k, src, n)
#endif
#define XB_TMO      128
#define XB_XCNT(j)  (256  + 64 * (j))
#define XB_XSUB(j)  (1280 + 64 * (j))
#define XB_XGEN(j)  (2304 + 64 * (j))
#define XB_TOP      3328
#define XB_TOPGEN   3392
#define XCD_BAR_WORDS 3456
#define XB_SPIN_CAP (1u << 18)

__device__ __forceinline__ unsigned xb_ld(unsigned* p)              { return __hip_atomic_load(p, __ATOMIC_RELAXED, __HIP_MEMORY_SCOPE_AGENT); }
__device__ __forceinline__ unsigned xb_add(unsigned* p, unsigned v) { return __hip_atomic_fetch_add(p, v, __ATOMIC_RELAXED, __HIP_MEMORY_SCOPE_AGENT); }
__device__ __forceinline__ unsigned xb_xcc_id() { return (unsigned)__builtin_amdgcn_s_getreg((3 << 11) | 20) & 0xFu; }
#define XB_SPIN(cond, bar) do { unsigned _sp = 0; while (cond) { __builtin_amdgcn_s_sleep(1); \
    if ((++_sp & 255u) == 0u) { if (xb_ld(&(bar)[XB_TMO])) break; if (_sp > XB_SPIN_CAP) { atomicAdd(&(bar)[XB_TMO], 1u); break; } } } } while (0)

struct XcdBarrier {
    unsigned* bar; unsigned x;
    volatile LAS unsigned* st;
};

__device__ __forceinline__ XcdBarrier xcd_barrier_post(unsigned* bar, volatile LAS unsigned* st) {
    XcdBarrier b; b.bar = bar; b.x = xb_xcc_id(); b.st = st;
    if (threadIdx.x == 0) (void)xb_add(&bar[XB_XCNT(b.x)], 1u);
    return b;
}
__device__ __forceinline__ void xcd_barrier_complete(unsigned* bar, unsigned x, unsigned& nloc, unsigned& nx) {
    const unsigned G = gridDim.x * gridDim.y * gridDim.z;
    unsigned sum, cnt, mine, sp = 0u;
    for (;;) {
        sum = 0u; cnt = 0u; mine = 0u;
#pragma unroll
        for (unsigned j = 0; j < 16; ++j) { const unsigned c = xb_ld(&bar[XB_XCNT(j)]); sum += c; cnt += (c > 0u) ? 1u : 0u; mine = (j == x) ? c : mine; }
        if (sum == G) break;
        __builtin_amdgcn_s_sleep(1);
        if ((++sp & 255u) == 0u) { if (xb_ld(&bar[XB_TMO])) break; if (sp > XB_SPIN_CAP) { atomicAdd(&bar[XB_TMO], 1u); break; } }
    }
    nloc = mine > 0u ? mine : 1u; nx = cnt > 0u ? cnt : 1u;
}

__device__ __forceinline__ void xcd_barrier(const XcdBarrier& b) {
    asm volatile("s_waitcnt vmcnt(0)" ::: "memory");
    __syncthreads();
    if (threadIdx.x == 0) {
        unsigned* bar = b.bar;
        __builtin_amdgcn_s_waitcnt(0);
        unsigned nloc = b.st[0], nx = b.st[1];
        if (nloc == 0u) { xcd_barrier_complete(bar, b.x, nloc, nx); b.st[0] = nloc; b.st[1] = nx; }
        const unsigned old = xb_add(&bar[XB_XSUB(b.x)], 1u);
        const unsigned gen = old / nloc;
        if (old + 1u == (gen + 1u) * nloc) {
            __builtin_amdgcn_fence(__ATOMIC_RELEASE, "agent");
            asm volatile("s_waitcnt vmcnt(0)" ::: "memory");
            const unsigned og = xb_add(&bar[XB_TOP], 1u);
            const unsigned tg = og / nx;
            if (og + 1u == (tg + 1u) * nx) xb_add(&bar[XB_TOPGEN], 1u);
            else XB_SPIN(xb_ld(&bar[XB_TOPGEN]) == tg, bar);
            __builtin_amdgcn_fence(__ATOMIC_ACQUIRE, "agent");
            xb_add(&bar[XB_XGEN(b.x)], 1u);
            asm volatile("s_waitcnt vmcnt(0)" ::: "memory");
        } else {
            XB_SPIN(xb_ld(&bar[XB_XGEN(b.x)]) == gen, bar);
            __builtin_amdgcn_fence(__ATOMIC_ACQUIRE, "agent");
            asm volatile("s_waitcnt vmcnt(0)" ::: "memory");
        }
    }
    __syncthreads();
}


__global__ void __launch_bounds__(512) fwd_megakernel(P p) {
    extern __shared__ __attribute__((aligned(16))) unsigned char shm[];
    LAS unsigned char* lds = (LAS unsigned char*)shm;
    cg::grid_group grid = cg::this_grid();
    volatile LAS unsigned* xst = (volatile LAS unsigned*)(lds + 153600);
    if (threadIdx.x == 0) { xst[0] = 0u; xst[1] = 0u; }
    __syncthreads();
    const XcdBarrier xb = xcd_barrier_post((unsigned*)(p.ws + O_BAR), xst);
#ifdef TIME_A
    unsigned long long ts0 = 0, ts1 = 0, ts2 = 0, ts3 = 0, ts4 = 0, ts5 = 0, ts6 = 0, ts7 = 0, ts8 = 0, ts9 = 0, ts10 = 0, ts11 = 0, ts12 = 0, ts13 = 0;
#define TS(k) ts##k = __builtin_amdgcn_s_memrealtime();
#define TSCAT2(a) ts##a
#define TSCAT(a) TSCAT2(a)
#else
#define TS(k)
#endif
    TS(0)
    unsigned char* ws = p.ws; const int nb = gridDim.x, bid = blockIdx.x;
    float* mod = (float*)(ws + O_MOD);
    bf16_t* cc = (bf16_t*)p.out;

#ifndef PHMASK
#define PHMASK 0xffff
#endif
    if (PHMASK & 1) phase0(lds, p);
    xcd_barrier(xb); if (p.pad == 0x7eadbeef) grid.sync();
    TS(1)
#ifdef DBL_P0
    phase0(lds, p);
    xcd_barrier(xb);
#endif
    if (PHMASK & 1) phase_modreduce(p);
    xcd_barrier(xb);
    TS(2)
    if (PHMASK & 1) phase_modulate(p.x, p.ctx, p.g_mix, mod, 0, 1, (bf16_t*)(ws + O_H), NROW);
    xcd_barrier(xb);
    TS(3)
    if (PHMASK & 2) { SchedProj1 S{(const char*)(ws + O_H), (const char*)(ws + O_XR), ws, nb, bid}; EpiProj1 E; pg8::gemm_phase(lds, 2048, S, E); }
    xcd_barrier(xb);
    TS(4)
    DBG_AT(1, ws + O_QA, 2048, 8192, 2048)
    DBG_AT(2, ws + O_VBT, NROW, 2048, 2048)
    DBG_AT(11, ws + O_H, 2048, 8192, 2048)
    DBG_AT(12, ws + O_KB, 1024, 8192, 1024)
    phase_kprep(p);
    xcd_barrier(xb);
    {
        unsigned* qctr = (unsigned*)(ws + O_BAR + 16384); volatile LAS unsigned* qs = (volatile LAS unsigned*)(lds + 153608);
        for (;;) {
            __syncthreads();
            if (threadIdx.x == 0) qs[0] = __hip_atomic_fetch_add(qctr, 1u, __ATOMIC_RELAXED, __HIP_MEMORY_SCOPE_AGENT);
            __syncthreads();
            const int it = (int)qs[0];
            if (it >= 528 + 1024) break;
            if (it < 528) glaprep_item(lds, p, it); else attn_item(lds, p, cc, it - 528);
        }
    }
    xcd_barrier(xb);
    TS(5)
    DBG_AT(3, cc, 4096, 8192, 2048)
    DBG_AT(4, ws + O_QF, 1024, 8192, 1024)
    DBG_AT(5, ws + O_XR, 2048, 8192, 2048)
    DBG_AT(6, ws + O_KT, NROW, 2048, 2048)
    DBG_AT(13, ws + O_QB, 1024, 8192, 1024)
#if defined(DBG_STOP) && DBG_STOP == 16
    { xcd_barrier(xb); for (size_t i = (size_t)bid * 512 + threadIdx.x; i < (size_t)NTOK * DM; i += (size_t)nb * 512) p.out[i] = i < 270336 ? ((const float*)(ws + O_DD))[i] : 0.f; return; }
#endif
    if (PHMASK & 16) for (int it = bid; it < 256; it += nb) glaseq_item(lds, p, it);
    xcd_barrier(xb);
    TS(6)
#ifdef DBL_SEQ
    for (int it = bid; it < 256; it += nb) glaseq_item(lds, p, it);
    xcd_barrier(xb);
#endif
    DBG_AT(7, ws + O_OF, 2048, 8192, 2048)
    DBG_NAN(20, ws + O_OF, (size_t)2 * NTOK * 2048)
    DBG_NAN(21, ws + O_KT, (size_t)2 * 1024 * NROW)
    DBG_AT(14, ws + O_OF + 67108864, 2048, 8192, 2048)
    if (PHMASK & 32) phase_glafinal(p, cc);
    xcd_barrier(xb);
    TS(7)
    DBG_AT(8, cc + 2048, 4096, 8192, 2048)
    if (PHMASK & 64) { SchedProj2 S{(const char*)(ws + O_H), (const char*)(ws + O_W2IN), ws, cc, nb, bid}; EpiProj2 E; pg8::gemm_phase(lds, 2048, S, E); }
    xcd_barrier(xb);
    TS(8)
    DBG_AT(9, ws + O_GA, 2048, 8192, 2048)
    DBG_AT(15, cc + 2048, 4096, 8192, 2048)
    if (PHMASK & 128) { SchedMerge S{(const char*)cc, (const char*)(ws + O_WMRG), ws, nb, bid}; EpiMerge E{(const bf16_t*)(ws + O_GA), (const bf16_t*)(ws + O_GA + 67108864)}; pg8::gemm_phase(lds, 4096, S, E); }
    xcd_barrier(xb);
    TS(9)
    DBG_AT(10, ws + O_M, 2048, 8192, 2048)
    if (PHMASK & 256) { SchedRes S{(const char*)(ws + O_M), (const char*)(ws + O_WOUT), 2048, nb, bid}; EpiDelta E{(bf16_t*)(ws + O_D1), mod + 2 * 2048}; pg8::gemm_phase(lds, 2048, S, E); }
    xcd_barrier(xb);
    TS(10)
#ifdef DBG_STOP_WOUT
    return;
#endif
    phase_modulate2(p.x, (const bf16_t*)(ws + O_D1), p.g_ffn, mod, 3, 4, (bf16_t*)(ws + O_H2));
    { LAS float* tl = (LAS float*)lds; const int J5 = 32 * 44, J6 = 88 * 8, JT = J5 + J6; const int tid = threadIdx.x + opaque0();
      auto job2 = [&](int it) -> TJob { return it < J5 ? tj_make(p.w_up, 11264, (bf16_t*)(ws + O_WUP), 2048, 11264, 3, 0, it) : tj_make(p.w_down, 2048, (bf16_t*)(ws + O_WDN), 5632, 2048, 0, 0, it - J5); };
      int it = bid; f32x4 v[8]; TJob cur;
      if (it < JT) { cur = job2(it); tj_load(cur, tid, v); }
      while (it < JT) {
          LDS_BARRIER(); tj_store(tl, cur, tid, v);
          const int itn = it + nb; TJob nxt = cur; if (itn < JT) { nxt = job2(itn); tj_load(nxt, tid, v); }
          LDS_BARRIER(); tj_flush(tl, cur, tid);
          cur = nxt; it = itn; } }
    xcd_barrier(xb);
    TS(11)
    { SchedUpC S{(const char*)(ws + O_H2), (const char*)(ws + O_WUP), nb, bid}; EpiUpConv E{p.conv_w, p.conv_b, (bf16_t*)(ws + O_U), (float*)(ws + O_U + 184549376), lds}; pg8::gemm_phase(lds, 2048, S, E); }
    xcd_barrier(xb);
    phase_convfix(p, (const float*)(ws + O_U + 184549376), (bf16_t*)(ws + O_U));
    xcd_barrier(xb);
    TS(12)
    if (PHMASK & 4096) { SchedRes S{(const char*)(ws + O_U), (const char*)(ws + O_WDN), 5632, nb, bid}; EpiRes2 E{p.x, (const bf16_t*)(ws + O_D1), p.out, mod + 5 * 2048}; pg8::gemm_phase(lds, 5632, S, E); }
#ifdef TIME_A
    xcd_barrier(xb); TS(13)
    if (bid == 0 && threadIdx.x == 0) p.out[0] = (float)(TSCAT(TIME_B) - TSCAT(TIME_A));
#endif
#ifdef DBG_COPYX
    xcd_barrier(xb);
    for (size_t i = (size_t)bid * 512 + threadIdx.x; i < (size_t)NTOK * DM / 4; i += (size_t)nb * 512) ((f32x4*)p.out)[i] = ((const f32x4*)p.x)[i];
#endif
}

extern "C" void kernel_launch(void* const* d_in, const int* in_sizes, int n_in, void* d_out, int out_size, void* d_ws, size_t ws_size, hipStream_t stream) {
    static int grid_blocks = 0;
    if (grid_blocks == 0) {
        int dev = 0, cus = 0, per_cu = 0;
        hipGetDevice(&dev); hipDeviceGetAttribute(&cus, hipDeviceAttributeMultiprocessorCount, dev);
        if (hipFuncSetAttribute((const void*)fwd_megakernel, hipFuncAttributeMaxDynamicSharedMemorySize, LDS_BYTES) != hipSuccess) { fprintf(stderr, "kernel_launch: hipFuncSetAttribute failed\n"); grid_blocks = -1; return; }
        if (hipOccupancyMaxActiveBlocksPerMultiprocessor(&per_cu, (const void*)fwd_megakernel, 512, LDS_BYTES) != hipSuccess || per_cu < 1) { fprintf(stderr, "kernel_launch: occupancy query gave %d\n", per_cu); per_cu = 1; }
        (void)hipGetLastError();
        grid_blocks = cus * 1;
    }
    if (grid_blocks < 0) return;
    P p{};
    const float** f = (const float**)&p;
    for (int i = 0; i < 24; ++i) f[i] = (const float*)d_in[i];
    p.out = (float*)d_out; p.ws = (unsigned char*)d_ws;
    const size_t act_bytes = 184549376;
    if (ws_size >= O_U + (size_t)24 * 256 * NTOK * 2 + act_bytes) { p.ns[0] = 20; p.ns[1] = 24; p.ns[2] = 0; p.nsmax = 24; }
    else { p.ns[0] = 16; p.ns[1] = 16; p.ns[2] = 12; p.ns[3] = 0; p.nsmax = 16; }
    p.o_act = (long long)(O_U + (size_t)p.nsmax * 256 * NTOK * 2);
    if (ws_size < (size_t)p.o_act + act_bytes || ws_size < O_MIXEND) { fprintf(stderr, "kernel_launch: workspace too small (%zu)\n", ws_size); return; }
    if (ws_size < O_BAR + 16384 + 256) { fprintf(stderr, "kernel_launch: workspace too small for the barrier words (%zu)\n", ws_size); return; }
    if (hipMemsetAsync((char*)d_ws + O_BAR, 0, 16384 + 256, stream) != hipSuccess) { fprintf(stderr, "kernel_launch: memset failed\n"); return; }
    void* args[] = {&p};
    hipError_t e = hipLaunchCooperativeKernel((void*)fwd_megakernel, dim3(grid_blocks), dim3(512), args, LDS_BYTES, stream);
    if (e != hipSuccess) fprintf(stderr, "cooperative launch failed: %s (grid %d)\n", hipGetErrorString(e), grid_blocks);
}
```

```cpp
#include <hip/hip_runtime.h>
#include <hip/hip_cooperative_groups.h>
#include <cstdio>
namespace cg = cooperative_groups;

#define LAS __attribute__((address_space(3)))
typedef unsigned short bf16_t;
typedef short bf16x8 __attribute__((ext_vector_type(8)));
typedef float f32x4 __attribute__((ext_vector_type(4)));
typedef float f32x2 __attribute__((ext_vector_type(2)));
typedef unsigned u32x4 __attribute__((ext_vector_type(4)));
typedef unsigned u32x2 __attribute__((ext_vector_type(2)));

constexpr int T_ = 8192, NTOK = 16384, NROW = 16896, DM = 2048;
constexpr int LDS_BYTES = 153616;
constexpr size_t O_BAR = 530000896;
constexpr float EPS_ = 1e-6f;

constexpr size_t O_MODP = 0;
constexpr size_t O_MOD = O_MODP + 4718592;
constexpr size_t O_ROPE = O_MOD + 147456;
constexpr size_t O_DD = O_ROPE + 32768;
constexpr size_t O_BASE = O_DD + 1081344;
constexpr size_t O_W2IN = O_BASE;
constexpr size_t O_WMRG = O_W2IN + 25165824;
constexpr size_t O_WOUT = O_WMRG + 16777216;
constexpr size_t O_H = O_WOUT + 8388608;
constexpr size_t O_XR = O_H + 69206016;
constexpr size_t O_QA = O_XR + 33554432;
constexpr size_t O_KA = O_QA + 67108864;
constexpr size_t O_VAT = O_KA + 17301504;
constexpr size_t O_KB = O_VAT + 17301504;
constexpr size_t O_QB = O_KB + 34603008;
constexpr size_t O_VBT = O_QB + 33554432;
constexpr size_t O_LR = O_VBT + 69206016;
constexpr size_t O_QF = O_LR + 2162688;
constexpr size_t O_KT = O_QF + 33554432;
constexpr size_t O_MIXEND = O_KT + 69206016;
constexpr size_t O_D1 = 400000000;
constexpr size_t O_OF = O_QA;
constexpr size_t O_GA = O_QB;
constexpr size_t O_M = O_QA;
constexpr size_t O_WUP = O_BASE;
constexpr size_t O_WDN = O_WUP + 46137344;
constexpr size_t O_H2 = O_WDN + 23068672;
constexpr size_t O_U = O_H2 + 67108864;

struct P {
    const float *x, *c, *ctx, *c_ctx, *w_mod, *b_mod, *g_mix, *w_in, *q_norm, *k_norm, *sink, *wgf, *bgf, *wgb, *bgb, *gla_norm,
        *w_attn_o, *w_gla_o, *w_out, *g_ffn, *w_up, *conv_w, *conv_b, *w_down;
    float* out;
    unsigned char* ws;
    long long o_act;
    int ns[4];
    int nsmax, pad;
};

typedef __bf16 bf16x2_t __attribute__((ext_vector_type(2)));
__device__ __forceinline__ unsigned cvt_pk_bf16(float lo, float hi) { const f32x2 v = {lo, hi}; const bf16x2_t b = __builtin_convertvector(v, bf16x2_t); return __builtin_bit_cast(unsigned, b); }
__device__ __forceinline__ float bf2f(unsigned short b) { return __uint_as_float(((unsigned)b) << 16); }
__device__ __forceinline__ float bflo(unsigned u) { return __uint_as_float(u << 16); }
__device__ __forceinline__ float bfhi(unsigned u) { return __uint_as_float(u & 0xffff0000u); }
__device__ __forceinline__ bf16_t f2bf(float f) { return (bf16_t)(cvt_pk_bf16(f, 0.f) & 0xffffu); }
__device__ __forceinline__ float wave_sum(float v) {
#pragma unroll
    for (int o = 32; o >= 1; o >>= 1) v += __shfl_xor(v, o);
    return v;
}
__device__ __forceinline__ float sigmoidf_(float x) { return __builtin_amdgcn_rcpf(1.0f + __expf(-x)); }
__device__ __forceinline__ float siluf_(float x) { return x * __builtin_amdgcn_rcpf(1.0f + __expf(-x)); }
__device__ __forceinline__ void unpack8(const u32x4 v, float* f) {
    f[0] = bflo(v.x); f[1] = bfhi(v.x); f[2] = bflo(v.y); f[3] = bfhi(v.y); f[4] = bflo(v.z); f[5] = bfhi(v.z); f[6] = bflo(v.w); f[7] = bfhi(v.w);
}
__device__ __forceinline__ u32x4 pack8(const float* f) {
    u32x4 w; w.x = cvt_pk_bf16(f[0], f[1]); w.y = cvt_pk_bf16(f[2], f[3]); w.z = cvt_pk_bf16(f[4], f[5]); w.w = cvt_pk_bf16(f[6], f[7]); return w;
}
__device__ __forceinline__ int opaque0() { int z; asm volatile("v_mov_b32 %0, 0" : "=v"(z)); return z; }
#define LDS_BARRIER() do { asm volatile("s_waitcnt lgkmcnt(0)" ::: "memory"); __builtin_amdgcn_s_barrier(); asm volatile("" ::: "memory"); } while (0)
#define MFMA16(a, b, c) __builtin_amdgcn_mfma_f32_16x16x32_bf16((a), (b), (c), 0, 0, 0)

namespace pg8 {
constexpr int BM = 256, BK = 64, HALF = 128, HTB = HALF * BK * 2, STAGE_BYTES = 8 * HTB, NXCD = 8, WGM = 8;
__device__ __forceinline__ int lds_byte(int r, int c) { const int st = (r >> 4) * 2 + (c >> 5), rr = r & 15, cc = c & 31, ob = rr * 64 + cc * 2; return st * 1024 + (ob ^ (((ob >> 9) & 1) << 5)); }
__device__ __forceinline__ void stage_rc(int b, int& R, int& C) { const int st = b / 1024, sb = b % 1024, swz = sb ^ (((sb >> 9) & 1) << 5); R = (st >> 1) * 16 + swz / 64; C = (st & 1) * 32 + (swz % 64) / 2; }
__device__ __forceinline__ int perm32(int rho) { const int n = rho >> 4, i = rho & 15; return 8 * (i >> 2) + 4 * n + (i & 3); }

struct Unit { const char* A; const char* B; char* out; int ldc; int kind; int row0; int col0; };

__device__ __forceinline__ void rect_map(int L, int nM, int nN, int& pm, int& pn) {
    const int nwg = nM * nN; int wgid = L;
    { const int q = nwg / NXCD, r = nwg % NXCD, xcd = wgid % NXCD, off = wgid / NXCD; wgid = (xcd < r ? xcd * (q + 1) : r * (q + 1) + (xcd - r) * q) + off; }
    const int nig = WGM * nN, gid = wgid / nig, fm = gid * WGM, gsz = (nM - fm) < WGM ? (nM - fm) : WGM;
    pm = fm + ((wgid % nig) % gsz); pn = (wgid % nig) / gsz;
}

template <class Epi, class Sched>
__device__ __forceinline__ void gemm_phase(LAS unsigned char* lds, const int K, const Sched& S, const Epi& E) {
    const int tid = threadIdx.x + opaque0(), wid = __builtin_amdgcn_readfirstlane(tid >> 6), lane = tid & 63, wr = wid >> 2, wc = wid & 3, fr = lane & 15, fq = lane >> 4;
    const int nt = K / BK;
    unsigned voffA[2], voffB[2];
#pragma unroll
    for (int i = 0; i < 2; ++i) { int R, C; stage_rc(tid * 16 + i * 8192, R, C); const int Rb = (R & ~31) + perm32(R & 31);
        voffA[i] = (unsigned)(R * K + C) * 2u; voffB[i] = (unsigned)(Rb * K + C) * 2u; }
    const size_t kstep = (size_t)(BK * 2);
    const size_t hstep = (size_t)HALF * K * 2;
    const unsigned ldsw = (unsigned)wid * 1024u;
    const int aoff = lds_byte(wr * 64 + fr, fq * 8), boff = lds_byte(wc * 32 + fr, fq * 8);
#define PG8_SA(b, h) (((b) * 2 + (h)) * HTB)
#define PG8_SB(b, h) ((4 + (b) * 2 + (h)) * HTB)
#define PG8_STAGE(bufoff, gbase, voff) do { _Pragma("unroll") for (int _i = 0; _i < 2; ++_i) \
        __builtin_amdgcn_global_load_lds((const unsigned*)((const char*)(gbase) + (voff)[_i]), (LAS unsigned*)(lds + (bufoff) + ldsw + _i * 8192), 16, 0, 0); } while (0)
#define PG8_LDA(dst, b, h) do { _Pragma("unroll") for (int m = 0; m < 4; ++m) _Pragma("unroll") for (int k = 0; k < 2; ++k) dst[m][k] = *(const LAS bf16x8*)(lds + PG8_SA(b, h) + aoff + m * 2048 + k * 1024); } while (0)
#define PG8_LDB(dst, b, h) do { _Pragma("unroll") for (int n = 0; n < 2; ++n) _Pragma("unroll") for (int k = 0; k < 2; ++k) dst[n][k] = *(const LAS bf16x8*)(lds + PG8_SB(b, h) + boff + n * 2048 + k * 1024); } while (0)
#define PG8_MMA(ai, bj, At, Bt) do { __builtin_amdgcn_s_setprio(1); _Pragma("unroll") for (int m = 0; m < 4; ++m) _Pragma("unroll") for (int n = 0; n < 2; ++n) _Pragma("unroll") for (int k = 0; k < 2; ++k) \
        acc[ai][bj][m][n] = __builtin_amdgcn_mfma_f32_16x16x32_bf16(Bt[n][k], At[m][k], acc[ai][bj][m][n], 0, 0, 0); __builtin_amdgcn_s_setprio(0); } while (0)
#define PG8_WAIT_V(n) asm volatile("s_waitcnt vmcnt(" #n ")" ::: "memory")
#define PG8_WAIT_L(n) asm volatile("s_waitcnt lgkmcnt(" #n ")" ::: "memory")
#define PG8_BAR __builtin_amdgcn_s_barrier()
#define PG8_SCHED __builtin_amdgcn_sched_barrier(0)
    Unit cur, nxt; int ui = 0;
    if (!S.next(0, cur)) return;
    f32x4 acc[2][2][4][2];
#pragma unroll
    for (int a = 0; a < 2; ++a)
#pragma unroll
        for (int b = 0; b < 2; ++b)
#pragma unroll
            for (int m = 0; m < 4; ++m)
#pragma unroll
                for (int n = 0; n < 2; ++n) acc[a][b][m][n] = (f32x4){0.f, 0.f, 0.f, 0.f};
    bf16x8 At[4][2], B0[2][2], B1[2][2];
    const char* cA = cur.A; const char* cB = cur.B;
    PG8_STAGE(PG8_SB(0, 0), cB, voffB); PG8_STAGE(PG8_SA(0, 0), cA, voffA); PG8_STAGE(PG8_SB(0, 1), cB + hstep, voffB); PG8_STAGE(PG8_SA(0, 1), cA + hstep, voffA);
    if (wr == 1) PG8_BAR;
    PG8_WAIT_V(4); PG8_BAR;
    PG8_STAGE(PG8_SB(1, 0), cB + kstep, voffB); PG8_STAGE(PG8_SA(1, 0), cA + kstep, voffA); PG8_STAGE(PG8_SB(1, 1), cB + hstep + kstep, voffB);
    PG8_WAIT_V(6); PG8_BAR;
    for (;;) {
        const bool has_next = S.next(ui + 1, nxt);
        const char* nA = has_next ? nxt.A : cA; const char* nB = has_next ? nxt.B : cB;
        for (int t = 0; t < nt; t += 2) {
            const bool last = (t == nt - 2);
            if constexpr (Epi::MID) { if (t == (nt >> 1)) E.mid(acc, cur, wr, wc, fr, fq); }
            const char* a1 = cA + (size_t)(t + 1) * kstep;
            const char* a2 = last ? nA : cA + (size_t)(t + 2) * kstep; const char* b2 = last ? nB : cB + (size_t)(t + 2) * kstep;
            const char* a3 = a2 + kstep; const char* b3 = b2 + kstep;
            PG8_LDB(B0, 0, 0); PG8_SCHED; PG8_LDA(At, 0, 0); PG8_STAGE(PG8_SA(1, 1), a1 + hstep, voffA);
            PG8_WAIT_L(8); PG8_BAR; PG8_WAIT_L(0); PG8_MMA(0, 0, At, B0); PG8_BAR; PG8_SCHED;
            PG8_LDB(B1, 0, 1); PG8_STAGE(PG8_SB(0, 0), b2, voffB);
            PG8_BAR; PG8_WAIT_L(0); PG8_MMA(0, 1, At, B1); PG8_BAR;
            PG8_LDA(At, 0, 1); PG8_STAGE(PG8_SA(0, 0), a2, voffA);
            PG8_BAR; PG8_WAIT_L(0); PG8_MMA(1, 0, At, B0); PG8_BAR; PG8_SCHED;
            PG8_STAGE(PG8_SB(0, 1), b2 + hstep, voffB);
            PG8_WAIT_V(6); PG8_BAR; PG8_MMA(1, 1, At, B1); PG8_BAR;
            PG8_LDB(B0, 1, 0); PG8_SCHED; PG8_LDA(At, 1, 0); PG8_STAGE(PG8_SA(0, 1), a2 + hstep, voffA);
            PG8_WAIT_L(8); PG8_BAR; PG8_WAIT_L(0); PG8_MMA(0, 0, At, B0); PG8_BAR; PG8_SCHED;
            PG8_LDB(B1, 1, 1); PG8_STAGE(PG8_SB(1, 0), b3, voffB);
            PG8_BAR; PG8_WAIT_L(0); PG8_MMA(0, 1, At, B1); PG8_BAR;
            PG8_LDA(At, 1, 1); PG8_STAGE(PG8_SA(1, 0), a3, voffA);
            PG8_BAR; PG8_WAIT_L(0); PG8_MMA(1, 0, At, B0); PG8_BAR; PG8_SCHED;
            PG8_STAGE(PG8_SB(1, 1), b3 + hstep, voffB);
            PG8_WAIT_V(6); PG8_BAR; PG8_MMA(1, 1, At, B1); PG8_BAR;
        }
        E(acc, cur, wr, wc, fr, fq);
        if (!has_next) break;
#pragma unroll
        for (int a = 0; a < 2; ++a)
#pragma unroll
            for (int b = 0; b < 2; ++b)
#pragma unroll
                for (int m = 0; m < 4; ++m)
#pragma unroll
                    for (int n = 0; n < 2; ++n) acc[a][b][m][n] = (f32x4){0.f, 0.f, 0.f, 0.f};
        cur = nxt; cA = nA; cB = nB; ++ui;
    }
    PG8_WAIT_V(0);
    if (wr == 0) PG8_BAR;
    PG8_BAR;
#undef PG8_SA
#undef PG8_SB
#undef PG8_STAGE
#undef PG8_LDA
#undef PG8_LDB
#undef PG8_MMA
#undef PG8_WAIT_V
#undef PG8_WAIT_L
#undef PG8_BAR
#undef PG8_SCHED
}
}
using pg8::Unit;
typedef f32x4 Acc[2][2][4][2];

__device__ __forceinline__ void store_tile_bf16(const Acc& acc, const Unit& u, int wr, int wc, int fr, int fq) {
    bf16_t* base = (bf16_t*)u.out + (size_t)(wr * 64 + fr) * u.ldc + wc * 32 + 8 * fq;
#pragma unroll
    for (int ai = 0; ai < 2; ++ai)
#pragma unroll
        for (int m = 0; m < 4; ++m) {
            bf16_t* rowp = base + (size_t)(ai * 128 + m * 16) * u.ldc;
#pragma unroll
            for (int bj = 0; bj < 2; ++bj) {
                const f32x4 v0 = acc[ai][bj][m][0], v1 = acc[ai][bj][m][1];
                u32x4 w; w.x = cvt_pk_bf16(v0[0], v0[1]); w.y = cvt_pk_bf16(v0[2], v0[3]); w.z = cvt_pk_bf16(v1[0], v1[1]); w.w = cvt_pk_bf16(v1[2], v1[3]);
                *(u32x4*)(rowp + bj * 128) = w;
            }
        }
}

struct SchedProj1 {
    const char* h; const char* w; unsigned char* ws; int G, c;
    __device__ bool next(int i, Unit& u) const {
        const int L = i * G + c; int pm, pn;
        if (L < 64 * 29) pg8::rect_map(L, 64, 29, pm, pn);
        else { const int e = L - 64 * 29; if (e >= 34) return false; pm = 64 + e / 17; const int q = e % 17; pn = q < 4 ? 8 + q : (q < 16 ? 12 + q : 28); }
        const char* ha = h + (size_t)pm * 256 * DM * 2; const char* wa = w + (size_t)pn * 256 * DM * 2;
        u.A = ha; u.B = wa; u.kind = 0; u.row0 = pm * 256; u.col0 = pn * 256;
        if (pn < 8) { u.out = (char*)(ws + O_QA) + ((size_t)pm * 256 * 2048 + pn * 256) * 2; u.ldc = 2048; }
        else if (pn < 10) { u.out = (char*)(ws + O_KA) + ((size_t)pm * 256 * 512 + (pn - 8) * 256) * 2; u.ldc = 512; }
        else if (pn < 12) { u.A = wa; u.B = ha; u.out = (char*)(ws + O_VAT) + ((size_t)(pn - 10) * 256 * NROW + pm * 256) * 2; u.ldc = NROW; }
        else if (pn < 16) { u.out = (char*)(ws + O_QB) + ((size_t)pm * 256 * 1024 + (pn - 12) * 256) * 2; u.ldc = 1024; }
        else if (pn < 20) { u.out = (char*)(ws + O_KB) + ((size_t)pm * 256 * 1024 + (pn - 16) * 256) * 2; u.ldc = 1024; }
        else if (pn < 28) { u.A = wa; u.B = ha; u.out = (char*)(ws + O_VBT) + ((size_t)(pn - 20) * 256 * NROW + pm * 256) * 2; u.ldc = NROW; }
        else { u.kind = 1; u.out = (char*)(ws + O_LR) + (size_t)pm * 256 * 32 * 4; u.ldc = 32; }
        return true;
    }
};
struct EpiProj1 {
    static constexpr bool MID = false;
    __device__ __forceinline__ void mid(Acc&, const Unit&, int, int, int, int) const {}
    __device__ __forceinline__ void operator()(const Acc& acc, const Unit& u, int wr, int wc, int fr, int fq) const {
        if (u.kind == 0) { store_tile_bf16(acc, u, wr, wc, fr, fq); return; }
        if (wc == 0) {
            float* base = (float*)u.out + (size_t)(wr * 64 + fr) * 32 + 8 * fq;
#pragma unroll
            for (int ai = 0; ai < 2; ++ai)
#pragma unroll
                for (int m = 0; m < 4; ++m) { float* rowp = base + (size_t)(ai * 128 + m * 16) * 32; *(f32x4*)rowp = acc[ai][0][m][0]; *(f32x4*)(rowp + 4) = acc[ai][0][m][1]; }
        }
    }
};
struct SchedProj2 {
    const char* h; const char* w; unsigned char* ws; bf16_t* cc; int G, c;
    __device__ bool next(int i, Unit& u) const {
        const int L = i * G + c; if (L >= 64 * 24) return false; int pm, pn; pg8::rect_map(L, 64, 24, pm, pn);
        u.A = h + (size_t)pm * 256 * DM * 2; u.B = w + (size_t)pn * 256 * DM * 2; u.row0 = pm * 256; u.col0 = pn * 256;
        if (pn < 8) { u.kind = 2; u.out = (char*)(cc + (size_t)pm * 256 * 4096 + 2048 + pn * 256); u.ldc = 4096; }
        else if (pn < 16) { u.kind = 0; u.out = (char*)(ws + O_GA) + ((size_t)pm * 256 * 2048 + (pn - 8) * 256) * 2; u.ldc = 2048; }
        else { u.kind = 0; u.out = (char*)(ws + O_GA + 67108864) + ((size_t)pm * 256 * 2048 + (pn - 16) * 256) * 2; u.ldc = 2048; }
        return true;
    }
};
struct EpiProj2 {
    static constexpr bool MID = false;
    __device__ __forceinline__ void mid(Acc&, const Unit&, int, int, int, int) const {}
    __device__ __forceinline__ void operator()(const Acc& acc, const Unit& u, int wr, int wc, int fr, int fq) const {
        if (u.kind == 0) { store_tile_bf16(acc, u, wr, wc, fr, fq); return; }
        bf16_t* base = (bf16_t*)u.out + (size_t)(wr * 64 + fr) * u.ldc + wc * 32 + 8 * fq;
#pragma unroll
        for (int ai = 0; ai < 2; ++ai)
#pragma unroll
            for (int m = 0; m < 4; ++m) {
                bf16_t* rowp = base + (size_t)(ai * 128 + m * 16) * u.ldc;
#pragma unroll
                for (int bj = 0; bj < 2; ++bj) {
                    const f32x4 v0 = acc[ai][bj][m][0], v1 = acc[ai][bj][m][1];
                    float y[8]; unpack8(*(const u32x4*)(rowp + bj * 128), y);
                    y[0] *= siluf_(v0[0]); y[1] *= siluf_(v0[1]); y[2] *= siluf_(v0[2]); y[3] *= siluf_(v0[3]);
                    y[4] *= siluf_(v1[0]); y[5] *= siluf_(v1[1]); y[6] *= siluf_(v1[2]); y[7] *= siluf_(v1[3]);
                    *(u32x4*)(rowp + bj * 128) = pack8(y);
                }
            }
    }
};
struct SchedMerge {
    const char* a; const char* w; unsigned char* ws; int G, c;
    __device__ bool next(int i, Unit& u) const {
        const int L = i * G + c; if (L >= 64 * 8) return false; int pm, pn; pg8::rect_map(L, 64, 8, pm, pn);
        u.A = a + (size_t)pm * 256 * 4096 * 2; u.B = w + (size_t)pn * 256 * 4096 * 2; u.row0 = pm * 256; u.col0 = pn * 256; u.kind = 0;
        u.out = (char*)(ws + O_M) + ((size_t)pm * 256 * 2048 + pn * 256) * 2; u.ldc = 2048; return true;
    }
};
struct EpiMerge {
    static constexpr bool MID = true;
    const bf16_t* ga; const bf16_t* gb;
    __device__ __forceinline__ void mid(Acc& acc, const Unit& u, int wr, int wc, int fr, int fq) const {
        const unsigned lo = (unsigned)(((wr * 64 + fr) * 2048 + wc * 32 + 8 * fq) * 2 + opaque0());
#pragma unroll
        for (int g4 = 0; g4 < 4; ++g4) {
            u32x4 ra[4], rb[4];
#pragma unroll
            for (int c = 0; c < 4; ++c) { const int cb = g4 * 4 + c, ai = cb >> 3, m = (cb >> 1) & 3, bj = cb & 1;
                const size_t ub = ((size_t)(u.row0 + ai * 128 + m * 16) * 2048 + u.col0 + bj * 128) * 2;
                ra[c] = *(const u32x4*)((const char*)ga + ub + lo); rb[c] = *(const u32x4*)((const char*)gb + ub + lo); }
#pragma unroll
            for (int c = 0; c < 4; ++c) { const int cb = g4 * 4 + c, ai = cb >> 3, m = (cb >> 1) & 3, bj = cb & 1;
                float a[8], b[8]; unpack8(ra[c], a); unpack8(rb[c], b);
#pragma unroll
                for (int e = 0; e < 8; ++e) { const float r = (1.0f + __expf(-b[e])) * __builtin_amdgcn_rcpf(1.0f + __expf(-a[e])); acc[ai][bj][m][e >> 2][e & 3] *= r; } }
            __builtin_amdgcn_sched_barrier(0);
        }
    }
    __device__ __forceinline__ void operator()(const Acc& acc, const Unit& u, int wr, int wc, int fr, int fq) const {
        const unsigned lo = (unsigned)(((wr * 64 + fr) * 2048 + wc * 32 + 8 * fq) * 2 + opaque0());
        char* outp = (char*)u.out - ((size_t)u.row0 * 2048 + u.col0) * 2;
#pragma unroll
        for (int g4 = 0; g4 < 4; ++g4) {
            u32x4 rb[4];
#pragma unroll
            for (int c = 0; c < 4; ++c) { const int cb = g4 * 4 + c, ai = cb >> 3, m = (cb >> 1) & 3, bj = cb & 1;
                const size_t ub = ((size_t)(u.row0 + ai * 128 + m * 16) * 2048 + u.col0 + bj * 128) * 2;
                rb[c] = *(const u32x4*)((const char*)gb + ub + lo); }
#pragma unroll
            for (int c = 0; c < 4; ++c) { const int cb = g4 * 4 + c, ai = cb >> 3, m = (cb >> 1) & 3, bj = cb & 1;
                const size_t ub = ((size_t)(u.row0 + ai * 128 + m * 16) * 2048 + u.col0 + bj * 128) * 2;
                float b[8], y[8]; unpack8(rb[c], b);
#pragma unroll
                for (int e = 0; e < 8; ++e) y[e] = acc[ai][bj][m][e >> 2][e & 3] * sigmoidf_(b[e]);
                *(u32x4*)(outp + ub + lo) = pack8(y); }
            __builtin_amdgcn_sched_barrier(0);
        }
    }
};
struct SchedRes {
    const char* a; const char* w; int K, G, c;
    __device__ bool next(int i, Unit& u) const {
        const int L = i * G + c; if (L >= 64 * 8) return false; int pm, pn; pg8::rect_map(L, 64, 8, pm, pn);
        u.A = a + (size_t)pm * 256 * K * 2; u.B = w + (size_t)pn * 256 * K * 2; u.row0 = pm * 256; u.col0 = pn * 256; u.kind = 0; u.out = nullptr; u.ldc = 2048; return true;
    }
};
struct EpiRes {
    static constexpr bool MID = false;
    const float* base; float* out; const float* gate;
    __device__ __forceinline__ void mid(Acc&, const Unit&, int, int, int, int) const {}
    __device__ __forceinline__ void operator()(const Acc& acc, const Unit& u, int wr, int wc, int fr, int fq) const {
        const int col = u.col0 + wc * 32 + 8 * fq;
        const float* gp = gate + (size_t)(u.row0 >> 13) * 12288 + col;
        f32x4 g[2][2];
#pragma unroll
        for (int bj = 0; bj < 2; ++bj) { g[bj][0] = *(const f32x4*)(gp + bj * 128); g[bj][1] = *(const f32x4*)(gp + bj * 128 + 4); }
        const size_t o0 = (size_t)(u.row0 + wr * 64 + fr) * 2048 + col;
#pragma unroll
        for (int ai = 0; ai < 2; ++ai)
#pragma unroll
            for (int m = 0; m < 4; ++m)
#pragma unroll
                for (int bj = 0; bj < 2; ++bj) {
                    const size_t o = o0 + (size_t)(ai * 128 + m * 16) * 2048 + bj * 128;
                    const f32x4 x0 = *(const f32x4*)(base + o), x1 = *(const f32x4*)(base + o + 4);
                    *(f32x4*)(out + o) = x0 + g[bj][0] * acc[ai][bj][m][0];
                    *(f32x4*)(out + o + 4) = x1 + g[bj][1] * acc[ai][bj][m][1];
                }
    }
};

struct EpiDelta {
    static constexpr bool MID = false;
    bf16_t* d1; const float* gate;
    __device__ __forceinline__ void mid(Acc&, const Unit&, int, int, int, int) const {}
    __device__ __forceinline__ void operator()(const Acc& acc, const Unit& u, int wr, int wc, int fr, int fq) const {
        const int col = u.col0 + wc * 32 + 8 * fq;
        const float* gp = gate + (size_t)(u.row0 >> 13) * 12288 + col;
        f32x4 g[2][2];
#pragma unroll
        for (int bj = 0; bj < 2; ++bj) { g[bj][0] = *(const f32x4*)(gp + bj * 128); g[bj][1] = *(const f32x4*)(gp + bj * 128 + 4); }
        bf16_t* base = d1 + (size_t)(u.row0 + wr * 64 + fr) * 2048 + col;
#pragma unroll
        for (int ai = 0; ai < 2; ++ai)
#pragma unroll
            for (int m = 0; m < 4; ++m) {
                bf16_t* rowp = base + (size_t)(ai * 128 + m * 16) * 2048;
#pragma unroll
                for (int bj = 0; bj < 2; ++bj) {
                    const f32x4 v0 = g[bj][0] * acc[ai][bj][m][0], v1 = g[bj][1] * acc[ai][bj][m][1];
                    u32x4 w; w.x = cvt_pk_bf16(v0[0], v0[1]); w.y = cvt_pk_bf16(v0[2], v0[3]); w.z = cvt_pk_bf16(v1[0], v1[1]); w.w = cvt_pk_bf16(v1[2], v1[3]);
                    *(u32x4*)(rowp + bj * 128) = w;
                }
            }
    }
};
struct EpiRes2 {
    static constexpr bool MID = false;
    const float* x; const bf16_t* d1; float* out; const float* gate;
    __device__ __forceinline__ void mid(Acc&, const Unit&, int, int, int, int) const {}
    __device__ __forceinline__ void operator()(const Acc& acc, const Unit& u, int wr, int wc, int fr, int fq) const {
        const int col = u.col0 + wc * 32 + 8 * fq;
        const float* gp = gate + (size_t)(u.row0 >> 13) * 12288 + col;
        f32x4 g[2][2];
#pragma unroll
        for (int bj = 0; bj < 2; ++bj) { g[bj][0] = *(const f32x4*)(gp + bj * 128); g[bj][1] = *(const f32x4*)(gp + bj * 128 + 4); }
        const size_t o0 = (size_t)(u.row0 + wr * 64 + fr) * 2048 + col;
#pragma unroll
        for (int ai = 0; ai < 2; ++ai)
#pragma unroll
            for (int m = 0; m < 4; ++m)
#pragma unroll
                for (int bj = 0; bj < 2; ++bj) {
                    const size_t o = o0 + (size_t)(ai * 128 + m * 16) * 2048 + bj * 128;
                    const f32x4 x0 = *(const f32x4*)(x + o), x1 = *(const f32x4*)(x + o + 4);
                    float d[8]; unpack8(*(const u32x4*)(d1 + o), d);
                    *(f32x4*)(out + o) = x0 + (f32x4){d[0], d[1], d[2], d[3]} + g[bj][0] * acc[ai][bj][m][0];
                    *(f32x4*)(out + o + 4) = x1 + (f32x4){d[4], d[5], d[6], d[7]} + g[bj][1] * acc[ai][bj][m][1];
                }
    }
};
struct SchedUp {
    const char* a; const char* w; char* uo; int j0, ns, ldu, G, c;
    __device__ bool next(int i, Unit& u) const {
        const int L = i * G + c; if (L >= 64 * ns) return false; int pm, pn; pg8::rect_map(L, 64, ns, pm, pn);
        u.A = a + (size_t)pm * 256 * DM * 2; u.B = w + (size_t)(j0 + pn) * 256 * DM * 2; u.row0 = pm * 256; u.col0 = pn * 256; u.kind = 0;
        u.out = uo + ((size_t)pm * 256 * ldu + pn * 256) * 2; u.ldc = ldu; return true;
    }
};
struct EpiStore {
    static constexpr bool MID = false;
    __device__ __forceinline__ void mid(Acc&, const Unit&, int, int, int, int) const {}
    __device__ __forceinline__ void operator()(const Acc& acc, const Unit& u, int wr, int wc, int fr, int fq) const { store_tile_bf16(acc, u, wr, wc, fr, fq); }
};


__device__ __forceinline__ float dpp_ror1(float v) { return __builtin_bit_cast(float, __builtin_amdgcn_update_dpp(0, __builtin_bit_cast(int, v), 0x121, 0xF, 0xF, false)); }
__device__ __forceinline__ float dpp_rol1(float v) { return __builtin_bit_cast(float, __builtin_amdgcn_update_dpp(0, __builtin_bit_cast(int, v), 0x12F, 0xF, 0xF, false)); }
struct SchedUpC {
    const char* a; const char* w; int G, c;
    __device__ bool next(int i, Unit& u) const {
        const int L = i * G + c; if (L >= 64 * 44) return false; int pm, pn; pg8::rect_map(L, 64, 44, pm, pn);
        u.A = a + (size_t)pm * 256 * DM * 2; u.B = w + (size_t)pn * 256 * DM * 2; u.row0 = pm * 256; u.col0 = pn * 256; u.kind = 0; u.out = nullptr; u.ldc = 0; return true;
    }
};
struct EpiUpConv {
    static constexpr bool MID = false;
    const float* cw; const float* cb; bf16_t* act; float* halo; LAS unsigned char* lds;
    __device__ __forceinline__ void mid(Acc&, const Unit&, int, int, int, int) const {}
    __device__ __forceinline__ void operator()(const Acc& acc, const Unit& u, int wr, int wc, int fr, int fq) const {
        LAS float* X = (LAS float*)(lds + 131072);
        const int c8 = wc * 32 + 8 * fq, pm = u.row0 >> 8, ch = (u.col0 >> 1) + c8;
        if (fr == 0) {
#pragma unroll
            for (int ai = 0; ai < 2; ++ai)
#pragma unroll
                for (int bj = 0; bj < 2; ++bj)
#pragma unroll
                    for (int n = 0; n < 2; ++n) *(LAS f32x4*)(X + ((((ai * 2 + wr) * 2 + 0) * 2 + bj) * 128 + c8 + 4 * n)) = acc[ai][bj][0][n];
        }
        if (fr == 15) {
#pragma unroll
            for (int ai = 0; ai < 2; ++ai)
#pragma unroll
                for (int bj = 0; bj < 2; ++bj)
#pragma unroll
                    for (int n = 0; n < 2; ++n) *(LAS f32x4*)(X + ((((ai * 2 + wr) * 2 + 1) * 2 + bj) * 128 + c8 + 4 * n)) = acc[ai][bj][3][n];
        }
        asm volatile("s_waitcnt lgkmcnt(0)" ::: "memory"); __builtin_amdgcn_s_barrier(); asm volatile("" ::: "memory"); __builtin_amdgcn_s_barrier(); asm volatile("" ::: "memory");
#pragma unroll
        for (int n = 0; n < 2; ++n) {
            const int chn = ch + 4 * n;
            f32x4 w[3][2], bb[2];
#pragma unroll
            for (int j = 0; j < 3; ++j)
#pragma unroll
                for (int bj = 0; bj < 2; ++bj) w[j][bj] = *(const f32x4*)(cw + j * 11264 + bj * 5632 + chn);
#pragma unroll
            for (int bj = 0; bj < 2; ++bj) bb[bj] = *(const f32x4*)(cb + bj * 5632 + chn);
#pragma unroll
            for (int ai = 0; ai < 2; ++ai) {
                const int g = ai * 2 + wr, gp = g > 0 ? g - 1 : 0, gn = g < 3 ? g + 1 : 3;
                f32x4 upb[2], dnb[2];
#pragma unroll
                for (int bj = 0; bj < 2; ++bj) { upb[bj] = *(const LAS f32x4*)(X + (((gp * 2 + 1) * 2 + bj) * 128 + c8 + 4 * n)); dnb[bj] = *(const LAS f32x4*)(X + (((gn * 2 + 0) * 2 + bj) * 128 + c8 + 4 * n)); }
#pragma unroll
                for (int m = 0; m < 4; ++m) {
                    const int r = 128 * ai + 64 * wr + 16 * m + fr;
                    const bool first = r == 0, last = r == 255;
                    f32x4 pre[2];
#pragma unroll
                    for (int bj = 0; bj < 2; ++bj)
#pragma unroll
                        for (int j = 0; j < 4; ++j) {
                            const float cur = acc[ai][bj][m][n][j];
                            const float ur = dpp_ror1(cur), dr = dpp_rol1(cur);
                            const float ue = m > 0 ? dpp_ror1(acc[ai][bj][m > 0 ? m - 1 : 0][n][j]) : upb[bj][j];
                            const float de = m < 3 ? dpp_rol1(acc[ai][bj][m < 3 ? m + 1 : 3][n][j]) : dnb[bj][j];
                            float up = fr == 0 ? ue : ur, dn = fr == 15 ? de : dr;
                            if (first) up = 0.f; if (last) dn = 0.f;
                            pre[bj][j] = w[0][bj][j] * up + w[1][bj][j] * cur + w[2][bj][j] * dn + bb[bj][j];
                        }
                    if (first || last) {
                        float* hp = halo + ((size_t)(pm * 4 + (last ? 1 : 0)) * 2) * 5632 + chn;
#pragma unroll
                        for (int bj = 0; bj < 2; ++bj) { *(f32x4*)(hp + bj * 5632) = acc[ai][bj][m][n]; *(f32x4*)(hp + (size_t)4 * 5632 + bj * 5632) = pre[bj]; }
                    } else {
                        u32x2 pk; pk.x = cvt_pk_bf16(siluf_(pre[0][0]) * pre[1][0], siluf_(pre[0][1]) * pre[1][1]); pk.y = cvt_pk_bf16(siluf_(pre[0][2]) * pre[1][2], siluf_(pre[0][3]) * pre[1][3]);
                        *(u32x2*)(act + (size_t)(u.row0 + r) * 5632 + chn) = pk;
                    }
                    __builtin_amdgcn_sched_barrier(0);
                }
            }
        }
    }
};
__device__ void phase_convfix(const P& p, const float* halo, bf16_t* act) {
    for (int i = blockIdx.x * 512 + threadIdx.x + opaque0(); i < 64 * 2 * 5632; i += gridDim.x * 512) {
        const int ch = i % 5632, pe = i / 5632, e = pe & 1, pm = pe >> 1;
        float pa = halo[((size_t)(pm * 4 + 2 + e) * 2 + 0) * 5632 + ch], pg = halo[((size_t)(pm * 4 + 2 + e) * 2 + 1) * 5632 + ch];
        if (e == 0 && (pm & 31) > 0) { pa += p.conv_w[ch] * halo[((size_t)((pm - 1) * 4 + 1) * 2 + 0) * 5632 + ch]; pg += p.conv_w[5632 + ch] * halo[((size_t)((pm - 1) * 4 + 1) * 2 + 1) * 5632 + ch]; }
        if (e == 1 && (pm & 31) < 31) { pa += p.conv_w[2 * 11264 + ch] * halo[((size_t)((pm + 1) * 4 + 0) * 2 + 0) * 5632 + ch]; pg += p.conv_w[2 * 11264 + 5632 + ch] * halo[((size_t)((pm + 1) * 4 + 0) * 2 + 1) * 5632 + ch]; }
        act[(size_t)(pm * 256 + (e ? 255 : 0)) * 5632 + ch] = f2bf(siluf_(pa) * pg);
    }
}

__device__ __forceinline__ int srccol(int kind, int n) {
    if (kind == 0) return n;
    if (kind == 1) return n < 7168 ? n : (n < 7200 ? n + 2048 : -1);
    if (kind == 2) return n < 2048 ? 7168 + n : 9248 + (n - 2048);
    const int j = n >> 8, i = n & 255; return i < 128 ? 128 * j + i : 5632 + 128 * j + (i - 128);
}
struct TJob { const float* src; int ld_src; bf16_t* dst; int ld_dst; int k0; int n0; int kind; int koff; };
__device__ __forceinline__ void tj_load(const TJob& j, int tid, f32x4 (&v)[8]) {
    const int kr = tid >> 6, nq = (tid & 63) * 4; const int sc = srccol(j.kind, j.n0 + nq);
#pragma unroll
    for (int pass = 0; pass < 8; ++pass) { v[pass] = (f32x4){0.f, 0.f, 0.f, 0.f}; if (sc >= 0) v[pass] = *(const f32x4*)(j.src + (size_t)(j.k0 + kr + 8 * pass) * j.ld_src + sc); }
}
__device__ __forceinline__ void tj_store(LAS float* tl, const TJob& j, int tid, const f32x4 (&v)[8]) {
    { const int kr = tid >> 6, nq = (tid & 63) * 4;
#pragma unroll
      for (int pass = 0; pass < 8; ++pass) { const int k = kr + 8 * pass;
          tl[(nq + 0) * 65 + k] = v[pass][0]; tl[(nq + 1) * 65 + k] = v[pass][1]; tl[(nq + 2) * 65 + k] = v[pass][2]; tl[(nq + 3) * 65 + k] = v[pass][3]; } }
}
__device__ __forceinline__ void tj_flush(LAS float* tl, const TJob& j, int tid) {
    const int nr = tid >> 3, kc = (tid & 7) * 8;
#pragma unroll
    for (int pass = 0; pass < 4; ++pass) { const int n = nr + 64 * pass; float f[8];
#pragma unroll
        for (int e = 0; e < 8; ++e) f[e] = tl[n * 65 + kc + e];
        *(u32x4*)(j.dst + (size_t)(j.n0 + n) * j.ld_dst + j.koff + j.k0 + kc) = pack8(f); }
}
__device__ __forceinline__ TJob tj_make(const float* src, int ld_src, bf16_t* dst, int ld_dst, int N, int kind, int koff, int it) {
    const int nnt = N / 256; TJob j; j.src = src; j.ld_src = ld_src; j.dst = dst; j.ld_dst = ld_dst; j.k0 = (it / nnt) * 64; j.n0 = (it % nnt) * 256; j.kind = kind; j.koff = koff; return j;
}
__device__ void phase0(LAS unsigned char* lds, const P& p) {
    LAS float* tl = (LAS float*)lds;
    unsigned char* ws = p.ws;
    const int nb = gridDim.x, bid = blockIdx.x, tid = threadIdx.x + opaque0();
    for (int it = bid; it < 256; it += nb) {
        const int kc = it >> 3, nch = it & 7; float a[3][3];
#pragma unroll
        for (int v = 0; v < 3; ++v)
#pragma unroll
            for (int j = 0; j < 3; ++j) a[v][j] = 0.f;
#pragma unroll 16
        for (int k = kc * 64; k < kc * 64 + 64; ++k) {
            const float s0 = siluf_(p.c[k]), s1 = siluf_(p.c[2048 + k]), s2 = siluf_(p.c_ctx[k]);
            const float* wr = p.w_mod + (size_t)k * 12288 + nch * 1536 + tid;
#pragma unroll
            for (int j = 0; j < 3; ++j) { const float w = wr[j * 512]; a[0][j] += s0 * w; a[1][j] += s1 * w; a[2][j] += s2 * w; }
        }
        float* mp = (float*)(ws + O_MODP) + (size_t)kc * 3 * 12288 + nch * 1536 + tid;
#pragma unroll
        for (int v = 0; v < 3; ++v)
#pragma unroll
            for (int j = 0; j < 3; ++j) mp[(size_t)v * 12288 + j * 512] = a[v][j];
    }
    for (int i = bid * 512 + tid; i < 128 * 32; i += nb * 512) {
        const int pos = i >> 5, f = i & 31;
        const float inv = exp2f(-(float)f * (13.287712379549449f / 32.0f));
        const float ang = (float)pos * inv;
        const double ad = (double)ang; const double n = rint(ad * 0.15915494309189535); double r = ad - n * 6.283185307179586476925;
        r *= 0.125; const double r2 = r * r;
        double s = r * (1.0 + r2 * (-1.0 / 6 + r2 * (1.0 / 120 + r2 * (-1.0 / 5040 + r2 * (1.0 / 362880 + r2 * (-1.0 / 39916800))))));
        double c = 1.0 + r2 * (-0.5 + r2 * (1.0 / 24 + r2 * (-1.0 / 720 + r2 * (1.0 / 40320 + r2 * (-1.0 / 3628800 + r2 * (1.0 / 479001600))))));
#pragma unroll
        for (int q = 0; q < 3; ++q) { const double s2 = 2.0 * s * c, c2 = c * c - s * s; s = s2; c = c2; }
        ((f32x2*)(ws + O_ROPE))[i] = (f32x2){(float)c, (float)s};
    }
    const int J0 = 32 * 29, J1 = 32 * 24, J2 = 256, J3 = 256, J4 = 256;
    auto job0 = [&](int it) -> TJob {
        int q = it;
        if (q < J0) return tj_make(p.w_in, 13344, (bf16_t*)(ws + O_XR), 2048, 7424, 1, 0, q); q -= J0;
        if (q < J1) return tj_make(p.w_in, 13344, (bf16_t*)(ws + O_W2IN), 2048, 6144, 2, 0, q); q -= J1;
        if (q < J2) return tj_make(p.w_attn_o, 2048, (bf16_t*)(ws + O_WMRG), 4096, 2048, 0, 0, q); q -= J2;
        if (q < J3) return tj_make(p.w_gla_o, 2048, (bf16_t*)(ws + O_WMRG), 4096, 2048, 0, 2048, q); q -= J3;
        return tj_make(p.w_out, 2048, (bf16_t*)(ws + O_WOUT), 2048, 2048, 0, 0, q);
    };
    { const int JT = J0 + J1 + J2 + J3 + J4; int it = bid; f32x4 v[8]; TJob cur;
      if (it < JT) { cur = job0(it); tj_load(cur, tid, v); }
      while (it < JT) {
          LDS_BARRIER(); tj_store(tl, cur, tid, v);
          const int itn = it + nb; TJob nxt = cur; if (itn < JT) { nxt = job0(itn); tj_load(nxt, tid, v); }
          LDS_BARRIER(); tj_flush(tl, cur, tid);
          cur = nxt; it = itn; } }
}
__device__ void phase_modreduce(const P& p) {
    const float* mp = (const float*)(p.ws + O_MODP); float* mod = (float*)(p.ws + O_MOD);
    for (int i = blockIdx.x * 512 + threadIdx.x; i < 3 * 12288; i += gridDim.x * 512) {
        float s = p.b_mod[i % 12288];
#pragma unroll
        for (int kc = 0; kc < 32; ++kc) s += mp[(size_t)kc * 3 * 12288 + i];
        mod[i] = s;
    }
}
__device__ void phase_modulate(const float* xlat, const float* xctx, const float* g, const float* mod, int sh, int sc, bf16_t* h, int nrows) {
    const int tix = threadIdx.x + opaque0(); const int lane = tix & 63, gw = blockIdx.x * 8 + (tix >> 6), nw = gridDim.x * 8;
    for (int r = gw; r < nrows; r += nw) {
        const float* xr = r < NTOK ? xlat + (size_t)r * DM : xctx + (size_t)(r - NTOK) * DM;
        const float* mv = mod + (size_t)(r < NTOK ? (r >> 13) : 2) * 12288;
        f32x4 v[8]; float ss = 0.f;
#pragma unroll
        for (int i = 0; i < 8; ++i) { v[i] = *(const f32x4*)(xr + (i * 64 + lane) * 4); ss += v[i][0] * v[i][0] + v[i][1] * v[i][1] + v[i][2] * v[i][2] + v[i][3] * v[i][3]; }
        ss = wave_sum(ss); const float rs = rsqrtf(ss * (1.0f / DM) + EPS_);
#pragma unroll
        for (int i = 0; i < 8; ++i) { const int cidx = (i * 64 + lane) * 4;
            const f32x4 gg = *(const f32x4*)(g + cidx), s1 = *(const f32x4*)(mv + sc * 2048 + cidx), s0 = *(const f32x4*)(mv + sh * 2048 + cidx);
            const f32x4 y = v[i] * rs * gg * (s1 + 1.0f) + s0;
            u32x2 w; w.x = cvt_pk_bf16(y[0], y[1]); w.y = cvt_pk_bf16(y[2], y[3]); *(u32x2*)(h + (size_t)r * DM + cidx) = w; }
    }
}


__device__ void phase_modulate2(const float* x, const bf16_t* d1, const float* g, const float* mod, int sh, int sc, bf16_t* h) {
    const int tix = threadIdx.x + opaque0(); const int lane = tix & 63, gw = blockIdx.x * 8 + (tix >> 6), nw = gridDim.x * 8;
    for (int r = gw; r < NTOK; r += nw) {
        const float* xr = x + (size_t)r * DM; const bf16_t* dr = d1 + (size_t)r * DM;
        const float* mv = mod + (size_t)(r >> 13) * 12288;
        f32x4 v[8]; float ss = 0.f;
#pragma unroll
        for (int i = 0; i < 8; ++i) { const int cidx = (i * 64 + lane) * 4; v[i] = *(const f32x4*)(xr + cidx); const u32x2 dd = *(const u32x2*)(dr + cidx);
            v[i][0] += bflo(dd.x); v[i][1] += bfhi(dd.x); v[i][2] += bflo(dd.y); v[i][3] += bfhi(dd.y);
            ss += v[i][0] * v[i][0] + v[i][1] * v[i][1] + v[i][2] * v[i][2] + v[i][3] * v[i][3]; }
        ss = wave_sum(ss); const float rs = rsqrtf(ss * (1.0f / DM) + EPS_);
#pragma unroll
        for (int i = 0; i < 8; ++i) { const int cidx = (i * 64 + lane) * 4;
            const f32x4 gg = *(const f32x4*)(g + cidx), s1 = *(const f32x4*)(mv + sc * 2048 + cidx), s0 = *(const f32x4*)(mv + sh * 2048 + cidx);
            const f32x4 y = v[i] * rs * gg * (s1 + 1.0f) + s0;
            u32x2 w; w.x = cvt_pk_bf16(y[0], y[1]); w.y = cvt_pk_bf16(y[2], y[3]); *(u32x2*)(h + (size_t)r * DM + cidx) = w; }
    }
}
__device__ void phase_kprep(const P& p) {
    const int tix = threadIdx.x + opaque0(); const int lane = tix & 63, gw = blockIdx.x * 8 + (tix >> 6), nw = gridDim.x * 8;
    bf16_t* KA = (bf16_t*)(p.ws + O_KA); const f32x2* tab = (const f32x2*)(p.ws + O_ROPE);
    const float w0 = p.k_norm[lane], w1 = p.k_norm[64 + lane];
    for (int r0 = gw * 2; r0 < NROW; r0 += nw * 2) {
        float x1[8], x2[8];
#pragma unroll
        for (int q = 0; q < 8; ++q) { const bf16_t* kp = KA + (size_t)(r0 + (q >> 2)) * 512 + (q & 3) * 128 + lane; x1[q] = bf2f(kp[0]); x2[q] = bf2f(kp[64]); }
#pragma unroll
        for (int q = 0; q < 8; ++q) {
            const int r = r0 + (q >> 2); bf16_t* kp = KA + (size_t)r * 512 + (q & 3) * 128 + lane;
            const float ss = wave_sum(x1[q] * x1[q] + x2[q] * x2[q]); const float rs = rsqrtf(ss * (1.0f / 128) + EPS_);
            float a1 = x1[q] * rs * w0, a2 = x2[q] * rs * w1;
            if (r < NTOK) { const int t = r & (T_ - 1); const int pos = lane < 32 ? (t >> 6) : (t & 63); const f32x2 cs = tab[pos * 32 + (lane & 31)];
                const float y1 = a1 * cs.x - a2 * cs.y, y2 = a2 * cs.x + a1 * cs.y; a1 = y1; a2 = y2; }
            kp[0] = f2bf(a1); kp[64] = f2bf(a2);
        }
    }
}
__device__ __forceinline__ void normrope8x4(float (&y)[4][8], const float* nw, int dofs, float rs, bool rope, int t, const f32x2* tab) {
#pragma unroll
    for (int s = 0; s < 4; ++s) { const f32x4 w0 = *(const f32x4*)(nw + s * 32 + dofs), w1 = *(const f32x4*)(nw + s * 32 + dofs + 4);
#pragma unroll
        for (int e = 0; e < 4; ++e) { y[s][e] *= rs * w0[e]; y[s][4 + e] *= rs * w1[e]; } }
    if (rope) {
#pragma unroll
        for (int s = 0; s < 2; ++s) { const int pos = s == 0 ? (t >> 6) : (t & 63); const f32x2* tp = tab + pos * 32 + dofs;
#pragma unroll
            for (int e = 0; e < 8; ++e) { const f32x2 cs = tp[e]; const float x1 = y[s][e], x2 = y[s + 2][e]; y[s][e] = x1 * cs.x - x2 * cs.y; y[s + 2][e] = x2 * cs.x + x1 * cs.y; } }
    }
}
__device__ void attn_item(LAS unsigned char* lds, const P& p, bf16_t* cc, int item) {
    const int tid = threadIdx.x + opaque0(), w = __builtin_amdgcn_readfirstlane(tid >> 6), lane = tid & 63, fr = lane & 15, fq = lane >> 4;
    const int pair = item & 1, kvh = (item >> 1) & 3, qb = (item >> 3) & 63, b = item >> 9;
    LAS bf16_t* KV0 = (LAS bf16_t*)lds;
    const bf16_t* QA = (const bf16_t*)(p.ws + O_QA); const bf16_t* KA = (const bf16_t*)(p.ws + O_KA); const bf16_t* VAT = (const bf16_t*)(p.ws + O_VAT);
    const f32x2* tab = (const f32x2*)(p.ws + O_ROPE);
    const int hq = kvh * 4 + pair * 2 + (w >> 2), rc = w & 3, qrow0 = qb * 128 + rc * 32;
    const float SC = 0.08838834764831845f * 1.4426950408889634f;
    bf16x8 qf[2][4];
#pragma unroll
    for (int mt = 0; mt < 2; ++mt) {
        const int t = qrow0 + mt * 16 + fr; const bf16_t* src = QA + (size_t)(b * T_ + t) * 2048 + hq * 128 + fq * 8;
        float y[4][8]; float ss = 0.f;
#pragma unroll
        for (int s = 0; s < 4; ++s) { unpack8(*(const u32x4*)(src + s * 32), y[s]);
#pragma unroll
            for (int e = 0; e < 8; ++e) ss += y[s][e] * y[s][e]; }
        ss += __shfl_xor(ss, 16); ss += __shfl_xor(ss, 32);
        const float rs = rsqrtf(ss * (1.0f / 128) + EPS_);
        normrope8x4(y, p.q_norm, fq * 8, rs, true, t, tab);
#pragma unroll
        for (int s = 0; s < 4; ++s) {
#pragma unroll
            for (int e = 0; e < 8; ++e) y[s][e] *= SC;
            const u32x4 pk = pack8(y[s]); qf[mt][s] = *(const bf16x8*)&pk; }
    }
    f32x4 o[2][8];
#pragma unroll
    for (int mt = 0; mt < 2; ++mt)
#pragma unroll
        for (int n = 0; n < 8; ++n) o[mt][n] = (f32x4){0.f, 0.f, 0.f, 0.f};
    float mrun[2], lrun[2];
    { const float sk = p.sink[hq] * 1.4426950408889634f; mrun[0] = sk; mrun[1] = sk; lrun[0] = fq == 0 ? 1.0f : 0.0f; lrun[1] = lrun[0]; }
#define AT_TOKBASE(jj_) ((jj_) < 3 ? b * T_ + (qb - 1 + (jj_)) * 128 : NTOK + b * 256 + ((jj_) - 3) * 128)
#define AT_NEXT(jj_) (((jj_) + 1 == 2 && qb == 63) ? 3 : (jj_) + 1)
#define AT_STAGE(jj_, buf_) do { const int tb_ = AT_TOKBASE(jj_); const int key = tid >> 2, part = tid & 3; \
        LAS bf16_t* kd_ = KV0 + (buf_) * (2 * 128 * 136); LAS bf16_t* vd_ = kd_ + 128 * 136; \
        const bf16_t* src = KA + (size_t)(tb_ + key) * 512 + kvh * 128 + part * 8; const bf16_t* vsrc = VAT + (size_t)(kvh * 128 + key) * NROW + tb_ + part * 8; \
        u32x4 rk_[4], rv_[4]; \
        _Pragma("unroll") for (int s = 0; s < 4; ++s) { rk_[s] = *(const u32x4*)(src + s * 32); rv_[s] = *(const u32x4*)(vsrc + s * 32); } \
        _Pragma("unroll") for (int s = 0; s < 4; ++s) { *(LAS u32x4*)(kd_ + key * 136 + s * 32 + part * 8) = rk_[s]; *(LAS u32x4*)(vd_ + key * 136 + s * 32 + part * 8) = rv_[s]; } } while (0)
    int jn = qb == 0 ? 1 : 0, cur = 0;
    LDS_BARRIER();
    AT_STAGE(jn, 0);
    LDS_BARRIER();
    while (jn < 5) {
        const int jj = jn; jn = AT_NEXT(jj);
        const int mtype = jj == 0 ? 1 : (jj == 2 ? 2 : 0);
        const int mlo = mtype == 1 ? 0 : -100000, mhi = mtype == 2 ? 0 : 100000;
        const int dl = fq * 4 - rc * 32 - fr + opaque0();
        if (jn < 5) AT_STAGE(jn, cur ^ 1);
        LAS bf16_t* Ks = KV0 + cur * (2 * 128 * 136); LAS bf16_t* Vs = Ks + 128 * 136;
        u32x2 pk[2][8];
#pragma unroll
        for (int mt = 0; mt < 2; ++mt) {
            f32x4 sacc[8];
#pragma unroll
            for (int n = 0; n < 8; ++n) sacc[n] = (f32x4){0.f, 0.f, 0.f, 0.f};
#pragma unroll
            for (int s = 0; s < 4; ++s) {
#pragma unroll
                for (int n = 0; n < 8; ++n) { const bf16x8 kf = *(const LAS bf16x8*)(Ks + (n * 16 + fr) * 136 + s * 32 + fq * 8); sacc[n] = MFMA16(kf, qf[mt][s], sacc[n]); }
                __builtin_amdgcn_sched_barrier(0); }
            float mx = -INFINITY;
            if (mtype != 0) {
#pragma unroll
                for (int n = 0; n < 8; ++n)
#pragma unroll
                    for (int j = 0; j < 4; ++j) { const int dkq = dl + (n * 16 + j - mt * 16); if (dkq < mlo || dkq > mhi) sacc[n][j] = -INFINITY; }
            }
#pragma unroll
            for (int n = 0; n < 8; ++n)
#pragma unroll
                for (int j = 0; j < 4; ++j) mx = fmaxf(mx, sacc[n][j]);
            mx = fmaxf(mx, __shfl_xor(mx, 16)); mx = fmaxf(mx, __shfl_xor(mx, 32));
            const float mn = fmaxf(mrun[mt], mx), al = __builtin_amdgcn_exp2f(mrun[mt] - mn); mrun[mt] = mn;
            if (__any(al != 1.0f)) {
#pragma unroll
                for (int n = 0; n < 8; ++n) o[mt][n] *= al;
            }
            f32x4 ps4 = (f32x4){0.f, 0.f, 0.f, 0.f};
#pragma unroll
            for (int n = 0; n < 8; ++n) { const f32x4 d4 = sacc[n] - mn; f32x4 pv;
#pragma unroll
                for (int j = 0; j < 4; ++j) pv[j] = __builtin_amdgcn_exp2f(d4[j]);
                ps4 += pv;
                pk[mt][n].x = cvt_pk_bf16(pv[0], pv[1]); pk[mt][n].y = cvt_pk_bf16(pv[2], pv[3]); }
            const float ps = (ps4[0] + ps4[1]) + (ps4[2] + ps4[3]);
            lrun[mt] = lrun[mt] * al + ps;
            __builtin_amdgcn_sched_barrier(0);
        }
#pragma unroll
        for (int s = 0; s < 4; ++s) {
            const u32x4 pq0 = (u32x4){pk[0][2 * s].x, pk[0][2 * s].y, pk[0][2 * s + 1].x, pk[0][2 * s + 1].y}, pq1 = (u32x4){pk[1][2 * s].x, pk[1][2 * s].y, pk[1][2 * s + 1].x, pk[1][2 * s + 1].y};
            const bf16x8 p0 = __builtin_bit_cast(bf16x8, pq0), p1 = __builtin_bit_cast(bf16x8, pq1);
#pragma unroll
            for (int n = 0; n < 8; ++n) {
                const u32x2 v0 = *(const LAS u32x2*)(Vs + (n * 16 + fr) * 136 + s * 32 + fq * 4), v1 = *(const LAS u32x2*)(Vs + (n * 16 + fr) * 136 + s * 32 + 16 + fq * 4);
                const u32x4 vq = (u32x4){v0.x, v0.y, v1.x, v1.y}; const bf16x8 vf = __builtin_bit_cast(bf16x8, vq);
                o[0][n] = MFMA16(vf, p0, o[0][n]); o[1][n] = MFMA16(vf, p1, o[1][n]); }
            __builtin_amdgcn_sched_barrier(0);
        }
        LDS_BARRIER();
        cur ^= 1;
    }
#undef AT_TOKBASE
#undef AT_NEXT
#undef AT_STAGE
#pragma unroll
    for (int mt = 0; mt < 2; ++mt) {
        float l = lrun[mt]; l += __shfl_xor(l, 16); l += __shfl_xor(l, 32);
        const float inv = 1.0f / l; bf16_t* dst = cc + (size_t)(b * T_ + qrow0 + mt * 16 + fr) * 4096 + hq * 128 + fq * 4;
#pragma unroll
        for (int n = 0; n < 8; ++n) { u32x2 pk; pk.x = cvt_pk_bf16(o[mt][n][0] * inv, o[mt][n][1] * inv); pk.y = cvt_pk_bf16(o[mt][n][2] * inv, o[mt][n][3] * inv); *(u32x2*)(dst + n * 16) = pk; }
    }
}

__device__ void glaprep_item(LAS unsigned char* lds, const P& p, int item) {
    const int tid = threadIdx.x + opaque0(), w = __builtin_amdgcn_readfirstlane(tid >> 6), lane = tid & 63, fr = lane & 15, fq = lane >> 4;
    const int ck = item % 66, h = (item / 66) & 3, b = item / 264;
    const bool lat = ck < 64; const int r0 = lat ? b * T_ + ck * 128 : NTOK + b * 256 + (ck - 64) * 128;
    LAS bf16_t* Qs = (LAS bf16_t*)lds; LAS bf16_t* Ks = Qs + 128 * 264; LAS float* lrs = (LAS float*)(lds + 2 * 128 * 264 * 2); LAS float* seg = lrs + 128 * 32;
    unsigned char* ws = p.ws;
    bf16_t* QB = (bf16_t*)(ws + O_QB); bf16_t* QF = (bf16_t*)(ws + O_QF); const bf16_t* KB = (const bf16_t*)(ws + O_KB);
    __syncthreads();
    { const f32x4* src = (const f32x4*)((const float*)(ws + O_LR) + (size_t)r0 * 32); ((LAS f32x4*)lrs)[tid] = src[tid]; ((LAS f32x4*)lrs)[tid + 512] = src[tid + 512]; }
    const int half = tid >> 8, d = tid & 255, gc = h * 256 + d;
    for (int dir = 0; dir < 2; ++dir) {
        const int chain = dir * 8 + b * 4 + h;
        const float* wg = dir == 0 ? p.wgf : p.wgb; const float bias = (dir == 0 ? p.bgf : p.bgb)[gc];
        float wv[16];
#pragma unroll
        for (int j = 0; j < 16; ++j) wv[j] = wg[j * 1024 + gc];
        __syncthreads();
        float carry = 0.f;
        bf16_t* qdst = dir == 0 ? QF : QB;
#pragma unroll 1
        for (int rnd = 0; rnd < 2; ++rnd) {
            float bl[32]; float run = 0.f;
            const int ibase = rnd * 64 + half * 32;
            unsigned short kraw[32], qraw[32];
#pragma unroll
            for (int ii = 0; ii < 32; ++ii) { const int i = ibase + ii, tok = dir == 0 ? i : 127 - i; const size_t gi = (size_t)(r0 + tok) * 1024 + gc;
                kraw[ii] = KB[gi]; qraw[ii] = lat ? QB[gi] : (unsigned short)0; }
#pragma unroll
            for (int ii = 0; ii < 32; ++ii) {
                const int i = ibase + ii, tok = dir == 0 ? i : 127 - i;
                const LAS f32x4* lp = (const LAS f32x4*)(lrs + tok * 32 + dir * 16);
                f32x2 x2 = (f32x2){bias, 0.f};
#pragma unroll
                for (int q = 0; q < 4; ++q) { const f32x4 l4 = lp[q];
                    x2 = __builtin_elementwise_fma((f32x2){l4[0], l4[1]}, (f32x2){wv[q * 4], wv[q * 4 + 1]}, x2);
                    x2 = __builtin_elementwise_fma((f32x2){l4[2], l4[3]}, (f32x2){wv[q * 4 + 2], wv[q * 4 + 3]}, x2); }
                const float xg = x2.x + x2.y;
                const float ls = fminf(xg, 0.f) - __logf(1.0f + __expf(-fabsf(xg)));
                run += ls * 0.0625f; bl[ii] = run;
            }
            __syncthreads();
            seg[half * 256 + d] = run;
            __syncthreads();
            const float s0 = seg[d], s1 = seg[256 + d];
            const float off = carry + (half == 1 ? s0 : 0.f);
            carry += s0 + s1;
#pragma unroll
            for (int ii = 0; ii < 32; ++ii) {
                const int i = ibase + ii, tok = dir == 0 ? i : 127 - i;
                const float bb = bl[ii] + off; const float eb = __expf(bb), ieb = __expf(-bb);
                Ks[tok * 264 + d] = f2bf(bf2f(kraw[ii]) * ieb);
                if (lat) { const bf16_t qv = f2bf(bf2f(qraw[ii]) * 0.0625f * eb); Qs[tok * 264 + d] = qv; }
            }
        }
        if (half == 1) ((float*)(ws + O_DD))[((size_t)chain * 66 + ck) * 256 + d] = __expf(carry);
        __syncthreads();
        if (lat) {
            f32x4 a[8];
#pragma unroll
            for (int n = 0; n < 8; ++n) a[n] = (f32x4){0.f, 0.f, 0.f, 0.f};
#pragma unroll
            for (int s = 0; s < 8; ++s) { const bf16x8 qfr = *(const LAS bf16x8*)(Qs + (16 * w + fr) * 264 + s * 32 + fq * 8);
#pragma unroll
                for (int n = 0; n < 8; ++n) { const bf16x8 kfr = *(const LAS bf16x8*)(Ks + (n * 16 + fr) * 264 + s * 32 + fq * 8); a[n] = MFMA16(kfr, qfr, a[n]); }
                __builtin_amdgcn_sched_barrier(0); }
            bf16_t* ab = (bf16_t*)(ws + O_XR) + (size_t)(chain * 64 + ck) * 16384;
            {
#pragma unroll
                for (int it = 0; it < 8; ++it) { const int idx = it * 512 + tid, f = idx >> 6, L = idx & 63;
                    const u32x4 v = *(const LAS u32x4*)(Qs + (16 * (f >> 3) + (L & 15)) * 264 + (f & 7) * 32 + (L >> 4) * 8);
                    *(u32x4*)(qdst + (size_t)(r0 + 2 * f + (L >> 5)) * 1024 + h * 256 + (L & 31) * 8) = v; }
            }
            const int cmr = (fq * 4 - 16 * w - fr + opaque0()) * (dir == 0 ? 1 : -1);
#pragma unroll
            for (int n = 0; n < 8; ++n) { float v[4];
#pragma unroll
                for (int j = 0; j < 4; ++j) { const int dcr = cmr + (dir == 0 ? (n * 16 + j) : -(n * 16 + j)); v[j] = dcr <= 0 ? a[n][j] : 0.f; }
                u32x2 pk; pk.x = cvt_pk_bf16(v[0], v[1]); pk.y = cvt_pk_bf16(v[2], v[3]);
                *(u32x2*)(ab + ((w * 4 + (n >> 1)) * 64 + ((n & 1) * 2 + (fq >> 1)) * 16 + fr) * 8 + (fq & 1) * 4) = pk; }
        }
        {
            bf16_t* kt = (bf16_t*)(ws + O_KT) + ((size_t)(chain * 66 + ck)) * 32768 + ((size_t)((d >> 5) * 2 + ((d >> 4) & 1)) * 4 * 64 + (d & 15)) * 8;
#pragma unroll
            for (int it = 0; it < 8; ++it) { const int tc = it * 2 + half; unsigned short e[8];
#pragma unroll
                for (int q = 0; q < 8; ++q) e[q] = Ks[(tc * 8 + q) * 264 + d];
                u32x4 pk; pk.x = e[0] | ((unsigned)e[1] << 16); pk.y = e[2] | ((unsigned)e[3] << 16); pk.z = e[4] | ((unsigned)e[5] << 16); pk.w = e[6] | ((unsigned)e[7] << 16);
                *(u32x4*)(kt + ((tc >> 2) * 64 + (tc & 3) * 16) * 8) = pk; }
        }
    }
}

__device__ void glaseq_item(LAS unsigned char* lds, const P& p, int item) {
    const int tid = threadIdx.x + opaque0(), w = __builtin_amdgcn_readfirstlane(tid >> 6), lane = tid & 63, fr = lane & 15, fq = lane >> 4;
    const int chain = item & 15, sl = item >> 4, dir = chain >> 3, b = (chain >> 2) & 1, h = chain & 3;
    unsigned char* ws = p.ws;
    LAS bf16_t* Ss = (LAS bf16_t*)lds;
    const bf16_t* VBT = (const bf16_t*)(ws + O_VBT) + (size_t)(h * 512 + sl * 32 + fr) * NROW + fq * 8;
    const bf16_t* KT = (const bf16_t*)(ws + O_KT) + (size_t)chain * 66 * 32768 + ((size_t)w * 2 * 4 * 64 + lane) * 8;
    const bf16_t* QT = (const bf16_t*)(ws + (dir == 0 ? O_QF : O_QB));
    const bf16_t* AB = (const bf16_t*)(ws + O_XR) + (size_t)chain * 64 * 128 * 128;
    const float* DD = (const float*)(ws + O_DD) + (size_t)chain * 66 * 256 + 32 * w + fq * 4;
    bf16_t* OB = (bf16_t*)(ws + O_OF) + (size_t)dir * NTOK * 2048;
    f32x4 st[2][2];
#pragma unroll
    for (int t = 0; t < 2; ++t)
#pragma unroll
        for (int n = 0; n < 2; ++n) st[t][n] = (f32x4){0.f, 0.f, 0.f, 0.f};
#define GS_CK(s_) (dir == 0 ? ((s_) < 2 ? 64 + (s_) : (s_) - 2) : 65 - (s_))
#define GS_R0(s_, ck_) ((s_) >= 2 ? b * T_ + (ck_) * 128 : NTOK + b * 256 + ((ck_) - 64) * 128)
#define GS_LOADK(KF, DDv, s_) do { const int ck_ = GS_CK(s_); \
        _Pragma("unroll") for (int n = 0; n < 2; ++n) _Pragma("unroll") for (int q = 0; q < 4; ++q) KF[n][q] = *(const bf16x8*)(KT + (size_t)ck_ * 32768 + ((n * 4 + q) * 64) * 8); \
        DDv[0] = *(const f32x4*)(DD + (size_t)ck_ * 256); DDv[1] = *(const f32x4*)(DD + (size_t)ck_ * 256 + 16); } while (0)
#define GS_LOADV8(VF, s_) do { const int ck_ = GS_CK(s_); const int r0_ = GS_R0(s_, ck_); \
        _Pragma("unroll") for (int n = 0; n < 2; ++n) _Pragma("unroll") for (int q = 0; q < 4; ++q) VF[n][q] = *(const bf16x8*)(VBT + (size_t)n * 16 * NROW + r0_ + q * 32); } while (0)
#define GS_VFRAG(dst, s_) do { const int ck_ = GS_CK(s_); const int r0_ = GS_R0(s_, ck_); dst = *(const bf16x8*)(VBT + (size_t)(w >> 2) * 16 * NROW + r0_ + (w & 3) * 32); } while (0)
#define GS_UPDATE(VF, KF, DDv) do { _Pragma("unroll") for (int t = 0; t < 2; ++t) _Pragma("unroll") for (int n = 0; n < 2; ++n) { f32x4 tmp = st[t][n]; \
        _Pragma("unroll") for (int q = 0; q < 4; ++q) tmp = MFMA16(KF[t][q], VF[n][q], tmp); st[t][n] = tmp * DDv[t]; } } while (0)
#define GS_LOADQA(s_) do { const int ck_ = GS_CK(s_); const int r0_ = GS_R0(s_, ck_); \
        const bf16_t* qp_ = QT + (size_t)(r0_ + 16 * w + (lane >> 5)) * 1024 + h * 256 + (lane & 31) * 8; const bf16_t* ap_ = AB + (size_t)ck_ * 16384 + ((size_t)w * 4 * 64 + lane) * 8; \
        _Pragma("unroll") for (int q = 0; q < 8; ++q) qfr[q] = *(const bf16x8*)(qp_ + (size_t)q * 2 * 1024); \
        _Pragma("unroll") for (int q = 0; q < 4; ++q) if (q >= qlo && q <= qhi) af[q] = *(const bf16x8*)(ap_ + q * 64 * 8); } while (0)
    bf16x8 kfA[2][4], kfB[2][4], qfr[8], af[4], vcur; f32x4 ddA[2], ddB[2];
    const int qlo = dir == 0 ? 0 : (w >> 1), qhi = dir == 0 ? (w >> 1) : 3;
#pragma unroll
    for (int q = 0; q < 4; ++q) af[q] = (bf16x8){0, 0, 0, 0, 0, 0, 0, 0};
    LAS bf16x8* Vl = (LAS bf16x8*)(lds + 2 * 16896);
    __syncthreads();
    {
        bf16x8 vf0[2][4];
        GS_LOADK(kfA, ddA, 0); GS_LOADV8(vf0, 0); GS_LOADK(kfB, ddB, 1);
        GS_UPDATE(vf0, kfA, ddA);
        GS_LOADV8(vf0, 1);
        GS_LOADK(kfA, ddA, 2); GS_LOADQA(2); GS_VFRAG(vcur, 2);
        GS_UPDATE(vf0, kfB, ddB);
    }
#define GS_STEP(KF, DDv, KFN, DDN, s_, BUF) do { \
        const int sn_ = (s_) + 1 < 66 ? (s_) + 1 : 65; \
        GS_LOADK(KFN, DDN, sn_); \
        LAS bf16_t* SsB = Ss + (BUF) * (32 * 264); LAS bf16x8* VlB = Vl + (BUF) * 512; \
        _Pragma("unroll") for (int t = 0; t < 2; ++t) _Pragma("unroll") for (int n = 0; n < 2; ++n) { u32x2 pk; pk.x = cvt_pk_bf16(st[t][n][0], st[t][n][1]); pk.y = cvt_pk_bf16(st[t][n][2], st[t][n][3]); \
            *(LAS u32x2*)(SsB + (n * 16 + fr) * 264 + 32 * w + t * 16 + fq * 4) = pk; } \
        VlB[w * 64 + lane] = vcur; \
        LDS_BARRIER(); \
        bf16x8 vf[2][4]; \
        _Pragma("unroll") for (int n = 0; n < 2; ++n) _Pragma("unroll") for (int q = 0; q < 4; ++q) vf[n][q] = VlB[(n * 4 + q) * 64 + lane]; \
        GS_VFRAG(vcur, sn_); \
        GS_UPDATE(vf, KF, DDv); \
        f32x4 oo[2] = {(f32x4){0.f, 0.f, 0.f, 0.f}, (f32x4){0.f, 0.f, 0.f, 0.f}}; \
        _Pragma("unroll") for (int q = 0; q < 4; ++q) if (q >= qlo && q <= qhi) { _Pragma("unroll") for (int n = 0; n < 2; ++n) oo[n] = MFMA16(vf[n][q], af[q], oo[n]); } \
        _Pragma("unroll") for (int q = 0; q < 8; ++q) _Pragma("unroll") for (int n = 0; n < 2; ++n) { \
            const bf16x8 sf = *(const LAS bf16x8*)(SsB + (n * 16 + fr) * 264 + q * 32 + fq * 8); oo[n] = MFMA16(sf, qfr[q], oo[n]); } \
        { const int ck_ = GS_CK(s_); const int r0_ = GS_R0(s_, ck_); bf16_t* op = OB + (size_t)(r0_ + 16 * w + fr) * 2048 + h * 512 + sl * 32 + fq * 4; \
          _Pragma("unroll") for (int n = 0; n < 2; ++n) { u32x2 pk; pk.x = cvt_pk_bf16(oo[n][0], oo[n][1]); pk.y = cvt_pk_bf16(oo[n][2], oo[n][3]); *(u32x2*)(op + n * 16) = pk; } } \
        GS_LOADQA(sn_); \
    } while (0)
#pragma unroll 1
    for (int s = 2; s < 66; s += 2) {
        GS_STEP(kfA, ddA, kfB, ddB, s, 0);
        GS_STEP(kfB, ddB, kfA, ddA, s + 1, 1);
    }
#undef GS_CK
#undef GS_R0
#undef GS_LOADK
#undef GS_LOADV8
#undef GS_VFRAG
#undef GS_UPDATE
#undef GS_LOADQA
#undef GS_STEP
}

__device__ void phase_glafinal(const P& p, bf16_t* cc) {
    const int tix = threadIdx.x + opaque0(); const int lane = tix & 63, gw = blockIdx.x * 8 + (tix >> 6), nw = gridDim.x * 8;
    const bf16_t* OF = (const bf16_t*)(p.ws + O_OF); const bf16_t* OBk = OF + (size_t)NTOK * 2048;
    f32x4 g0 = *(const f32x4*)(p.gla_norm + lane * 8), g1 = *(const f32x4*)(p.gla_norm + lane * 8 + 4);
    for (int i = gw; i < NTOK * 4; i += nw) {
        const size_t o = (size_t)i * 512 + lane * 8;
        float a[8], c[8]; unpack8(*(const u32x4*)(OF + o), a); unpack8(*(const u32x4*)(OBk + o), c);
        float ss = 0.f;
#pragma unroll
        for (int e = 0; e < 8; ++e) { a[e] += c[e]; ss += a[e] * a[e]; }
        ss = wave_sum(ss); const float rs = rsqrtf(ss * (1.0f / 512) + EPS_);
#pragma unroll
        for (int e = 0; e < 4; ++e) { a[e] *= rs * g0[e]; a[4 + e] *= rs * g1[e]; }
        const int r = i >> 2, hh = i & 3;
        *(u32x4*)(cc + (size_t)r * 4096 + 2048 + hh * 512 + lane * 8) = pack8(a);
    }
}

__device__ void phase_conv(const P& p, const bf16_t* U, int ldu, int j0, int ns, bf16_t* act) {
    const int ncg = ns * 16, ntask = 256 * ncg;
    for (int task = blockIdx.x * 512 + threadIdx.x + opaque0(); task < ntask; task += gridDim.x * 512) {
        const int run = task / ncg, cgi = task % ncg, jl = cgi >> 4, i8 = (cgi & 15) * 8;
        const int ch = 128 * (j0 + jl) + i8; const int ucol = jl * 256 + i8;
        float wa[3][8], wg[3][8], ba[8], bg[8];
#pragma unroll
        for (int j = 0; j < 3; ++j)
#pragma unroll
            for (int e = 0; e < 8; ++e) { wa[j][e] = p.conv_w[j * 11264 + ch + e]; wg[j][e] = p.conv_w[j * 11264 + 5632 + ch + e]; }
#pragma unroll
        for (int e = 0; e < 8; ++e) { ba[e] = p.conv_b[ch + e]; bg[e] = p.conv_b[5632 + ch + e]; }
        const int rw0 = run * 64; const int tl0 = rw0 & (T_ - 1);
        float pa[8], pg[8], ca[8], cg_[8], na[8], ng[8];
        const bf16_t* up = U + (size_t)rw0 * ldu + ucol;
        if (tl0 > 0) { unpack8(*(const u32x4*)(up - ldu), pa); unpack8(*(const u32x4*)(up - ldu + 128), pg); }
        else {
#pragma unroll
            for (int e = 0; e < 8; ++e) { pa[e] = 0.f; pg[e] = 0.f; } }
        unpack8(*(const u32x4*)(up), ca); unpack8(*(const u32x4*)(up + 128), cg_);
#pragma unroll 1
        for (int i0 = 0; i0 < 64; i0 += 8) {
            u32x4 ra[8], rg[8];
#pragma unroll
            for (int k = 0; k < 8; ++k) { const int rn = rw0 + i0 + k + 1; const bf16_t* q = U + (size_t)(rn < NTOK ? rn : NTOK - 1) * ldu + ucol;
                ra[k] = *(const u32x4*)q; rg[k] = *(const u32x4*)(q + 128); }
#pragma unroll
            for (int k = 0; k < 8; ++k) {
                const int i = i0 + k; const bool has_next = (tl0 + i + 1) < T_;
                unpack8(ra[k], na); unpack8(rg[k], ng);
                if (!has_next) {
#pragma unroll
                    for (int e = 0; e < 8; ++e) { na[e] = 0.f; ng[e] = 0.f; } }
                float y[8];
#pragma unroll
                for (int e = 0; e < 8; ++e) { const float av = wa[0][e] * pa[e] + wa[1][e] * ca[e] + wa[2][e] * na[e] + ba[e]; const float gv = wg[0][e] * pg[e] + wg[1][e] * cg_[e] + wg[2][e] * ng[e] + bg[e];
                    y[e] = siluf_(av) * gv; pa[e] = ca[e]; pg[e] = cg_[e]; ca[e] = na[e]; cg_[e] = ng[e]; }
                *(u32x4*)(act + (size_t)(rw0 + i) * 5632 + ch) = pack8(y);
            }
        }
    }
}


#ifdef DBG_STOP
__device__ void dbg_dump(cg::grid_group& grid, const P& p, const bf16_t* src, size_t ld, int rows, int cols) {
    bf16_t* tmp = (bf16_t*)(p.ws + O_MIXEND);
    grid.sync();
    const size_t n = (size_t)rows * cols;
    for (size_t i = (size_t)blockIdx.x * 512 + threadIdx.x; i < n; i += (size_t)gridDim.x * 512) tmp[i] = src[(i / cols) * ld + (i % cols)];
    grid.sync();
    for (size_t i = (size_t)blockIdx.x * 512 + threadIdx.x; i < (size_t)NTOK * DM; i += (size_t)gridDim.x * 512) {
        const size_t r = i / DM, c = i % DM; p.out[i] = (r < (size_t)rows && c < (size_t)cols) ? bf2f(tmp[r * cols + c]) : 0.f; }
}
#define DBG_AT(k, src, ld, rows, cols) if (DBG_STOP == k) { dbg_dump(grid, p, (const bf16_t*)(src), ld, rows, cols); return; }
#else
#define DBG_AT(k, src, ld, rows, cols)
#endif

#ifdef DBG_STOP
__device__ void dbg_nancount(cg::grid_group& grid, const P& p, const bf16_t* src, size_t n, int mode) {
    unsigned* cnt = (unsigned*)(p.ws + O_MIXEND);
    grid.sync();
    if (blockIdx.x == 0 && threadIdx.x == 0) { cnt[0] = 0; cnt[1] = 0; }
    grid.sync();
    unsigned c = 0; float mx = 0.f;
    for (size_t i = (size_t)blockIdx.x * 512 + threadIdx.x; i < n; i += (size_t)gridDim.x * 512) { const unsigned short v = src[i]; if ((v & 0x7f80) == 0x7f80) ++c; else mx = fmaxf(mx, fabsf(bf2f(v))); }
    if (c) atomicAdd(cnt, c);
    atomicMax(cnt + 1, __float_as_uint(mx));
    grid.sync();
    for (size_t i = (size_t)blockIdx.x * 512 + threadIdx.x; i < (size_t)NTOK * DM; i += (size_t)gridDim.x * 512) p.out[i] = 0.f;
    grid.sync();
    if (blockIdx.x == 0 && threadIdx.x == 0) p.out[0] = mode == 0 ? (float)cnt[0] : __uint_as_float(cnt[1]);
}
#define DBG_NAN(k, src, n) if (DBG_STOP == k) { dbg_nancount(grid, p, (const bf16_t*)(src), n, 0); return; } if (DBG_STOP == k + 100) { dbg_nancount(grid, p, (const bf16_t*)(src), n, 1); return; }
#else
#define DBG_NAN(k, src, n)
#endif
#define XB_TMO      128
#define XB_XCNT(j)  (256  + 64 * (j))
#define XB_XSUB(j)  (1280 + 64 * (j))
#define XB_XGEN(j)  (2304 + 64 * (j))
#define XB_TOP      3328
#define XB_TOPGEN   3392
#define XCD_BAR_WORDS 3456
#define XB_SPIN_CAP (1u << 18)

__device__ __forceinline__ unsigned xb_ld(unsigned* p)              { return __hip_atomic_load(p, __ATOMIC_RELAXED, __HIP_MEMORY_SCOPE_AGENT); }
__device__ __forceinline__ unsigned xb_add(unsigned* p, unsigned v) { return __hip_atomic_fetch_add(p, v, __ATOMIC_RELAXED, __HIP_MEMORY_SCOPE_AGENT); }
__device__ __forceinline__ unsigned xb_xcc_id() { return (unsigned)__builtin_amdgcn_s_getreg((3 << 11) | 20) & 0xFu; }
#define XB_SPIN(cond, bar) do { unsigned _sp = 0; while (cond) { __builtin_amdgcn_s_sleep(1); \
    if ((++_sp & 255u) == 0u) { if (xb_ld(&(bar)[XB_TMO])) break; if (_sp > XB_SPIN_CAP) { atomicAdd(&(bar)[XB_TMO], 1u); break; } } } } while (0)

struct XcdBarrier {
    unsigned* bar; unsigned x;
    volatile LAS unsigned* st;
};

__device__ __forceinline__ XcdBarrier xcd_barrier_post(unsigned* bar, volatile LAS unsigned* st) {
    XcdBarrier b; b.bar = bar; b.x = xb_xcc_id(); b.st = st;
    if (threadIdx.x == 0) (void)xb_add(&bar[XB_XCNT(b.x)], 1u);
    return b;
}
__device__ __forceinline__ void xcd_barrier_complete(unsigned* bar, unsigned x, unsigned& nloc, unsigned& nx) {
    const unsigned G = gridDim.x * gridDim.y * gridDim.z;
    unsigned sum, cnt, mine, sp = 0u;
    for (;;) {
        sum = 0u; cnt = 0u; mine = 0u;
#pragma unroll
        for (unsigned j = 0; j < 16; ++j) { const unsigned c = xb_ld(&bar[XB_XCNT(j)]); sum += c; cnt += (c > 0u) ? 1u : 0u; mine = (j == x) ? c : mine; }
        if (sum == G) break;
        __builtin_amdgcn_s_sleep(1);
        if ((++sp & 255u) == 0u) { if (xb_ld(&bar[XB_TMO])) break; if (sp > XB_SPIN_CAP) { atomicAdd(&bar[XB_TMO], 1u); break; } }
    }
    nloc = mine > 0u ? mine : 1u; nx = cnt > 0u ? cnt : 1u;
}

__device__ __forceinline__ void xcd_barrier(const XcdBarrier& b) {
    asm volatile("s_waitcnt vmcnt(0)" ::: "memory");
    __syncthreads();
    if (threadIdx.x == 0) {
        unsigned* bar = b.bar;
        __builtin_amdgcn_s_waitcnt(0);
        unsigned nloc = b.st[0], nx = b.st[1];
        if (nloc == 0u) { xcd_barrier_complete(bar, b.x, nloc, nx); b.st[0] = nloc; b.st[1] = nx; }
        const unsigned old = xb_add(&bar[XB_XSUB(b.x)], 1u);
        const unsigned gen = old / nloc;
        if (old + 1u == (gen + 1u) * nloc) {
            __builtin_amdgcn_fence(__ATOMIC_RELEASE, "agent");
            asm volatile("s_waitcnt vmcnt(0)" ::: "memory");
            const unsigned og = xb_add(&bar[XB_TOP], 1u);
            const unsigned tg = og / nx;
            if (og + 1u == (tg + 1u) * nx) xb_add(&bar[XB_TOPGEN], 1u);
            else XB_SPIN(xb_ld(&bar[XB_TOPGEN]) == tg, bar);
            __builtin_amdgcn_fence(__ATOMIC_ACQUIRE, "agent");
            xb_add(&bar[XB_XGEN(b.x)], 1u);
            asm volatile("s_waitcnt vmcnt(0)" ::: "memory");
        } else {
            XB_SPIN(xb_ld(&bar[XB_XGEN(b.x)]) == gen, bar);
            __builtin_amdgcn_fence(__ATOMIC_ACQUIRE, "agent");
            asm volatile("s_waitcnt vmcnt(0)" ::: "memory");
        }
    }
    __syncthreads();
}


__global__ void __launch_bounds__(512) fwd_megakernel(P p) {
    extern __shared__ __attribute__((aligned(16))) unsigned char shm[];
    LAS unsigned char* lds = (LAS unsigned char*)shm;
    cg::grid_group grid = cg::this_grid();
    volatile LAS unsigned* xst = (volatile LAS unsigned*)(lds + 153600);
    if (threadIdx.x == 0) { xst[0] = 0u; xst[1] = 0u; }
    __syncthreads();
    const XcdBarrier xb = xcd_barrier_post((unsigned*)(p.ws + O_BAR), xst);
#ifdef TIME_A
    unsigned long long ts0 = 0, ts1 = 0, ts2 = 0, ts3 = 0, ts4 = 0, ts5 = 0, ts6 = 0, ts7 = 0, ts8 = 0, ts9 = 0, ts10 = 0, ts11 = 0, ts12 = 0, ts13 = 0;
#define TS(k) ts##k = __builtin_amdgcn_s_memrealtime();
#define TSCAT2(a) ts##a
#define TSCAT(a) TSCAT2(a)
#else
#define TS(k)
#endif
    TS(0)
    unsigned char* ws = p.ws; const int nb = gridDim.x, bid = blockIdx.x;
    float* mod = (float*)(ws + O_MOD);
    bf16_t* cc = (bf16_t*)p.out;

#ifndef PHMASK
#define PHMASK 0xffff
#endif
    if (PHMASK & 1) phase0(lds, p);
    xcd_barrier(xb); if (p.pad == 0x7eadbeef) grid.sync();
    TS(1)
#ifdef DBL_P0
    phase0(lds, p);
    xcd_barrier(xb);
#endif
    if (PHMASK & 1) phase_modreduce(p);
    xcd_barrier(xb);
    TS(2)
    if (PHMASK & 1) phase_modulate(p.x, p.ctx, p.g_mix, mod, 0, 1, (bf16_t*)(ws + O_H), NROW);
    xcd_barrier(xb);
    TS(3)
    if (PHMASK & 2) { SchedProj1 S{(const char*)(ws + O_H), (const char*)(ws + O_XR), ws, nb, bid}; EpiProj1 E; pg8::gemm_phase(lds, 2048, S, E); }
    xcd_barrier(xb);
    TS(4)
    DBG_AT(1, ws + O_QA, 2048, 8192, 2048)
    DBG_AT(2, ws + O_VBT, NROW, 2048, 2048)
    DBG_AT(11, ws + O_H, 2048, 8192, 2048)
    DBG_AT(12, ws + O_KB, 1024, 8192, 1024)
    phase_kprep(p);
    xcd_barrier(xb);
    {
        unsigned* qctr = (unsigned*)(ws + O_BAR + 16384); volatile LAS unsigned* qs = (volatile LAS unsigned*)(lds + 153608);
        for (;;) {
            __syncthreads();
            if (threadIdx.x == 0) qs[0] = __hip_atomic_fetch_add(qctr, 1u, __ATOMIC_RELAXED, __HIP_MEMORY_SCOPE_AGENT);
            __syncthreads();
            const int it = (int)qs[0];
            if (it >= 528 + 1024) break;
            if (it < 528) glaprep_item(lds, p, it); else attn_item(lds, p, cc, it - 528);
        }
    }
    xcd_barrier(xb);
    TS(5)
    DBG_AT(3, cc, 4096, 8192, 2048)
    DBG_AT(4, ws + O_QF, 1024, 8192, 1024)
    DBG_AT(5, ws + O_XR, 2048, 8192, 2048)
    DBG_AT(6, ws + O_KT, NROW, 2048, 2048)
    DBG_AT(13, ws + O_QB, 1024, 8192, 1024)
#if defined(DBG_STOP) && DBG_STOP == 16
    { xcd_barrier(xb); for (size_t i = (size_t)bid * 512 + threadIdx.x; i < (size_t)NTOK * DM; i += (size_t)nb * 512) p.out[i] = i < 270336 ? ((const float*)(ws + O_DD))[i] : 0.f; return; }
#endif
    if (PHMASK & 16) for (int it = bid; it < 256; it += nb) glaseq_item(lds, p, it);
    xcd_barrier(xb);
    TS(6)
#ifdef DBL_SEQ
    for (int it = bid; it < 256; it += nb) glaseq_item(lds, p, it);
    xcd_barrier(xb);
#endif
    DBG_AT(7, ws + O_OF, 2048, 8192, 2048)
    DBG_NAN(20, ws + O_OF, (size_t)2 * NTOK * 2048)
    DBG_NAN(21, ws + O_KT, (size_t)2 * 1024 * NROW)
    DBG_AT(14, ws + O_OF + 67108864, 2048, 8192, 2048)
    if (PHMASK & 32) phase_glafinal(p, cc);
    xcd_barrier(xb);
    TS(7)
    DBG_AT(8, cc + 2048, 4096, 8192, 2048)
    if (PHMASK & 64) { SchedProj2 S{(const char*)(ws + O_H), (const char*)(ws + O_W2IN), ws, cc, nb, bid}; EpiProj2 E; pg8::gemm_phase(lds, 2048, S, E); }
    xcd_barrier(xb);
    TS(8)
    DBG_AT(9, ws + O_GA, 2048, 8192, 2048)
    DBG_AT(15, cc + 2048, 4096, 8192, 2048)
    if (PHMASK & 128) { SchedMerge S{(const char*)cc, (const char*)(ws + O_WMRG), ws, nb, bid}; EpiMerge E{(const bf16_t*)(ws + O_GA), (const bf16_t*)(ws + O_GA + 67108864)}; pg8::gemm_phase(lds, 4096, S, E); }
    xcd_barrier(xb);
    TS(9)
    DBG_AT(10, ws + O_M, 2048, 8192, 2048)
    if (PHMASK & 256) { SchedRes S{(const char*)(ws + O_M), (const char*)(ws + O_WOUT), 2048, nb, bid}; EpiDelta E{(bf16_t*)(ws + O_D1), mod + 2 * 2048}; pg8::gemm_phase(lds, 2048, S, E); }
    xcd_barrier(xb);
    TS(10)
#ifdef DBG_STOP_WOUT
    return;
#endif
    phase_modulate2(p.x, (const bf16_t*)(ws + O_D1), p.g_ffn, mod, 3, 4, (bf16_t*)(ws + O_H2));
    { LAS float* tl = (LAS float*)lds; const int J5 = 32 * 44, J6 = 88 * 8, JT = J5 + J6; const int tid = threadIdx.x + opaque0();
      auto job2 = [&](int it) -> TJob { return it < J5 ? tj_make(p.w_up, 11264, (bf16_t*)(ws + O_WUP), 2048, 11264, 3, 0, it) : tj_make(p.w_down, 2048, (bf16_t*)(ws + O_WDN), 5632, 2048, 0, 0, it - J5); };
      int it = bid; f32x4 v[8]; TJob cur;
      if (it < JT) { cur = job2(it); tj_load(cur, tid, v); }
      while (it < JT) {
          LDS_BARRIER(); tj_store(tl, cur, tid, v);
          const int itn = it + nb; TJob nxt = cur; if (itn < JT) { nxt = job2(itn); tj_load(nxt, tid, v); }
          LDS_BARRIER(); tj_flush(tl, cur, tid);
          cur = nxt; it = itn; } }
    xcd_barrier(xb);
    TS(11)
    { SchedUpC S{(const char*)(ws + O_H2), (const char*)(ws + O_WUP), nb, bid}; EpiUpConv E{p.conv_w, p.conv_b, (bf16_t*)(ws + O_U), (float*)(ws + O_U + 184549376), lds}; pg8::gemm_phase(lds, 2048, S, E); }
    xcd_barrier(xb);
    phase_convfix(p, (const float*)(ws + O_U + 184549376), (bf16_t*)(ws + O_U));
    xcd_barrier(xb);
    TS(12)
    if (PHMASK & 4096) { SchedRes S{(const char*)(ws + O_U), (const char*)(ws + O_WDN), 5632, nb, bid}; EpiRes2 E{p.x, (const bf16_t*)(ws + O_D1), p.out, mod + 5 * 2048}; pg8::gemm_phase(lds, 5632, S, E); }
#ifdef TIME_A
    xcd_barrier(xb); TS(13)
    if (bid == 0 && threadIdx.x == 0) p.out[0] = (float)(TSCAT(TIME_B) - TSCAT(TIME_A));
#endif
#ifdef DBG_COPYX
    xcd_barrier(xb);
    for (size_t i = (size_t)bid * 512 + threadIdx.x; i < (size_t)NTOK * DM / 4; i += (size_t)nb * 512) ((f32x4*)p.out)[i] = ((const f32x4*)p.x)[i];
#endif
}

extern "C" void kernel_launch(void* const* d_in, const int* in_sizes, int n_in, void* d_out, int out_size, void* d_ws, size_t ws_size, hipStream_t stream) {
    static int grid_blocks = 0;
    if (grid_blocks == 0) {
        int dev = 0, cus = 0, per_cu = 0;
        hipGetDevice(&dev); hipDeviceGetAttribute(&cus, hipDeviceAttributeMultiprocessorCount, dev);
        if (hipFuncSetAttribute((const void*)fwd_megakernel, hipFuncAttributeMaxDynamicSharedMemorySize, LDS_BYTES) != hipSuccess) { fprintf(stderr, "kernel_launch: hipFuncSetAttribute failed\n"); grid_blocks = -1; return; }
        if (hipOccupancyMaxActiveBlocksPerMultiprocessor(&per_cu, (const void*)fwd_megakernel, 512, LDS_BYTES) != hipSuccess || per_cu < 1) { fprintf(stderr, "kernel_launch: occupancy query gave %d\n", per_cu); per_cu = 1; }
        (void)hipGetLastError();
        grid_blocks = cus * 1;
    }
    if (grid_blocks < 0) return;
    P p{};
    const float** f = (const float**)&p;
    for (int i = 0; i < 24; ++i) f[i] = (const float*)d_in[i];
    p.out = (float*)d_out; p.ws = (unsigned char*)d_ws;
    const size_t act_bytes = 184549376;
    if (ws_size >= O_U + (size_t)24 * 256 * NTOK * 2 + act_bytes) { p.ns[0] = 20; p.ns[1] = 24; p.ns[2] = 0; p.nsmax = 24; }
    else { p.ns[0] = 16; p.ns[1] = 16; p.ns[2] = 12; p.ns[3] = 0; p.nsmax = 16; }
    p.o_act = (long long)(O_U + (size_t)p.nsmax * 256 * NTOK * 2);
    if (ws_size < (size_t)p.o_act + act_bytes || ws_size < O_MIXEND) { fprintf(stderr, "kernel_launch: workspace too small (%zu)\n", ws_size); return; }
    if (ws_size < O_BAR + 16384 + 256) { fprintf(stderr, "kernel_launch: workspace too small for the barrier words (%zu)\n", ws_size); return; }
    if (hipMemsetAsync((char*)d_ws + O_BAR, 0, 16384 + 256, stream) != hipSuccess) { fprintf(stderr, "kernel_launch: memset failed\n"); return; }
    void* args[] = {&p};
    hipError_t e = hipLaunchCooperativeKernel((void*)fwd_megakernel, dim3(grid_blocks), dim3(512), args, LDS_BYTES, stream);
    if (e != hipSuccess) fprintf(stderr, "cooperative launch failed: %s (grid %d)\n", hipGetErrorString(e), grid_blocks);
}
```
